# Optimizing an MI355X kernel written in HIP

```python
import jax
import jax.numpy as jnp
from jax import lax
import numpy as np

D_MODEL = 1024
BATCH = 4
SEQ = 8192
DEPTH = 2

CHUNK = 64
Q_BLOCK = 128
N_A_LAYERS = DEPTH // 2
N_B_LAYERS = DEPTH - N_A_LAYERS
CONV_WIDTH = 31
N_HEADS = 8
QK_NOPE_DIM = 128
QK_ROPE_DIM = 64
QK_DIM = QK_NOPE_DIM + QK_ROPE_DIM
V_HEAD_DIM = 128
KV_LORA_RANK = D_MODEL // 4
Q_LORA_RANK = 3 * KV_LORA_RANK // 2
ROPE_THETA = 10000.0
SOFTMAX_SCALE = QK_DIM ** -0.5
N_GROUPS = 4
EXPERTS_PER_GROUP = 8
N_EXPERTS = N_GROUPS * EXPERTS_PER_GROUP
TOP_K_IN_GROUP = 2
D_EXPERT = D_MODEL // 2
EPS = 1e-6
MASK_VALUE = -1e30

kernel_name = "conv_mla_yoco_hier_moe_block"


def rms_norm(x, g):
    xf = x.astype(jnp.float32)
    y = xf * lax.rsqrt(jnp.mean(xf * xf, axis=-1, keepdims=True) + EPS)
    return (y * g.astype(jnp.float32)).astype(x.dtype)


def layer_norm(x, g, b):
    xf = x.astype(jnp.float32)
    mu = jnp.mean(xf, axis=-1, keepdims=True)
    var = jnp.mean(jnp.square(xf - mu), axis=-1, keepdims=True)
    y = (xf - mu) * lax.rsqrt(var + EPS)
    return (y * g.astype(jnp.float32) + b.astype(jnp.float32)).astype(x.dtype)


def rope_tables(positions):
    inv_freq = ROPE_THETA ** (-jnp.arange(0, QK_ROPE_DIM, 2, dtype=jnp.float32) / QK_ROPE_DIM)
    ang = positions.astype(jnp.float32)[..., None] * inv_freq
    return jnp.cos(ang)[:, :, None, :], jnp.sin(ang)[:, :, None, :]


def rope_tail(x, cos, sin):
    x_nope = x[..., :QK_NOPE_DIM]
    xr = x[..., QK_NOPE_DIM:].astype(jnp.float32)
    x1, x2 = jnp.split(xr, 2, axis=-1)
    rot = jnp.concatenate([x1 * cos - x2 * sin, x1 * sin + x2 * cos], axis=-1)
    return jnp.concatenate([x_nope, rot.astype(x.dtype)], axis=-1)


def conformer_conv_module(h, norm_g, pw1_w, pw1_b, dw_w, dw_b, ln_g, ln_b, pw2_w, pw2_b):
    hn = rms_norm(h, norm_g)
    a, gate = jnp.split(hn @ pw1_w + pw1_b, 2, axis=-1)
    u = a * jax.nn.sigmoid(gate)
    u = lax.conv_general_dilated(
        u, dw_w[:, None, :].astype(u.dtype), window_strides=(1,),
        padding=[(CONV_WIDTH - 1, 0)],
        dimension_numbers=('NWC', 'WIO', 'NWC'),
        feature_group_count=D_MODEL) + dw_b
    u = jax.nn.silu(layer_norm(u, ln_g, ln_b))
    return u @ pw2_w + pw2_b


def shared_mla_kv(h, kv_norm_g, w_dkv, kv_latent_g, w_kr, w_ukv, k_norm_g, cos, sin):
    B, S, _ = h.shape
    hn = rms_norm(h, kv_norm_g)
    c_kv = rms_norm(hn @ w_dkv, kv_latent_g)
    kv = (c_kv @ w_ukv).reshape(B, S, N_HEADS, QK_NOPE_DIM + V_HEAD_DIM)
    k_nope, v = kv[..., :QK_NOPE_DIM], kv[..., QK_NOPE_DIM:]
    k_rope = hn @ w_kr
    k = jnp.concatenate(
        [k_nope, jnp.broadcast_to(k_rope[:, :, None, :], (B, S, N_HEADS, QK_ROPE_DIM))], axis=-1)
    k = rope_tail(rms_norm(k, k_norm_g), cos, sin)
    return k, v


def chunk_causal_attention(q, k, v):
    B, S, H, Dqk = q.shape
    n_blk = S // Q_BLOCK
    qb = q.reshape(B, n_blk, Q_BLOCK, H, Dqk).transpose(1, 0, 3, 2, 4)
    key_chunk = jnp.arange(S) // CHUNK

    def one_block(args):
        q_blk, blk = args
        q_chunk = (blk * Q_BLOCK + jnp.arange(Q_BLOCK)) // CHUNK
        allowed = key_chunk[None, :] <= q_chunk[:, None]
        s = jnp.einsum('bhqd,bkhd->bhqk', q_blk, k).astype(jnp.float32) * SOFTMAX_SCALE
        s = jnp.where(allowed, s, MASK_VALUE)
        p = jax.nn.softmax(s, axis=-1).astype(v.dtype)
        return jnp.einsum('bhqk,bkhd->bqhd', p, v)

    out = lax.map(one_block, (qb, jnp.arange(n_blk)))
    return out.transpose(1, 0, 2, 3, 4).reshape(B, S, H, v.shape[-1])


def mla_attention_layer(h, k, v, norm_g, w_dq, q_latent_g, w_uq, q_norm_g, w_o, cos, sin):
    B, S, _ = h.shape
    hn = rms_norm(h, norm_g)
    c_q = rms_norm(hn @ w_dq, q_latent_g)
    q = (c_q @ w_uq).reshape(B, S, N_HEADS, QK_DIM)
    q = rope_tail(rms_norm(q, q_norm_g), cos, sin)
    o = chunk_causal_attention(q, k, v)
    return o.reshape(B, S, N_HEADS * V_HEAD_DIM) @ w_o


def hierarchical_moe(h, norm_g, w_group, b_group, w_router, b_router, w_gate_up, w_down):
    B, S, D = h.shape
    xt = rms_norm(h, norm_g).reshape(B * S, D)
    g_prob = jax.nn.softmax((xt @ w_group + b_group).astype(jnp.float32), axis=-1)
    g_idx = jnp.argmax(g_prob, axis=-1)
    g_w = jnp.take_along_axis(g_prob, g_idx[:, None], axis=-1)
    e_logits = (xt @ w_router + b_router).astype(jnp.float32).reshape(-1, N_GROUPS, EXPERTS_PER_GROUP)
    e_logits = jnp.take_along_axis(e_logits, g_idx[:, None, None], axis=1)[:, 0]
    e_prob = jax.nn.softmax(e_logits, axis=-1)
    top_p, top_i = lax.top_k(e_prob, TOP_K_IN_GROUP)
    top_p = top_p / jnp.sum(top_p, axis=-1, keepdims=True)
    expert_id = g_idx[:, None] * EXPERTS_PER_GROUP + top_i
    gates = jnp.sum(jax.nn.one_hot(expert_id, N_EXPERTS, dtype=jnp.float32)
                    * (g_w * top_p)[..., None], axis=1).astype(xt.dtype)

    def expert_step(acc, ex):
        w_gu, w_d, g = ex
        a, b = jnp.split(xt @ w_gu, 2, axis=-1)
        return acc + ((jax.nn.silu(a) * b) @ w_d) * g[:, None], None

    y, _ = lax.scan(expert_step, jnp.zeros_like(xt), (w_gate_up, w_down, gates.T))
    return y.reshape(B, S, D)


def setup_inputs(seed: int = 0) -> dict:
    key = jax.random.key(seed)
    ks = iter(jax.random.split(key, 40))

    def nrm(shape, scale):
        return jax.random.normal(next(ks), shape, jnp.float32) * scale

    def gain(shape):
        return 1.0 + nrm(shape, 0.05)

    D, NA, NB, L = D_MODEL, N_A_LAYERS, N_B_LAYERS, DEPTH
    x = nrm((BATCH, SEQ, D), 1.0)
    offsets = jax.random.randint(next(ks), (BATCH, 1), 0, 64) * CHUNK
    positions = (jnp.arange(SEQ, dtype=jnp.int32)[None, :] + offsets).astype(jnp.int32)
    return {
        "x": x,
        "positions": positions,
        "a_norm_g": gain((NA, D)),
        "a_pw1_w": nrm((NA, D, 2 * D), D ** -0.5),
        "a_pw1_b": nrm((NA, 2 * D), 0.01),
        "a_dw_w": nrm((NA, CONV_WIDTH, D), CONV_WIDTH ** -0.5),
        "a_dw_b": nrm((NA, D), 0.01),
        "a_ln_g": gain((NA, D)),
        "a_ln_b": nrm((NA, D), 0.01),
        "a_pw2_w": nrm((NA, D, D), D ** -0.5),
        "a_pw2_b": nrm((NA, D), 0.01),
        "kv_norm_g": gain((D,)),
        "w_dkv": nrm((D, KV_LORA_RANK), D ** -0.5),
        "kv_latent_g": gain((KV_LORA_RANK,)),
        "w_kr": nrm((D, QK_ROPE_DIM), D ** -0.5),
        "w_ukv": nrm((KV_LORA_RANK, N_HEADS * (QK_NOPE_DIM + V_HEAD_DIM)), KV_LORA_RANK ** -0.5),
        "k_norm_g": gain((QK_DIM,)),
        "b_norm_g": gain((NB, D)),
        "w_dq": nrm((NB, D, Q_LORA_RANK), D ** -0.5),
        "q_latent_g": gain((NB, Q_LORA_RANK)),
        "w_uq": nrm((NB, Q_LORA_RANK, N_HEADS * QK_DIM), Q_LORA_RANK ** -0.5),
        "q_norm_g": gain((NB, QK_DIM)),
        "w_o": nrm((NB, N_HEADS * V_HEAD_DIM, D), (N_HEADS * V_HEAD_DIM) ** -0.5),
        "ffn_norm_g": gain((L, D)),
        "w_group": nrm((L, D, N_GROUPS), D ** -0.5),
        "b_group": nrm((L, N_GROUPS), 0.01),
        "w_router": nrm((L, D, N_EXPERTS), D ** -0.5),
        "b_router": nrm((L, N_EXPERTS), 0.01),
        "w_gate_up": nrm((L, N_EXPERTS, D, 2 * D_EXPERT), D ** -0.5),
        "w_down": nrm((L, N_EXPERTS, D_EXPERT, D), D_EXPERT ** -0.5),
    }


def reference(x, positions, a_norm_g, a_pw1_w, a_pw1_b, a_dw_w, a_dw_b, a_ln_g, a_ln_b, a_pw2_w, a_pw2_b,
              kv_norm_g, w_dkv, kv_latent_g, w_kr, w_ukv, k_norm_g,
              b_norm_g, w_dq, q_latent_g, w_uq, q_norm_g, w_o,
              ffn_norm_g, w_group, b_group, w_router, b_router, w_gate_up, w_down):
    cos, sin = rope_tables(positions)
    h = x
    k_shared = None
    v_shared = None
    for layer in range(DEPTH):
        if layer < N_A_LAYERS:
            i = layer
            h = h + conformer_conv_module(h, a_norm_g[i], a_pw1_w[i], a_pw1_b[i], a_dw_w[i], a_dw_b[i],
                                          a_ln_g[i], a_ln_b[i], a_pw2_w[i], a_pw2_b[i])
        else:
            i = layer - N_A_LAYERS
            if i == 0:
                k_shared, v_shared = shared_mla_kv(h, kv_norm_g, w_dkv, kv_latent_g, w_kr, w_ukv,
                                                   k_norm_g, cos, sin)
            h = h + mla_attention_layer(h, k_shared, v_shared, b_norm_g[i], w_dq[i], q_latent_g[i],
                                        w_uq[i], q_norm_g[i], w_o[i], cos, sin)
        h = h + hierarchical_moe(h, ffn_norm_g[layer], w_group[layer], b_group[layer], w_router[layer],
                                 b_router[layer], w_gate_up[layer], w_down[layer])
    return h
```

```cpp
#include <hip/hip_runtime.h>
#include <stdint.h>
#include <stdio.h>

typedef unsigned short bf16;
constexpr int NB = 4, SEQ = 8192, T = NB * SEQ, D = 1024, NH = 8, DQK = 192, DNOPE = 128, DROPE = 64, DV = 128, KVR = 256, QLR = 384;
constexpr int NE = 32, NG = 4, EPG = 8, DE = 512, CONVW = 31, NCL = 768, NRT = 36;
constexpr float EPS = 1e-6f;
constexpr float SM_SCALE = 0.07216878364870322f;

constexpr size_t MiB = 1u << 20;
constexpr size_t WS_CTL = 0, WS_W1T = 1 * MiB, WS_W2T = 5 * MiB, WS_WC = 7 * MiB, WS_WUKV = 9 * MiB, WS_WUQ = 10 * MiB, WS_WO = 12 * MiB, WS_WR = 14 * MiB,
                 WS_WGU = 16 * MiB, WS_WD = 144 * MiB, WS_RSTD0 = 208 * MiB, WS_RSTD = WS_RSTD0 + 256 * 1024, WS_RSTD2 = WS_RSTD0 + 512 * 1024,
                 WS_GATE = 209 * MiB, WS_LIST = 210 * MiB, WS_CS = 214 * MiB, WS_SSP = 222 * MiB, WS_SSQ = 225 * MiB, WS_SSK = 231 * MiB,
                 WS_R1 = 236 * MiB, WS_R2 = 300 * MiB, WS_R3 = 364 * MiB, WS_CL = 492 * MiB, WS_QRAW = 540 * MiB, WS_KK = 636 * MiB, WS_SCR = 732 * MiB, WS_END = 988 * MiB;

__device__ const float INV_FREQ[32] = {
    1.0f, 0.7498942093324559f, 0.5623413251903491f, 0.4216965034285822f, 0.31622776601683794f, 0.23713737056616552f, 0.1778279410038923f, 0.1333521432163324f,
    0.1f, 0.07498942093324558f, 0.05623413251903491f, 0.04216965034285822f, 0.03162277660168379f, 0.023713737056616554f, 0.01778279410038923f, 0.01333521432163324f,
    0.01f, 0.007498942093324558f, 0.005623413251903491f, 0.004216965034285823f, 0.0031622776601683794f, 0.0023713737056616554f, 0.001778279410038923f, 0.001333521432163324f,
    0.001f, 0.0007498942093324559f, 0.0005623413251903491f, 0.00042169650342858224f, 0.00031622776601683794f, 0.00023713737056616554f, 0.0001778279410038923f, 0.0001333521432163324f};

__device__ __forceinline__ float bf2f(bf16 b) { return __uint_as_float(((unsigned)b) << 16); }
__device__ __forceinline__ bf16 f2bf(float f) { unsigned u = __float_as_uint(f); u += 0x7fffu + ((u >> 16) & 1u); return (bf16)(u >> 16); }
__device__ __forceinline__ float wave_sum(float v) {
#pragma unroll
    for (int o = 1; o < 64; o <<= 1) v += __shfl_xor(v, o);
    return v;
}
__device__ __forceinline__ float sigmoidf_(float x) { return 1.0f / (1.0f + __expf(-x)); }
__device__ __forceinline__ float siluf_(float x) { return x / (1.0f + __expf(-x)); }
__host__ __device__ __forceinline__ int pair_row(int n, int half) { const int j = n % half, hf = n / half; return 256 * (j / 128) + 128 * hf + (j % 128); }

__global__ void k_transpose(const float* __restrict__ W, int K, int N, bf16* __restrict__ Wt, int ldt, int row_off, const float* __restrict__ gain, int half,
                            size_t w_bstride, size_t wt_bstride, int gain_bdiv, int gain_bstride) {
    __shared__ float tile[32][33];
    const int bz = blockIdx.z; W += (size_t)bz * w_bstride; Wt += (size_t)bz * wt_bstride;
    const float* g = gain ? gain + (size_t)(bz / gain_bdiv) * gain_bstride : nullptr;
    const int n0 = blockIdx.x * 32, k0 = blockIdx.y * 32, tx = threadIdx.x, ty = threadIdx.y;
#pragma unroll
    for (int i = 0; i < 4; ++i) { const int k = k0 + ty + 8 * i; tile[ty + 8 * i][tx] = W[(size_t)k * N + n0 + tx] * (g ? g[k] : 1.0f); }
    __syncthreads();
#pragma unroll
    for (int i = 0; i < 4; ++i) { const int n = n0 + ty + 8 * i; const int nr = half ? pair_row(n, half) : n;
        Wt[(size_t)(row_off + nr) * ldt + k0 + tx] = f2bf(tile[tx][ty + 8 * i]); }
}
__global__ void k_router_w(const float* __restrict__ wg, const float* __restrict__ wr, const float* __restrict__ g, float* __restrict__ Wr) {
    const int i = blockIdx.x * blockDim.x + threadIdx.x; if (i >= 2 * D * NRT) return;
    const int c = i % NRT, k = (i / NRT) % D, l = i / (NRT * D);
    const float w = c < NG ? wg[((size_t)l * D + k) * NG + c] : wr[((size_t)l * D + k) * NE + (c - NG)];
    Wr[i] = w * g[l * D + k];
}
__global__ void k_x_prep(const float* __restrict__ x, bf16* __restrict__ xb, float* __restrict__ rstd) {
    const int row = blockIdx.x * 4 + (threadIdx.x >> 6), lane = threadIdx.x & 63;
    const float4* xr = (const float4*)(x + (size_t)row * D); float ss = 0.f;
#pragma unroll
    for (int j = 0; j < 4; ++j) { const float4 v = xr[lane + 64 * j]; ss += v.x * v.x + v.y * v.y + v.z * v.z + v.w * v.w;
        ushort4 o; o.x = f2bf(v.x); o.y = f2bf(v.y); o.z = f2bf(v.z); o.w = f2bf(v.w); ((ushort4*)(xb + (size_t)row * D))[lane + 64 * j] = o; }
    ss = wave_sum(ss); if (lane == 0) rstd[row] = 1.0f / sqrtf(ss * (1.0f / D) + EPS);
}
__device__ __forceinline__ void sincos_d(double a, double& s, double& c) {
    const double TWO_PI = 6.283185307179586476925287, PI = 3.14159265358979323846;
    double k = __builtin_rint(a / TWO_PI); double r = a - k * TWO_PI;
    double q = __builtin_rint(r / (PI * 0.5)); double y = r - q * (PI * 0.5); int qi = ((int)q) & 3;
    const double y2 = y * y;
    double sp = y * (1.0 + y2 * (-1.0 / 6 + y2 * (1.0 / 120 + y2 * (-1.0 / 5040 + y2 * (1.0 / 362880 + y2 * (-1.0 / 39916800 + y2 * (1.0 / 6227020800.0)))))));
    double cp = 1.0 + y2 * (-0.5 + y2 * (1.0 / 24 + y2 * (-1.0 / 720 + y2 * (1.0 / 40320 + y2 * (-1.0 / 3628800 + y2 * (1.0 / 479001600.0 + y2 * (-1.0 / 87178291200.0)))))));
    if (qi == 0) { s = sp; c = cp; } else if (qi == 1) { s = cp; c = -sp; } else if (qi == 2) { s = -sp; c = -cp; } else { s = -cp; c = sp; }
}
__global__ void k_cs(const int* __restrict__ pos, float* __restrict__ cs) {
    const int i = blockIdx.x * blockDim.x + threadIdx.x; if (i >= T * 32) return;
    const int t = i >> 5, f = i & 31; const float ang = (float)pos[t] * INV_FREQ[f];
    double s, c; sincos_d((double)ang, s, c); cs[(size_t)t * 64 + f] = (float)c; cs[(size_t)t * 64 + 32 + f] = (float)s;
}

__global__ void __launch_bounds__(256) k_gemm_ref(const bf16* __restrict__ A, int lda, const bf16* __restrict__ Bt, int ldb, float* __restrict__ C, int ldc, int M, int N, int K,
                                                  const int* __restrict__ idx, int a_shift, const int* __restrict__ cnt, size_t b_estride) {
    const int e = blockIdx.z; const int Meff = cnt ? cnt[e] : M; const int m0 = blockIdx.y * 64; if (m0 >= Meff) return;
    const int n0 = blockIdx.x * 64; const int* il = idx ? idx + (size_t)e * T : nullptr; Bt += (size_t)e * b_estride;
    __shared__ float As[16][65], Bs[16][65];
    const int tid = threadIdx.x, lr = tid >> 2, lk = (tid & 3) * 4, ty = tid >> 4, tx = tid & 15;
    const bool av = (m0 + lr) < Meff; const int ar = av ? (il ? (il[m0 + lr] >> a_shift) : (m0 + lr)) : 0;
    const bf16* ap = A + (size_t)ar * lda + lk; const bf16* bp = Bt + (size_t)(n0 + lr) * ldb + lk;
    float acc[4][4];
#pragma unroll
    for (int i = 0; i < 4; ++i)
#pragma unroll
        for (int j = 0; j < 4; ++j) acc[i][j] = 0.f;
    for (int k0 = 0; k0 < K; k0 += 16) {
        const uint2 a2 = av ? *(const uint2*)(ap + k0) : make_uint2(0u, 0u); const uint2 b2 = *(const uint2*)(bp + k0);
        As[lk + 0][lr] = __uint_as_float(a2.x << 16); As[lk + 1][lr] = __uint_as_float(a2.x & 0xffff0000u); As[lk + 2][lr] = __uint_as_float(a2.y << 16); As[lk + 3][lr] = __uint_as_float(a2.y & 0xffff0000u);
        Bs[lk + 0][lr] = __uint_as_float(b2.x << 16); Bs[lk + 1][lr] = __uint_as_float(b2.x & 0xffff0000u); Bs[lk + 2][lr] = __uint_as_float(b2.y << 16); Bs[lk + 3][lr] = __uint_as_float(b2.y & 0xffff0000u);
        __syncthreads();
#pragma unroll
        for (int kk = 0; kk < 16; ++kk) { float a[4], b[4];
#pragma unroll
            for (int i = 0; i < 4; ++i) { a[i] = As[kk][ty * 4 + i]; b[i] = Bs[kk][tx * 4 + i]; }
#pragma unroll
            for (int i = 0; i < 4; ++i)
#pragma unroll
                for (int j = 0; j < 4; ++j) acc[i][j] = fmaf(a[i], b[j], acc[i][j]); }
        __syncthreads();
    }
#pragma unroll
    for (int i = 0; i < 4; ++i) { const int r = m0 + ty * 4 + i; if (r < Meff) { const int cr = il ? il[r] : r;
        *(float4*)(C + (size_t)cr * ldc + n0 + tx * 4) = make_float4(acc[i][0], acc[i][1], acc[i][2], acc[i][3]); } }
}

__global__ void k_glu_ew(const float* __restrict__ scr, const float* __restrict__ rstd, const float* __restrict__ bias, bf16* __restrict__ U) {
    const size_t i = (size_t)blockIdx.x * blockDim.x + threadIdx.x; const int t = (int)(i >> 10), j = (int)(i & 1023);
    const int pa = 256 * (j >> 7) + (j & 127); const float r = rstd[t];
    const float a = scr[(size_t)t * 2048 + pa] * r + bias[j], g = scr[(size_t)t * 2048 + pa + 128] * r + bias[1024 + j];
    U[i] = f2bf(a * sigmoidf_(g));
}
__global__ void k_conv(const bf16* __restrict__ U, const float* __restrict__ w, const float* __restrict__ b, float* __restrict__ out) {
    const size_t i = (size_t)blockIdx.x * blockDim.x + threadIdx.x; const int t = (int)(i >> 10), c = (int)(i & 1023), s = t & (SEQ - 1);
    float acc = b[c];
#pragma unroll
    for (int j = 0; j < CONVW; ++j) { const int ds = j - (CONVW - 1); if (s + ds >= 0) acc = fmaf(w[j * D + c], bf2f(U[(size_t)(t + ds) * D + c]), acc); }
    out[i] = acc;
}
__global__ void k_ln_silu(const float* __restrict__ in, const float* __restrict__ g, const float* __restrict__ b, bf16* __restrict__ out) {
    const int row = blockIdx.x * 4 + (threadIdx.x >> 6), lane = threadIdx.x & 63;
    const float4* xr = (const float4*)(in + (size_t)row * D); float4 v[4]; float s = 0.f;
#pragma unroll
    for (int j = 0; j < 4; ++j) { v[j] = xr[lane + 64 * j]; s += v[j].x + v[j].y + v[j].z + v[j].w; }
    const float mean = wave_sum(s) * (1.0f / D); float q = 0.f;
#pragma unroll
    for (int j = 0; j < 4; ++j) { v[j].x -= mean; v[j].y -= mean; v[j].z -= mean; v[j].w -= mean; q += v[j].x * v[j].x + v[j].y * v[j].y + v[j].z * v[j].z + v[j].w * v[j].w; }
    const float rs = 1.0f / sqrtf(wave_sum(q) * (1.0f / D) + EPS);
#pragma unroll
    for (int j = 0; j < 4; ++j) { const int c = (lane + 64 * j) * 4; const float4 gg = *(const float4*)(g + c), bb = *(const float4*)(b + c);
        ushort4 o; o.x = f2bf(siluf_(v[j].x * rs * gg.x + bb.x)); o.y = f2bf(siluf_(v[j].y * rs * gg.y + bb.y)); o.z = f2bf(siluf_(v[j].z * rs * gg.z + bb.z)); o.w = f2bf(siluf_(v[j].w * rs * gg.w + bb.w));
        ((ushort4*)(out + (size_t)row * D))[lane + 64 * j] = o; }
}
__global__ void k_addres(const float* __restrict__ base, const float* __restrict__ scr, const float* __restrict__ bias, float* __restrict__ H) {
    const size_t i = (size_t)blockIdx.x * blockDim.x + threadIdx.x; const int c = (int)(i & 1023);
    H[i] = base[i] + scr[i] + (bias ? bias[c] : 0.f);
}
__global__ void k_route(const float* __restrict__ H, const float* __restrict__ Wr, const float* __restrict__ bg, const float* __restrict__ br,
                        bf16* __restrict__ XT, float* __restrict__ RSTD, int* __restrict__ LIST, int* __restrict__ CNT, float* __restrict__ GATE) {
    const int t = blockIdx.x * 4 + (threadIdx.x >> 6), lane = threadIdx.x & 63;
    const float4* xr = (const float4*)(H + (size_t)t * D); float acc[NRT];
#pragma unroll
    for (int c = 0; c < NRT; ++c) acc[c] = 0.f;
    float ss = 0.f;
#pragma unroll
    for (int j = 0; j < 4; ++j) { const float4 v = xr[lane + 64 * j]; ss += v.x * v.x + v.y * v.y + v.z * v.z + v.w * v.w;
        ushort4 o; o.x = f2bf(v.x); o.y = f2bf(v.y); o.z = f2bf(v.z); o.w = f2bf(v.w); ((ushort4*)(XT + (size_t)t * D))[lane + 64 * j] = o;
        const float* w = Wr + (size_t)((lane + 64 * j) * 4) * NRT; const float hv[4] = {v.x, v.y, v.z, v.w};
#pragma unroll
        for (int q = 0; q < 4; ++q)
#pragma unroll
            for (int c = 0; c < NRT; ++c) acc[c] = fmaf(hv[q], w[q * NRT + c], acc[c]); }
    ss = wave_sum(ss);
#pragma unroll
    for (int c = 0; c < NRT; ++c) acc[c] = wave_sum(acc[c]);
    if (lane == 0) {
        const float rs = 1.0f / sqrtf(ss * (1.0f / D) + EPS); RSTD[t] = rs;
        float lg[NG]; int gi = 0; float gm = -3.0e38f;
#pragma unroll
        for (int c = 0; c < NG; ++c) { lg[c] = acc[c] * rs + bg[c]; if (lg[c] > gm) { gm = lg[c]; gi = c; } }
        float gs = 0.f;
#pragma unroll
        for (int c = 0; c < NG; ++c) gs += __expf(lg[c] - gm);
        const float gw = 1.0f / gs;
        float le[EPG]; float em = -3.0e38f;
#pragma unroll
        for (int c = 0; c < EPG; ++c) { float v = 0.f;
#pragma unroll
            for (int g2 = 0; g2 < NG; ++g2) if (g2 == gi) v = acc[NG + g2 * EPG + c] * rs + br[g2 * EPG + c];
            le[c] = v; em = fmaxf(em, v); }
        int i0 = 0; float v0 = -3.0e38f;
#pragma unroll
        for (int c = 0; c < EPG; ++c) if (le[c] > v0) { v0 = le[c]; i0 = c; }
        int i1 = 0; float v1 = -3.0e38f;
#pragma unroll
        for (int c = 0; c < EPG; ++c) if (c != i0 && le[c] > v1) { v1 = le[c]; i1 = c; }
        const float p0 = __expf(v0 - em), p1 = __expf(v1 - em); const float inv = 1.0f / (p0 + p1);
        const int e0 = gi * EPG + i0, e1 = gi * EPG + i1;
        GATE[2 * t] = gw * p0 * inv; GATE[2 * t + 1] = gw * p1 * inv;
        const int s0 = atomicAdd(CNT + e0, 1); LIST[(size_t)e0 * T + s0] = 2 * t;
        const int s1 = atomicAdd(CNT + e1, 1); LIST[(size_t)e1 * T + s1] = 2 * t + 1;
    }
}
__global__ void k_swiglu_ew(const float* __restrict__ scr, const float* __restrict__ rstd, bf16* __restrict__ ACT) {
    const size_t i = (size_t)blockIdx.x * blockDim.x + threadIdx.x; const int r = (int)(i >> 9), j = (int)(i & 511);
    const int pa = 256 * (j >> 7) + (j & 127); const float rs = rstd[r >> 1];
    const float a = scr[(size_t)r * 1024 + pa] * rs, b = scr[(size_t)r * 1024 + pa + 128] * rs;
    ACT[i] = f2bf(siluf_(a) * b);
}
__global__ void k_scale_ew(const float* __restrict__ scr, const float* __restrict__ gate, bf16* __restrict__ Y) {
    const size_t i = (size_t)blockIdx.x * blockDim.x + threadIdx.x; const int r = (int)(i >> 10);
    Y[i] = f2bf(scr[i] * gate[r]);
}
__global__ void k_combine(float* __restrict__ H, const bf16* __restrict__ Y, bf16* __restrict__ HB, float* __restrict__ RSTD2) {
    const int t = blockIdx.x * 4 + (threadIdx.x >> 6), lane = threadIdx.x & 63;
    float4* hr = (float4*)(H + (size_t)t * D); const ushort4* y0 = (const ushort4*)(Y + (size_t)(2 * t) * D); const ushort4* y1 = (const ushort4*)(Y + (size_t)(2 * t + 1) * D);
    float ss = 0.f;
#pragma unroll
    for (int j = 0; j < 4; ++j) { float4 v = hr[lane + 64 * j]; const ushort4 a = y0[lane + 64 * j], b = y1[lane + 64 * j];
        v.x += bf2f(a.x) + bf2f(b.x); v.y += bf2f(a.y) + bf2f(b.y); v.z += bf2f(a.z) + bf2f(b.z); v.w += bf2f(a.w) + bf2f(b.w);
        hr[lane + 64 * j] = v; ss += v.x * v.x + v.y * v.y + v.z * v.z + v.w * v.w;
        if (HB) { ushort4 o; o.x = f2bf(v.x); o.y = f2bf(v.y); o.z = f2bf(v.z); o.w = f2bf(v.w); ((ushort4*)(HB + (size_t)t * D))[lane + 64 * j] = o; } }
    if (RSTD2) { ss = wave_sum(ss); if (lane == 0) RSTD2[t] = 1.0f / sqrtf(ss * (1.0f / D) + EPS); }
}
__global__ void k_cl_ew(const float* __restrict__ scr, const float* __restrict__ rstd2, bf16* __restrict__ CL, float* __restrict__ SSP) {
    const int i = blockIdx.x * blockDim.x + threadIdx.x; const int t = i / 24, g = i % 24; const float rs = rstd2[t]; float ss = 0.f;
    for (int c = 0; c < 32; ++c) { const float v = scr[(size_t)t * NCL + g * 32 + c] * rs; ss += v * v; CL[(size_t)t * NCL + g * 32 + c] = f2bf(v); }
    SSP[i] = ss;
}
__global__ void k_q_ew(const float* __restrict__ scr, const float* __restrict__ SSP, bf16* __restrict__ QRAW, float* __restrict__ SSQ) {
    const int i = blockIdx.x * blockDim.x + threadIdx.x; const int t = i / 48, g = i % 48; float s = 0.f;
    for (int k = 10; k < 22; ++k) s += SSP[t * 24 + k];
    const float rs = 1.0f / sqrtf(s * (1.0f / QLR) + EPS); float ss = 0.f;
    for (int c = 0; c < 32; ++c) { const float v = scr[(size_t)t * 1536 + g * 32 + c] * rs; ss += v * v; QRAW[(size_t)t * 1536 + g * 32 + c] = f2bf(v); }
    SSQ[i] = ss;
}
__global__ void k_kv_ew(const float* __restrict__ scr, const float* __restrict__ SSP, bf16* __restrict__ KN, bf16* __restrict__ VV, float* __restrict__ SSK) {
    const int i = blockIdx.x * blockDim.x + threadIdx.x; const int t = i / 64, g = i % 64; float s = 0.f;
    for (int k = 0; k < 8; ++k) s += SSP[t * 24 + k];
    const float rs = 1.0f / sqrtf(s * (1.0f / KVR) + EPS); const int h = g >> 3, gi = g & 7; const int b = t / SEQ, sq = t % SEQ; float ss = 0.f;
    for (int c = 0; c < 32; ++c) { const float v = scr[(size_t)t * 2048 + g * 32 + c] * rs;
        if (gi < 4) { ss += v * v; KN[(size_t)t * 1024 + h * 128 + gi * 32 + c] = f2bf(v); }
        else VV[(((size_t)b * NH + h) * SEQ + sq) * DV + (gi - 4) * 32 + c] = f2bf(v); }
    if (gi < 4) SSK[t * 32 + h * 4 + gi] = ss;
}
__global__ void k_kfin(const bf16* __restrict__ KN, const bf16* __restrict__ CL, const float* __restrict__ SSK, const float* __restrict__ SSP, const float* __restrict__ kg,
                       const float* __restrict__ cs, bf16* __restrict__ KK) {
    const int i = blockIdx.x * blockDim.x + threadIdx.x; const int t = i >> 3, h = i & 7; const int b = t / SEQ, sq = t % SEQ;
    const float ss = SSK[t * 32 + h * 4] + SSK[t * 32 + h * 4 + 1] + SSK[t * 32 + h * 4 + 2] + SSK[t * 32 + h * 4 + 3] + SSP[t * 24 + 8] + SSP[t * 24 + 9];
    const float rk = 1.0f / sqrtf(ss * (1.0f / DQK) + EPS);
    bf16* o = KK + (((size_t)b * NH + h) * SEQ + sq) * DQK;
    for (int j = 0; j < DNOPE; ++j) o[j] = f2bf(bf2f(KN[(size_t)t * 1024 + h * 128 + j]) * rk * kg[j]);
    for (int j = 0; j < 32; ++j) { const float x1 = bf2f(CL[(size_t)t * NCL + 256 + j]) * rk * kg[128 + j], x2 = bf2f(CL[(size_t)t * NCL + 288 + j]) * rk * kg[160 + j];
        const float c = cs[(size_t)t * 64 + j], s = cs[(size_t)t * 64 + 32 + j];
        o[128 + j] = f2bf(x1 * c - x2 * s); o[160 + j] = f2bf(x1 * s + x2 * c); }
}
constexpr int ATT_REF_LDS = (64 * 193 + 32 * 193 + 32 * 128 + 64 * 33 + 64 * 2) * 4;
__global__ void __launch_bounds__(256) k_attn_ref(const bf16* __restrict__ QRAW, const float* __restrict__ SSQ, const float* __restrict__ qg, const float* __restrict__ cs,
                                                  const bf16* __restrict__ KK, const bf16* __restrict__ VV, bf16* __restrict__ O) {
    extern __shared__ float sm[];
    float* Qs = sm; float* Ks = Qs + 64 * 193; float* Vs = Ks + 32 * 193; float* Ps = Vs + 32 * 128; float* al = Ps + 64 * 33; float* ls = al + 64;
    const int c = (gridDim.x - 1) - blockIdx.x, bh = blockIdx.y, b = bh / NH, h = bh % NH, tid = threadIdx.x;
    { const int q = tid >> 2, part = tid & 3; const int t = b * SEQ + c * 64 + q; float s = 0.f;
      for (int k = 0; k < 6; ++k) s += SSQ[t * 48 + h * 6 + k];
      const float rq = (1.0f / sqrtf(s * (1.0f / DQK) + EPS)) * SM_SCALE; const bf16* qr = QRAW + (size_t)t * 1536 + h * DQK;
      if (part < 2) { for (int j = part * 64; j < part * 64 + 64; ++j) Qs[q * 193 + j] = bf2f(qr[j]) * rq * qg[j]; }
      else if (part == 2) { for (int j = 0; j < 32; ++j) { const float x1 = bf2f(qr[128 + j]) * rq * qg[128 + j], x2 = bf2f(qr[160 + j]) * rq * qg[160 + j];
          const float cc = cs[(size_t)t * 64 + j], ss2 = cs[(size_t)t * 64 + 32 + j]; Qs[q * 193 + 128 + j] = x1 * cc - x2 * ss2; Qs[q * 193 + 160 + j] = x1 * ss2 + x2 * cc; } } }
    float m_run = -1e30f, l_run = 0.f;
    float acc[4][8];
#pragma unroll
    for (int i = 0; i < 4; ++i)
#pragma unroll
        for (int j = 0; j < 8; ++j) acc[i][j] = 0.f;
    const int tq = tid >> 4, tk = tid & 15;
    const bf16* Kb = KK + (size_t)bh * SEQ * DQK; const bf16* Vb = VV + (size_t)bh * SEQ * DV;
    const int ntiles = (c + 1) * 2;
    __syncthreads();
    for (int kt = 0; kt < ntiles; ++kt) {
        const int key0 = kt * 32;
        for (int i = tid; i < 32 * 192; i += 256) { const int kk = i / 192, dd = i % 192; Ks[kk * 193 + dd] = bf2f(Kb[(size_t)(key0 + kk) * DQK + dd]); }
        for (int i = tid; i < 32 * 128; i += 256) Vs[i] = bf2f(Vb[(size_t)key0 * DV + i]);
        __syncthreads();
        float s[4][2];
#pragma unroll
        for (int i = 0; i < 4; ++i) { s[i][0] = 0.f; s[i][1] = 0.f; }
        for (int d = 0; d < DQK; ++d) { const float k0 = Ks[(tk * 2) * 193 + d], k1 = Ks[(tk * 2 + 1) * 193 + d];
#pragma unroll
            for (int i = 0; i < 4; ++i) { const float qv = Qs[(tq * 4 + i) * 193 + d]; s[i][0] = fmaf(qv, k0, s[i][0]); s[i][1] = fmaf(qv, k1, s[i][1]); } }
#pragma unroll
        for (int i = 0; i < 4; ++i) { Ps[(tq * 4 + i) * 33 + tk * 2] = s[i][0]; Ps[(tq * 4 + i) * 33 + tk * 2 + 1] = s[i][1]; }
        __syncthreads();
        if (tid < 64) { float mx = m_run; for (int k = 0; k < 32; ++k) mx = fmaxf(mx, Ps[tid * 33 + k]);
            float sum = 0.f; for (int k = 0; k < 32; ++k) { const float p = __expf(Ps[tid * 33 + k] - mx); Ps[tid * 33 + k] = p; sum += p; }
            const float a = __expf(m_run - mx); al[tid] = a; l_run = l_run * a + sum; m_run = mx; }
        __syncthreads();
#pragma unroll
        for (int i = 0; i < 4; ++i) { const float a = al[tq * 4 + i];
#pragma unroll
            for (int j = 0; j < 8; ++j) acc[i][j] *= a; }
        for (int k = 0; k < 32; ++k) { float v[8];
#pragma unroll
            for (int j = 0; j < 8; ++j) v[j] = Vs[k * 128 + tk * 8 + j];
#pragma unroll
            for (int i = 0; i < 4; ++i) { const float p = Ps[(tq * 4 + i) * 33 + k];
#pragma unroll
                for (int j = 0; j < 8; ++j) acc[i][j] = fmaf(p, v[j], acc[i][j]); } }
        __syncthreads();
    }
    if (tid < 64) ls[tid] = l_run;
    __syncthreads();
#pragma unroll
    for (int i = 0; i < 4; ++i) { const int q = tq * 4 + i; const float inv = 1.0f / ls[q]; const int t = b * SEQ + c * 64 + q;
#pragma unroll
        for (int j = 0; j < 8; ++j) O[(size_t)t * D + h * DV + tk * 8 + j] = f2bf(acc[i][j] * inv); }
}

static inline void gemm_ref(hipStream_t st, const bf16* A, int lda, const bf16* Bt, int ldb, float* C, int ldc, int M, int N, int K) {
    hipLaunchKernelGGL(k_gemm_ref, dim3(N / 64, M / 64, 1), dim3(256), 0, st, A, lda, Bt, ldb, C, ldc, M, N, K, (const int*)nullptr, 0, (const int*)nullptr, (size_t)0);
}
extern "C" void kernel_launch(void* const* d_in, const int* in_sizes, int n_in, void* d_out, int out_size, void* d_ws, size_t ws_size, hipStream_t stream) {
    if (n_in != 30 || ws_size < WS_END || out_size != T * D) { fprintf(stderr, "kernel_launch: unexpected shapes (n_in %d, ws %zu, out %d)\n", n_in, ws_size, out_size); return; }
    static bool attr = false;
    if (!attr) { attr = true; (void)hipFuncSetAttribute((const void*)k_attn_ref, hipFuncAttributeMaxDynamicSharedMemorySize, ATT_REF_LDS); }
    const float* x = (const float*)d_in[0]; const int* positions = (const int*)d_in[1];
    const float *a_norm_g = (const float*)d_in[2], *a_pw1_w = (const float*)d_in[3], *a_pw1_b = (const float*)d_in[4], *a_dw_w = (const float*)d_in[5], *a_dw_b = (const float*)d_in[6],
                *a_ln_g = (const float*)d_in[7], *a_ln_b = (const float*)d_in[8], *a_pw2_w = (const float*)d_in[9], *a_pw2_b = (const float*)d_in[10],
                *kv_norm_g = (const float*)d_in[11], *w_dkv = (const float*)d_in[12], *kv_latent_g = (const float*)d_in[13], *w_kr = (const float*)d_in[14], *w_ukv = (const float*)d_in[15],
                *k_norm_g = (const float*)d_in[16], *b_norm_g = (const float*)d_in[17], *w_dq = (const float*)d_in[18], *q_latent_g = (const float*)d_in[19], *w_uq = (const float*)d_in[20],
                *q_norm_g = (const float*)d_in[21], *w_o = (const float*)d_in[22], *ffn_norm_g = (const float*)d_in[23], *w_group = (const float*)d_in[24], *b_group = (const float*)d_in[25],
                *w_router = (const float*)d_in[26], *b_router = (const float*)d_in[27], *w_gate_up = (const float*)d_in[28], *w_down = (const float*)d_in[29];
    char* ws = (char*)d_ws; float* H = (float*)d_out;
    bf16 *W1t = (bf16*)(ws + WS_W1T), *W2t = (bf16*)(ws + WS_W2T), *Wc = (bf16*)(ws + WS_WC), *Wukv = (bf16*)(ws + WS_WUKV), *Wuq = (bf16*)(ws + WS_WUQ), *Wo = (bf16*)(ws + WS_WO),
         *Wgu = (bf16*)(ws + WS_WGU), *Wd = (bf16*)(ws + WS_WD);
    float *Wr = (float*)(ws + WS_WR), *RSTD0 = (float*)(ws + WS_RSTD0), *RSTD = (float*)(ws + WS_RSTD), *RSTD2 = (float*)(ws + WS_RSTD2), *GATE = (float*)(ws + WS_GATE),
          *CS = (float*)(ws + WS_CS), *SSP = (float*)(ws + WS_SSP), *SSQ = (float*)(ws + WS_SSQ), *SSK = (float*)(ws + WS_SSK), *SCR = (float*)(ws + WS_SCR);
    int *CNT = (int*)(ws + WS_CTL), *LIST = (int*)(ws + WS_LIST);
    bf16 *XB = (bf16*)(ws + WS_R1), *XT = XB, *HB = XB, *U = (bf16*)(ws + WS_R2), *ACT = U, *O = U, *Vb = (bf16*)(ws + WS_R3), *Y = Vb, *KN = Vb, *VV = (bf16*)(ws + WS_R3 + 64 * MiB),
         *CL = (bf16*)(ws + WS_CL), *QRAW = (bf16*)(ws + WS_QRAW), *KK = (bf16*)(ws + WS_KK);

    (void)hipMemsetAsync(ws + WS_CTL, 0, 4096, stream);
    (void)hipMemsetAsync(ws + WS_WC + (size_t)704 * D * 2, 0, (size_t)64 * D * 2, stream);
    const dim3 tb(32, 8);
    hipLaunchKernelGGL(k_transpose, dim3(2048 / 32, D / 32, 1), tb, 0, stream, a_pw1_w, D, 2048, W1t, D, 0, a_norm_g, 1024, (size_t)0, (size_t)0, 1, 0);
    hipLaunchKernelGGL(k_transpose, dim3(D / 32, D / 32, 1), tb, 0, stream, a_pw2_w, D, D, W2t, D, 0, (const float*)nullptr, 0, (size_t)0, (size_t)0, 1, 0);
    hipLaunchKernelGGL(k_transpose, dim3(KVR / 32, D / 32, 1), tb, 0, stream, w_dkv, D, KVR, Wc, D, 0, kv_norm_g, 0, (size_t)0, (size_t)0, 1, 0);
    hipLaunchKernelGGL(k_transpose, dim3(DROPE / 32, D / 32, 1), tb, 0, stream, w_kr, D, DROPE, Wc, D, 256, kv_norm_g, 0, (size_t)0, (size_t)0, 1, 0);
    hipLaunchKernelGGL(k_transpose, dim3(QLR / 32, D / 32, 1), tb, 0, stream, w_dq, D, QLR, Wc, D, 320, b_norm_g, 0, (size_t)0, (size_t)0, 1, 0);
    hipLaunchKernelGGL(k_transpose, dim3(2048 / 32, KVR / 32, 1), tb, 0, stream, w_ukv, KVR, 2048, Wukv, KVR, 0, kv_latent_g, 0, (size_t)0, (size_t)0, 1, 0);
    hipLaunchKernelGGL(k_transpose, dim3(1536 / 32, QLR / 32, 1), tb, 0, stream, w_uq, QLR, 1536, Wuq, QLR, 0, q_latent_g, 0, (size_t)0, (size_t)0, 1, 0);
    hipLaunchKernelGGL(k_transpose, dim3(D / 32, D / 32, 1), tb, 0, stream, w_o, D, D, Wo, D, 0, (const float*)nullptr, 0, (size_t)0, (size_t)0, 1, 0);
    hipLaunchKernelGGL(k_transpose, dim3(1024 / 32, D / 32, 2 * NE), tb, 0, stream, w_gate_up, D, 1024, Wgu, D, 0, ffn_norm_g, 512, (size_t)D * 1024, (size_t)1024 * D, NE, D);
    hipLaunchKernelGGL(k_transpose, dim3(D / 32, DE / 32, 2 * NE), tb, 0, stream, w_down, DE, D, Wd, DE, 0, (const float*)nullptr, 0, (size_t)DE * D, (size_t)D * DE, 1, 0);
    hipLaunchKernelGGL(k_router_w, dim3((2 * D * NRT + 255) / 256), dim3(256), 0, stream, w_group, w_router, ffn_norm_g, Wr);
    hipLaunchKernelGGL(k_x_prep, dim3(T / 4), dim3(256), 0, stream, x, XB, RSTD0);
    hipLaunchKernelGGL(k_cs, dim3(T * 32 / 256), dim3(256), 0, stream, positions, CS);
    gemm_ref(stream, XB, D, W1t, D, SCR, 2048, T, 2048, D);
    hipLaunchKernelGGL(k_glu_ew, dim3(T * 1024 / 256), dim3(256), 0, stream, SCR, RSTD0, a_pw1_b, U);
    hipLaunchKernelGGL(k_conv, dim3(T * 1024 / 256), dim3(256), 0, stream, U, a_dw_w, a_dw_b, SCR);
    hipLaunchKernelGGL(k_ln_silu, dim3(T / 4), dim3(256), 0, stream, SCR, a_ln_g, a_ln_b, Vb);
    gemm_ref(stream, Vb, D, W2t, D, SCR, D, T, D, D);
    hipLaunchKernelGGL(k_addres, dim3(T * 1024 / 256), dim3(256), 0, stream, x, SCR, a_pw2_b, H);
    for (int l = 0; l < 2; ++l) {
        if (l == 1) {
            gemm_ref(stream, HB, D, Wc, D, SCR, NCL, T, NCL, D);
            hipLaunchKernelGGL(k_cl_ew, dim3(T * 24 / 256), dim3(256), 0, stream, SCR, RSTD2, CL, SSP);
            gemm_ref(stream, CL + 320, NCL, Wuq, QLR, SCR, 1536, T, 1536, QLR);
            hipLaunchKernelGGL(k_q_ew, dim3(T * 48 / 256), dim3(256), 0, stream, SCR, SSP, QRAW, SSQ);
            gemm_ref(stream, CL, NCL, Wukv, KVR, SCR, 2048, T, 2048, KVR);
            hipLaunchKernelGGL(k_kv_ew, dim3(T * 64 / 256), dim3(256), 0, stream, SCR, SSP, KN, VV, SSK);
            hipLaunchKernelGGL(k_kfin, dim3(T * 8 / 256), dim3(256), 0, stream, KN, CL, SSK, SSP, k_norm_g, CS, KK);
            hipLaunchKernelGGL(k_attn_ref, dim3(SEQ / 64, NB * NH), dim3(256), ATT_REF_LDS, stream, QRAW, SSQ, q_norm_g, CS, KK, VV, O);
            gemm_ref(stream, O, D, Wo, D, SCR, D, T, D, D);
            hipLaunchKernelGGL(k_addres, dim3(T * 1024 / 256), dim3(256), 0, stream, H, SCR, (const float*)nullptr, H);
        }
        hipLaunchKernelGGL(k_route, dim3(T / 4), dim3(256), 0, stream, H, Wr + (size_t)l * D * NRT, b_group + l * NG, b_router + l * NE, XT, RSTD, LIST, CNT + l * NE, GATE);
        hipLaunchKernelGGL(k_gemm_ref, dim3(1024 / 64, T / 64, NE), dim3(256), 0, stream, XT, D, Wgu + (size_t)l * NE * 1024 * D, D, SCR, 1024, T, 1024, D, LIST, 1, CNT + l * NE, (size_t)1024 * D);
        hipLaunchKernelGGL(k_swiglu_ew, dim3(2 * T * 512 / 256), dim3(256), 0, stream, SCR, RSTD, ACT);
        hipLaunchKernelGGL(k_gemm_ref, dim3(D / 64, T / 64, NE), dim3(256), 0, stream, ACT, DE, Wd + (size_t)l * NE * D * DE, DE, SCR, D, T, D, DE, LIST, 0, CNT + l * NE, (size_t)D * DE);
        hipLaunchKernelGGL(k_scale_ew, dim3(2 * T * 1024 / 256), dim3(256), 0, stream, SCR, GATE, Y);
        hipLaunchKernelGGL(k_combine, dim3(T / 4), dim3(256), 0, stream, H, Y, l == 0 ? HB : (bf16*)nullptr, l == 0 ? RSTD2 : (float*)nullptr);
    }
}
```

```cpp
#include <hip/hip_runtime.h>
#include <stdint.h>
#include <stdio.h>

typedef unsigned short bf16;
constexpr int NB = 4, SEQ = 8192, T = NB * SEQ, D = 1024, NH = 8, DQK = 192, DNOPE = 128, DROPE = 64, DV = 128, KVR = 256, QLR = 384;
constexpr int NE = 32, NG = 4, EPG = 8, DE = 512, CONVW = 31, NCL = 768, NRT = 36;
constexpr float EPS = 1e-6f;
constexpr float SM_SCALE = 0.07216878364870322f;

constexpr size_t MiB = 1u << 20;
constexpr size_t WS_CTL = 0, WS_W1T = 1 * MiB, WS_W2T = 5 * MiB, WS_WC = 7 * MiB, WS_WUKV = 9 * MiB, WS_WUQ = 10 * MiB, WS_WO = 12 * MiB, WS_WR = 14 * MiB,
                 WS_WGU = 16 * MiB, WS_WD = 144 * MiB, WS_RSTD0 = 208 * MiB, WS_RSTD = WS_RSTD0 + 256 * 1024, WS_RSTD2 = WS_RSTD0 + 512 * 1024,
                 WS_GATE = 209 * MiB, WS_LIST = 210 * MiB, WS_CS = 214 * MiB, WS_SSP = 222 * MiB, WS_SSQ = 226 * MiB, WS_SSK = 232 * MiB,
                 WS_R1 = 236 * MiB, WS_R2 = 300 * MiB, WS_R3 = 364 * MiB, WS_CL = 492 * MiB, WS_QRAW = 540 * MiB, WS_KK = 636 * MiB, WS_SCR = 732 * MiB, WS_END = 988 * MiB;

__device__ const float INV_FREQ[32] = {
    1.0f, 0.7498942093324559f, 0.5623413251903491f, 0.4216965034285822f, 0.31622776601683794f, 0.23713737056616552f, 0.1778279410038923f, 0.1333521432163324f,
    0.1f, 0.07498942093324558f, 0.05623413251903491f, 0.04216965034285822f, 0.03162277660168379f, 0.023713737056616554f, 0.01778279410038923f, 0.01333521432163324f,
    0.01f, 0.007498942093324558f, 0.005623413251903491f, 0.004216965034285823f, 0.0031622776601683794f, 0.0023713737056616554f, 0.001778279410038923f, 0.001333521432163324f,
    0.001f, 0.0007498942093324559f, 0.0005623413251903491f, 0.00042169650342858224f, 0.00031622776601683794f, 0.00023713737056616554f, 0.0001778279410038923f, 0.0001333521432163324f};

__device__ __forceinline__ float bf2f(bf16 b) { return __uint_as_float(((unsigned)b) << 16); }
__device__ __forceinline__ bf16 f2bf(float f) { unsigned u = __float_as_uint(f); u += 0x7fffu + ((u >> 16) & 1u); return (bf16)(u >> 16); }
__device__ __forceinline__ float wave_sum(float v) {
#pragma unroll
    for (int o = 1; o < 64; o <<= 1) v += __shfl_xor(v, o);
    return v;
}
__device__ __forceinline__ float sigmoidf_(float x) { return 1.0f / (1.0f + __expf(-x)); }
__device__ __forceinline__ float siluf_(float x) { return x / (1.0f + __expf(-x)); }
__host__ __device__ __forceinline__ int pair_row(int n, int half) { const int j = n % half, hf = n / half; return 256 * (j / 128) + 128 * hf + (j % 128); }

__global__ void k_transpose(const float* __restrict__ W, int K, int N, bf16* __restrict__ Wt, int ldt, int row_off, const float* __restrict__ gain, int half,
                            size_t w_bstride, size_t wt_bstride, int gain_bdiv, int gain_bstride) {
    __shared__ float tile[32][33];
    const int bz = blockIdx.z; W += (size_t)bz * w_bstride; Wt += (size_t)bz * wt_bstride;
    const float* g = gain ? gain + (size_t)(bz / gain_bdiv) * gain_bstride : nullptr;
    const int n0 = blockIdx.x * 32, k0 = blockIdx.y * 32, tx = threadIdx.x, ty = threadIdx.y;
#pragma unroll
    for (int i = 0; i < 4; ++i) { const int k = k0 + ty + 8 * i; tile[ty + 8 * i][tx] = W[(size_t)k * N + n0 + tx] * (g ? g[k] : 1.0f); }
    __syncthreads();
#pragma unroll
    for (int i = 0; i < 4; ++i) { const int n = n0 + ty + 8 * i; const int nr = half ? pair_row(n, half) : n;
        Wt[(size_t)(row_off + nr) * ldt + k0 + tx] = f2bf(tile[tx][ty + 8 * i]); }
}
__global__ void k_router_w(const float* __restrict__ wg, const float* __restrict__ wr, const float* __restrict__ g, float* __restrict__ Wr) {
    const int i = blockIdx.x * blockDim.x + threadIdx.x; if (i >= 2 * D * NRT) return;
    const int c = i % NRT, k = (i / NRT) % D, l = i / (NRT * D);
    const float w = c < NG ? wg[((size_t)l * D + k) * NG + c] : wr[((size_t)l * D + k) * NE + (c - NG)];
    Wr[i] = w * g[l * D + k];
}
__global__ void k_x_prep(const float* __restrict__ x, bf16* __restrict__ xb, float* __restrict__ rstd) {
    const int row = blockIdx.x * 4 + (threadIdx.x >> 6), lane = threadIdx.x & 63;
    const float4* xr = (const float4*)(x + (size_t)row * D); float ss = 0.f;
#pragma unroll
    for (int j = 0; j < 4; ++j) { const float4 v = xr[lane + 64 * j]; ss += v.x * v.x + v.y * v.y + v.z * v.z + v.w * v.w;
        ushort4 o; o.x = f2bf(v.x); o.y = f2bf(v.y); o.z = f2bf(v.z); o.w = f2bf(v.w); ((ushort4*)(xb + (size_t)row * D))[lane + 64 * j] = o; }
    ss = wave_sum(ss); if (lane == 0) rstd[row] = 1.0f / sqrtf(ss * (1.0f / D) + EPS);
}
__device__ __forceinline__ void sincos_d(double a, double& s, double& c) {
    const double TWO_PI = 6.283185307179586476925287, PI = 3.14159265358979323846;
    double k = __builtin_rint(a / TWO_PI); double r = a - k * TWO_PI;
    double q = __builtin_rint(r / (PI * 0.5)); double y = r - q * (PI * 0.5); int qi = ((int)q) & 3;
    const double y2 = y * y;
    double sp = y * (1.0 + y2 * (-1.0 / 6 + y2 * (1.0 / 120 + y2 * (-1.0 / 5040 + y2 * (1.0 / 362880 + y2 * (-1.0 / 39916800 + y2 * (1.0 / 6227020800.0)))))));
    double cp = 1.0 + y2 * (-0.5 + y2 * (1.0 / 24 + y2 * (-1.0 / 720 + y2 * (1.0 / 40320 + y2 * (-1.0 / 3628800 + y2 * (1.0 / 479001600.0 + y2 * (-1.0 / 87178291200.0)))))));
    if (qi == 0) { s = sp; c = cp; } else if (qi == 1) { s = cp; c = -sp; } else if (qi == 2) { s = -sp; c = -cp; } else { s = -cp; c = sp; }
}
__global__ void k_cs(const int* __restrict__ pos, float* __restrict__ cs) {
    const int i = blockIdx.x * blockDim.x + threadIdx.x; if (i >= T * 32) return;
    const int t = i >> 5, f = i & 31; const float ang = (float)pos[t] * INV_FREQ[f];
    double s, c; sincos_d((double)ang, s, c); cs[(size_t)t * 64 + f] = (float)c; cs[(size_t)t * 64 + 32 + f] = (float)s;
}

__global__ void __launch_bounds__(256) k_gemm_ref(const bf16* __restrict__ A, int lda, const bf16* __restrict__ Bt, int ldb, float* __restrict__ C, int ldc, int M, int N, int K,
                                                  const int* __restrict__ idx, int a_shift, const int* __restrict__ cnt, size_t b_estride) {
    const int e = blockIdx.z; const int Meff = cnt ? cnt[e] : M; const int m0 = blockIdx.y * 64; if (m0 >= Meff) return;
    const int n0 = blockIdx.x * 64; const int* il = idx ? idx + (size_t)e * T : nullptr; Bt += (size_t)e * b_estride;
    __shared__ float As[16][65], Bs[16][65];
    const int tid = threadIdx.x, lr = tid >> 2, lk = (tid & 3) * 4, ty = tid >> 4, tx = tid & 15;
    const bool av = (m0 + lr) < Meff; const int ar = av ? (il ? (il[m0 + lr] >> a_shift) : (m0 + lr)) : 0;
    const bf16* ap = A + (size_t)ar * lda + lk; const bf16* bp = Bt + (size_t)(n0 + lr) * ldb + lk;
    float acc[4][4];
#pragma unroll
    for (int i = 0; i < 4; ++i)
#pragma unroll
        for (int j = 0; j < 4; ++j) acc[i][j] = 0.f;
    for (int k0 = 0; k0 < K; k0 += 16) {
        const uint2 a2 = av ? *(const uint2*)(ap + k0) : make_uint2(0u, 0u); const uint2 b2 = *(const uint2*)(bp + k0);
        As[lk + 0][lr] = __uint_as_float(a2.x << 16); As[lk + 1][lr] = __uint_as_float(a2.x & 0xffff0000u); As[lk + 2][lr] = __uint_as_float(a2.y << 16); As[lk + 3][lr] = __uint_as_float(a2.y & 0xffff0000u);
        Bs[lk + 0][lr] = __uint_as_float(b2.x << 16); Bs[lk + 1][lr] = __uint_as_float(b2.x & 0xffff0000u); Bs[lk + 2][lr] = __uint_as_float(b2.y << 16); Bs[lk + 3][lr] = __uint_as_float(b2.y & 0xffff0000u);
        __syncthreads();
#pragma unroll
        for (int kk = 0; kk < 16; ++kk) { float a[4], b[4];
#pragma unroll
            for (int i = 0; i < 4; ++i) { a[i] = As[kk][ty * 4 + i]; b[i] = Bs[kk][tx * 4 + i]; }
#pragma unroll
            for (int i = 0; i < 4; ++i)
#pragma unroll
                for (int j = 0; j < 4; ++j) acc[i][j] = fmaf(a[i], b[j], acc[i][j]); }
        __syncthreads();
    }
#pragma unroll
    for (int i = 0; i < 4; ++i) { const int r = m0 + ty * 4 + i; if (r < Meff) { const int cr = il ? il[r] : r;
        *(float4*)(C + (size_t)cr * ldc + n0 + tx * 4) = make_float4(acc[i][0], acc[i][1], acc[i][2], acc[i][3]); } }
}

__global__ void k_glu_ew(const float* __restrict__ scr, const float* __restrict__ rstd, const float* __restrict__ bias, bf16* __restrict__ U) {
    const size_t i = (size_t)blockIdx.x * blockDim.x + threadIdx.x; const int t = (int)(i >> 10), j = (int)(i & 1023);
    const int pa = 256 * (j >> 7) + (j & 127); const float r = rstd[t];
    const float a = scr[(size_t)t * 2048 + pa] * r + bias[j], g = scr[(size_t)t * 2048 + pa + 128] * r + bias[1024 + j];
    U[i] = f2bf(a * sigmoidf_(g));
}
__global__ void k_conv(const bf16* __restrict__ U, const float* __restrict__ w, const float* __restrict__ b, float* __restrict__ out) {
    const size_t i = (size_t)blockIdx.x * blockDim.x + threadIdx.x; const int t = (int)(i >> 10), c = (int)(i & 1023), s = t & (SEQ - 1);
    float acc = b[c];
#pragma unroll
    for (int j = 0; j < CONVW; ++j) { const int ds = j - (CONVW - 1); if (s + ds >= 0) acc = fmaf(w[j * D + c], bf2f(U[(size_t)(t + ds) * D + c]), acc); }
    out[i] = acc;
}
__global__ void k_ln_silu(const float* __restrict__ in, const float* __restrict__ g, const float* __restrict__ b, bf16* __restrict__ out) {
    const int row = blockIdx.x * 4 + (threadIdx.x >> 6), lane = threadIdx.x & 63;
    const float4* xr = (const float4*)(in + (size_t)row * D); float4 v[4]; float s = 0.f;
#pragma unroll
    for (int j = 0; j < 4; ++j) { v[j] = xr[lane + 64 * j]; s += v[j].x + v[j].y + v[j].z + v[j].w; }
    const float mean = wave_sum(s) * (1.0f / D); float q = 0.f;
#pragma unroll
    for (int j = 0; j < 4; ++j) { v[j].x -= mean; v[j].y -= mean; v[j].z -= mean; v[j].w -= mean; q += v[j].x * v[j].x + v[j].y * v[j].y + v[j].z * v[j].z + v[j].w * v[j].w; }
    const float rs = 1.0f / sqrtf(wave_sum(q) * (1.0f / D) + EPS);
#pragma unroll
    for (int j = 0; j < 4; ++j) { const int c = (lane + 64 * j) * 4; const float4 gg = *(const float4*)(g + c), bb = *(const float4*)(b + c);
        ushort4 o; o.x = f2bf(siluf_(v[j].x * rs * gg.x + bb.x)); o.y = f2bf(siluf_(v[j].y * rs * gg.y + bb.y)); o.z = f2bf(siluf_(v[j].z * rs * gg.z + bb.z)); o.w = f2bf(siluf_(v[j].w * rs * gg.w + bb.w));
        ((ushort4*)(out + (size_t)row * D))[lane + 64 * j] = o; }
}
__global__ void k_addres(const float* __restrict__ base, const float* __restrict__ scr, const float* __restrict__ bias, float* __restrict__ H) {
    const size_t i = (size_t)blockIdx.x * blockDim.x + threadIdx.x; const int c = (int)(i & 1023);
    H[i] = base[i] + scr[i] + (bias ? bias[c] : 0.f);
}
__global__ void k_route(const float* __restrict__ H, const float* __restrict__ Wr, const float* __restrict__ bg, const float* __restrict__ br,
                        bf16* __restrict__ XT, float* __restrict__ RSTD, int* __restrict__ LIST, int* __restrict__ CNT, float* __restrict__ GATE) {
    const int t = blockIdx.x * 4 + (threadIdx.x >> 6), lane = threadIdx.x & 63;
    const float4* xr = (const float4*)(H + (size_t)t * D); float acc[NRT];
#pragma unroll
    for (int c = 0; c < NRT; ++c) acc[c] = 0.f;
    float ss = 0.f;
#pragma unroll
    for (int j = 0; j < 4; ++j) { const float4 v = xr[lane + 64 * j]; ss += v.x * v.x + v.y * v.y + v.z * v.z + v.w * v.w;
        ushort4 o; o.x = f2bf(v.x); o.y = f2bf(v.y); o.z = f2bf(v.z); o.w = f2bf(v.w); ((ushort4*)(XT + (size_t)t * D))[lane + 64 * j] = o;
        const float* w = Wr + (size_t)((lane + 64 * j) * 4) * NRT; const float hv[4] = {v.x, v.y, v.z, v.w};
#pragma unroll
        for (int q = 0; q < 4; ++q)
#pragma unroll
            for (int c = 0; c < NRT; ++c) acc[c] = fmaf(hv[q], w[q * NRT + c], acc[c]); }
    ss = wave_sum(ss);
#pragma unroll
    for (int c = 0; c < NRT; ++c) acc[c] = wave_sum(acc[c]);
    if (lane == 0) {
        const float rs = 1.0f / sqrtf(ss * (1.0f / D) + EPS); RSTD[t] = rs;
        float lg[NG]; int gi = 0; float gm = -3.0e38f;
#pragma unroll
        for (int c = 0; c < NG; ++c) { lg[c] = acc[c] * rs + bg[c]; if (lg[c] > gm) { gm = lg[c]; gi = c; } }
        float gs = 0.f;
#pragma unroll
        for (int c = 0; c < NG; ++c) gs += __expf(lg[c] - gm);
        const float gw = 1.0f / gs;
        float le[EPG]; float em = -3.0e38f;
#pragma unroll
        for (int c = 0; c < EPG; ++c) { float v = 0.f;
#pragma unroll
            for (int g2 = 0; g2 < NG; ++g2) if (g2 == gi) v = acc[NG + g2 * EPG + c] * rs + br[g2 * EPG + c];
            le[c] = v; em = fmaxf(em, v); }
        int i0 = 0; float v0 = -3.0e38f;
#pragma unroll
        for (int c = 0; c < EPG; ++c) if (le[c] > v0) { v0 = le[c]; i0 = c; }
        int i1 = 0; float v1 = -3.0e38f;
#pragma unroll
        for (int c = 0; c < EPG; ++c) if (c != i0 && le[c] > v1) { v1 = le[c]; i1 = c; }
        const float p0 = __expf(v0 - em), p1 = __expf(v1 - em); const float inv = 1.0f / (p0 + p1);
        const int e0 = gi * EPG + i0, e1 = gi * EPG + i1;
        GATE[2 * t] = gw * p0 * inv; GATE[2 * t + 1] = gw * p1 * inv;
        const int s0 = atomicAdd(CNT + e0, 1); LIST[(size_t)e0 * T + s0] = 2 * t;
        const int s1 = atomicAdd(CNT + e1, 1); LIST[(size_t)e1 * T + s1] = 2 * t + 1;
    }
}
__global__ void k_swiglu_ew(const float* __restrict__ scr, const float* __restrict__ rstd, bf16* __restrict__ ACT) {
    const size_t i = (size_t)blockIdx.x * blockDim.x + threadIdx.x; const int r = (int)(i >> 9), j = (int)(i & 511);
    const int pa = 256 * (j >> 7) + (j & 127); const float rs = rstd[r >> 1];
    const float a = scr[(size_t)r * 1024 + pa] * rs, b = scr[(size_t)r * 1024 + pa + 128] * rs;
    ACT[i] = f2bf(siluf_(a) * b);
}
__global__ void k_scale_ew(const float* __restrict__ scr, const float* __restrict__ gate, bf16* __restrict__ Y) {
    const size_t i = (size_t)blockIdx.x * blockDim.x + threadIdx.x; const int r = (int)(i >> 10);
    Y[i] = f2bf(scr[i] * gate[r]);
}
__global__ void k_combine(float* __restrict__ H, const bf16* __restrict__ Y, bf16* __restrict__ HB, float* __restrict__ RSTD2) {
    const int t = blockIdx.x * 4 + (threadIdx.x >> 6), lane = threadIdx.x & 63;
    float4* hr = (float4*)(H + (size_t)t * D); const ushort4* y0 = (const ushort4*)(Y + (size_t)(2 * t) * D); const ushort4* y1 = (const ushort4*)(Y + (size_t)(2 * t + 1) * D);
    float ss = 0.f;
#pragma unroll
    for (int j = 0; j < 4; ++j) { float4 v = hr[lane + 64 * j]; const ushort4 a = y0[lane + 64 * j], b = y1[lane + 64 * j];
        v.x += bf2f(a.x) + bf2f(b.x); v.y += bf2f(a.y) + bf2f(b.y); v.z += bf2f(a.z) + bf2f(b.z); v.w += bf2f(a.w) + bf2f(b.w);
        hr[lane + 64 * j] = v; ss += v.x * v.x + v.y * v.y + v.z * v.z + v.w * v.w;
        if (HB) { ushort4 o; o.x = f2bf(v.x); o.y = f2bf(v.y); o.z = f2bf(v.z); o.w = f2bf(v.w); ((ushort4*)(HB + (size_t)t * D))[lane + 64 * j] = o; } }
    if (RSTD2) { ss = wave_sum(ss); if (lane == 0) RSTD2[t] = 1.0f / sqrtf(ss * (1.0f / D) + EPS); }
}
__global__ void k_cl_ew(const float* __restrict__ scr, const float* __restrict__ rstd2, bf16* __restrict__ CL, float* __restrict__ SSP) {
    const int i = blockIdx.x * blockDim.x + threadIdx.x; const int t = i / 24, g = i % 24; const float rs = rstd2[t]; float ss = 0.f;
    for (int c = 0; c < 32; ++c) { const float v = scr[(size_t)t * NCL + g * 32 + c] * rs; ss += v * v; CL[(size_t)t * NCL + g * 32 + c] = f2bf(v); }
    SSP[t * 32 + (g < 10 ? g : g + 2)] = ss;
}
__global__ void k_q_ew(const float* __restrict__ scr, const float* __restrict__ SSP, bf16* __restrict__ QRAW, float* __restrict__ SSQ) {
    const int i = blockIdx.x * blockDim.x + threadIdx.x; const int t = i / 48, g = i % 48; float s = 0.f;
    for (int k = 12; k < 24; ++k) s += SSP[t * 32 + k];
    const float rs = 1.0f / sqrtf(s * (1.0f / QLR) + EPS); float ss = 0.f;
    for (int c = 0; c < 32; ++c) { const float v = scr[(size_t)t * 1536 + g * 32 + c] * rs; ss += v * v; QRAW[(size_t)t * 1536 + g * 32 + c] = f2bf(v); }
    SSQ[i] = ss;
}
__global__ void k_kv_ew(const float* __restrict__ scr, const float* __restrict__ SSP, bf16* __restrict__ KN, bf16* __restrict__ VV, float* __restrict__ SSK) {
    const int i = blockIdx.x * blockDim.x + threadIdx.x; const int t = i / 64, g = i % 64; float s = 0.f;
    for (int k = 0; k < 8; ++k) s += SSP[t * 32 + k];
    const float rs = 1.0f / sqrtf(s * (1.0f / KVR) + EPS); const int h = g >> 3, gi = g & 7; const int b = t / SEQ, sq = t % SEQ; float ss = 0.f;
    for (int c = 0; c < 32; ++c) { const float v = scr[(size_t)t * 2048 + g * 32 + c] * rs;
        if (gi < 4) { ss += v * v; KN[(size_t)t * 1024 + h * 128 + gi * 32 + c] = f2bf(v); }
        else VV[(((size_t)b * NH + h) * SEQ + sq) * DV + (gi - 4) * 32 + c] = f2bf(v); }
    if (gi < 4) SSK[t * 32 + h * 4 + gi] = ss;
}
__global__ void k_kfin(const bf16* __restrict__ KN, const bf16* __restrict__ CL, const float* __restrict__ SSK, const float* __restrict__ SSP, const float* __restrict__ kg,
                       const float* __restrict__ cs, bf16* __restrict__ KK) {
    const int i = blockIdx.x * blockDim.x + threadIdx.x; const int t = i >> 3, h = i & 7; const int b = t / SEQ, sq = t % SEQ;
    const float ss = SSK[t * 32 + h * 4] + SSK[t * 32 + h * 4 + 1] + SSK[t * 32 + h * 4 + 2] + SSK[t * 32 + h * 4 + 3] + SSP[t * 32 + 8] + SSP[t * 32 + 9];
    const float rk = 1.0f / sqrtf(ss * (1.0f / DQK) + EPS);
    bf16* o = KK + (((size_t)b * NH + h) * SEQ + sq) * DQK;
    for (int j = 0; j < DNOPE; ++j) o[j] = f2bf(bf2f(KN[(size_t)t * 1024 + h * 128 + j]) * rk * kg[j]);
    for (int j = 0; j < 32; ++j) { const float x1 = bf2f(CL[(size_t)t * NCL + 256 + j]) * rk * kg[128 + j], x2 = bf2f(CL[(size_t)t * NCL + 288 + j]) * rk * kg[160 + j];
        const float c = cs[(size_t)t * 64 + j], s = cs[(size_t)t * 64 + 32 + j];
        o[128 + j] = f2bf(x1 * c - x2 * s); o[160 + j] = f2bf(x1 * s + x2 * c); }
}
constexpr int ATT_REF_LDS = (64 * 193 + 32 * 193 + 32 * 128 + 64 * 33 + 64 * 2) * 4;
__global__ void __launch_bounds__(256) k_attn_ref(const bf16* __restrict__ QRAW, const float* __restrict__ SSQ, const float* __restrict__ qg, const float* __restrict__ cs,
                                                  const bf16* __restrict__ KK, const bf16* __restrict__ VV, bf16* __restrict__ O) {
    extern __shared__ float sm[];
    float* Qs = sm; float* Ks = Qs + 64 * 193; float* Vs = Ks + 32 * 193; float* Ps = Vs + 32 * 128; float* al = Ps + 64 * 33; float* ls = al + 64;
    const int c = (gridDim.x - 1) - blockIdx.x, bh = blockIdx.y, b = bh / NH, h = bh % NH, tid = threadIdx.x;
    { const int q = tid >> 2, part = tid & 3; const int t = b * SEQ + c * 64 + q; float s = 0.f;
      for (int k = 0; k < 6; ++k) s += SSQ[t * 48 + h * 6 + k];
      const float rq = (1.0f / sqrtf(s * (1.0f / DQK) + EPS)) * SM_SCALE; const bf16* qr = QRAW + (size_t)t * 1536 + h * DQK;
      if (part < 2) { for (int j = part * 64; j < part * 64 + 64; ++j) Qs[q * 193 + j] = bf2f(qr[j]) * rq * qg[j]; }
      else if (part == 2) { for (int j = 0; j < 32; ++j) { const float x1 = bf2f(qr[128 + j]) * rq * qg[128 + j], x2 = bf2f(qr[160 + j]) * rq * qg[160 + j];
          const float cc = cs[(size_t)t * 64 + j], ss2 = cs[(size_t)t * 64 + 32 + j]; Qs[q * 193 + 128 + j] = x1 * cc - x2 * ss2; Qs[q * 193 + 160 + j] = x1 * ss2 + x2 * cc; } } }
    float m_run = -1e30f, l_run = 0.f;
    float acc[4][8];
#pragma unroll
    for (int i = 0; i < 4; ++i)
#pragma unroll
        for (int j = 0; j < 8; ++j) acc[i][j] = 0.f;
    const int tq = tid >> 4, tk = tid & 15;
    const bf16* Kb = KK + (size_t)bh * SEQ * DQK; const bf16* Vb = VV + (size_t)bh * SEQ * DV;
    const int ntiles = (c + 1) * 2;
    __syncthreads();
    for (int kt = 0; kt < ntiles; ++kt) {
        const int key0 = kt * 32;
        for (int i = tid; i < 32 * 192; i += 256) { const int kk = i / 192, dd = i % 192; Ks[kk * 193 + dd] = bf2f(Kb[(size_t)(key0 + kk) * DQK + dd]); }
        for (int i = tid; i < 32 * 128; i += 256) Vs[i] = bf2f(Vb[(size_t)key0 * DV + i]);
        __syncthreads();
        float s[4][2];
#pragma unroll
        for (int i = 0; i < 4; ++i) { s[i][0] = 0.f; s[i][1] = 0.f; }
        for (int d = 0; d < DQK; ++d) { const float k0 = Ks[(tk * 2) * 193 + d], k1 = Ks[(tk * 2 + 1) * 193 + d];
#pragma unroll
            for (int i = 0; i < 4; ++i) { const float qv = Qs[(tq * 4 + i) * 193 + d]; s[i][0] = fmaf(qv, k0, s[i][0]); s[i][1] = fmaf(qv, k1, s[i][1]); } }
#pragma unroll
        for (int i = 0; i < 4; ++i) { Ps[(tq * 4 + i) * 33 + tk * 2] = s[i][0]; Ps[(tq * 4 + i) * 33 + tk * 2 + 1] = s[i][1]; }
        __syncthreads();
        if (tid < 64) { float mx = m_run; for (int k = 0; k < 32; ++k) mx = fmaxf(mx, Ps[tid * 33 + k]);
            float sum = 0.f; for (int k = 0; k < 32; ++k) { const float p = __expf(Ps[tid * 33 + k] - mx); Ps[tid * 33 + k] = p; sum += p; }
            const float a = __expf(m_run - mx); al[tid] = a; l_run = l_run * a + sum; m_run = mx; }
        __syncthreads();
#pragma unroll
        for (int i = 0; i < 4; ++i) { const float a = al[tq * 4 + i];
#pragma unroll
            for (int j = 0; j < 8; ++j) acc[i][j] *= a; }
        for (int k = 0; k < 32; ++k) { float v[8];
#pragma unroll
            for (int j = 0; j < 8; ++j) v[j] = Vs[k * 128 + tk * 8 + j];
#pragma unroll
            for (int i = 0; i < 4; ++i) { const float p = Ps[(tq * 4 + i) * 33 + k];
#pragma unroll
                for (int j = 0; j < 8; ++j) acc[i][j] = fmaf(p, v[j], acc[i][j]); } }
        __syncthreads();
    }
    if (tid < 64) ls[tid] = l_run;
    __syncthreads();
#pragma unroll
    for (int i = 0; i < 4; ++i) { const int q = tq * 4 + i; const float inv = 1.0f / ls[q]; const int t = b * SEQ + c * 64 + q;
#pragma unroll
        for (int j = 0; j < 8; ++j) O[(size_t)t * D + h * DV + tk * 8 + j] = f2bf(acc[i][j] * inv); }
}

#define LAS __attribute__((address_space(3)))
#define GAS __attribute__((address_space(1)))
typedef short bf16x8 __attribute__((ext_vector_type(8)));
typedef float f32x4 __attribute__((ext_vector_type(4)));
typedef float f32x2 __attribute__((ext_vector_type(2)));
typedef unsigned u32x4 __attribute__((ext_vector_type(4)));
typedef unsigned u32x2 __attribute__((ext_vector_type(2)));

__device__ __forceinline__ unsigned cvt_pk_bf16(float lo, float hi) { unsigned r; asm volatile("v_cvt_pk_bf16_f32 %0, %1, %2" : "=v"(r) : "v"(lo), "v"(hi)); return r; }
__device__ __forceinline__ float fast_sigmoid(float x) { return __builtin_amdgcn_rcpf(1.0f + __builtin_amdgcn_exp2f(-1.4426950408889634f * x)); }
__device__ __forceinline__ float fast_rsqrt(float x) { return 1.0f / sqrtf(x); }

namespace fg {
constexpr int BM = 256, BK = 64, HALF = 128, HTB = HALF * BK * 2, STAGE_BYTES = 8 * HTB, NXCD = 8, WGM = 8;
__host__ __device__ __forceinline__ int lds_byte(int r, int c) { const int st = (r >> 4) * 2 + (c >> 5), rr = r & 15, cc = c & 31, ob = rr * 64 + cc * 2; return st * 1024 + (ob ^ (((ob >> 9) & 1) << 5)); }
__host__ __device__ __forceinline__ void stage_rc(int b, int& R, int& C) { const int st = b / 1024, sb = b % 1024, swz = sb ^ (((sb >> 9) & 1) << 5); R = (st >> 1) * 16 + swz / 64; C = (st & 1) * 32 + (swz % 64) / 2; }
__host__ __device__ __forceinline__ int perm32(int rho) { const int n = rho >> 4, i = rho & 15; return 8 * (i >> 2) + 4 * n + (i & 3); }
struct Unit { int pm, pn, e, nvalid; };
typedef f32x4 Acc[2][2][4][2];

struct StaticOrder {
    int nM, nN, nwg, G, c;
    __device__ void init(int M, int N, int G_, int c_) { nM = M / BM; nN = N / BM; nwg = nM * nN; G = G_; c = c_; }
    __device__ bool next(int i, Unit& u) const {
        const long L = (long)i * G + c; if (L >= nwg) return false;
        int wgid = (int)L; { const int q = nwg / NXCD, r = nwg % NXCD, xcd = wgid % NXCD, off = wgid / NXCD; wgid = (xcd < r ? xcd * (q + 1) : r * (q + 1) + (xcd - r) * q) + off; }
        const int nig = WGM * nN, gid = wgid / nig, fm = gid * WGM, gsz = (nM - fm) < WGM ? (nM - fm) : WGM;
        u.pm = fm + ((wgid % nig) % gsz); u.pn = (wgid % nig) / gsz; u.e = 0; u.nvalid = 256; return true;
    }
};

template <class P>
__device__ __forceinline__ void gemm_phase(LAS unsigned char* lds, const P& p) {
    int tid_ = threadIdx.x; asm volatile("" : "+v"(tid_));
    const int tid = tid_, wid = __builtin_amdgcn_readfirstlane(tid >> 6), lane = tid & 63, wr = wid >> 2, wc = wid & 3, fr = lane & 15, fq = lane >> 4;
    const int K = p.K, nt = K / BK;
    int sR[2], sC[2]; unsigned voffB[2];
#pragma unroll
    for (int i = 0; i < 2; ++i) { int R, C; stage_rc(tid * 16 + i * 8192, R, C); sR[i] = R; sC[i] = C; const int Rb = P::PERM ? ((R & ~31) + perm32(R & 31)) : R; voffB[i] = (unsigned)(Rb * K + C) * 2u; }
    const size_t kstep = (size_t)(BK * 2), hstepB = (size_t)HALF * K * 2;
    const unsigned ldsw = (unsigned)wid * 1024u;
    const int aoff = lds_byte(wr * 64 + fr, fq * 8), boff = lds_byte(wc * 32 + fr, fq * 8);
#define FG_SA(b, h) (((b) * 2 + (h)) * HTB)
#define FG_SB(b, h) ((4 + (b) * 2 + (h)) * HTB)
#define FG_STAGE(bufoff, gbase, voff) do { _Pragma("unroll") for (int _i = 0; _i < 2; ++_i) \
        __builtin_amdgcn_global_load_lds((const unsigned*)((const char*)(gbase) + (voff)[_i]), (LAS unsigned*)(lds + (bufoff) + ldsw + _i * 8192), 16, 0, 0); } while (0)
#define FG_LDA(dst, b, h) do { _Pragma("unroll") for (int m = 0; m < 4; ++m) _Pragma("unroll") for (int k = 0; k < 2; ++k) dst[m][k] = *(const LAS bf16x8*)(lds + FG_SA(b, h) + aoff + m * 2048 + k * 1024); } while (0)
#define FG_LDB(dst, b, h) do { _Pragma("unroll") for (int n = 0; n < 2; ++n) _Pragma("unroll") for (int k = 0; k < 2; ++k) dst[n][k] = *(const LAS bf16x8*)(lds + FG_SB(b, h) + boff + n * 2048 + k * 1024); } while (0)
#define FG_MMA(ai, bj, At, Bt) do { __builtin_amdgcn_s_setprio(1); _Pragma("unroll") for (int m = 0; m < 4; ++m) _Pragma("unroll") for (int n = 0; n < 2; ++n) _Pragma("unroll") for (int k = 0; k < 2; ++k) \
        acc[ai][bj][m][n] = __builtin_amdgcn_mfma_f32_16x16x32_bf16(Bt[n][k], At[m][k], acc[ai][bj][m][n], 0, 0, 0); __builtin_amdgcn_s_setprio(0); } while (0)
#define FG_WAIT_V(n) asm volatile("s_waitcnt vmcnt(" #n ")" ::: "memory")
#define FG_WAIT_L(n) asm volatile("s_waitcnt lgkmcnt(" #n ")" ::: "memory")
#define FG_BAR __builtin_amdgcn_s_barrier()
#define FG_SCHED __builtin_amdgcn_sched_barrier(0)
    Unit cur, nxt, nn; int ui = 0;
    if (!p.next(0, cur)) return;
    unsigned ao[4], nao[4], nnao[4];
    p.a_off(cur, sR, sC, ao);
    bool has_next = p.next(1, nxt);
    if (has_next) p.a_off(nxt, sR, sC, nao); else { nxt = cur; _Pragma("unroll") for (int j = 0; j < 4; ++j) nao[j] = ao[j]; }
    Acc acc;
#pragma unroll
    for (int a = 0; a < 2; ++a)
#pragma unroll
        for (int b = 0; b < 2; ++b)
#pragma unroll
            for (int m = 0; m < 4; ++m)
#pragma unroll
                for (int n = 0; n < 2; ++n) acc[a][b][m][n] = (f32x4){0.f, 0.f, 0.f, 0.f};
    bf16x8 At[4][2], B0[2][2], B1[2][2];
    const char* const Ab = p.A;
    const char* cB = p.b_base(cur);
    FG_STAGE(FG_SB(0, 0), cB, voffB); FG_STAGE(FG_SB(0, 1), cB + hstepB, voffB); FG_STAGE(FG_SA(0, 0), Ab, ao); FG_STAGE(FG_SA(0, 1), Ab, ao + 2);
    if (wr == 1) FG_BAR;
    FG_WAIT_V(2); FG_BAR;
    FG_STAGE(FG_SB(1, 0), cB + kstep, voffB); FG_STAGE(FG_SA(1, 0), Ab + kstep, ao); FG_STAGE(FG_SB(1, 1), cB + hstepB + kstep, voffB);
    FG_WAIT_V(6); FG_BAR;
    for (;;) {
        const char* nB = has_next ? p.b_base(nxt) : cB;
        for (int t = 0; t < nt; t += 2) {
            const bool last = (t == nt - 2);
            const char* a1 = Ab + (size_t)(t + 1) * kstep;
            const char* a2 = last ? Ab : Ab + (size_t)(t + 2) * kstep; const char* b2 = last ? nB : cB + (size_t)(t + 2) * kstep;
            const char* a3 = a2 + kstep; const char* b3 = b2 + kstep;
            unsigned so[4];
#pragma unroll
            for (int j = 0; j < 4; ++j) so[j] = last ? nao[j] : ao[j];
            FG_LDB(B0, 0, 0); FG_LDB(B1, 0, 1); FG_SCHED; FG_LDA(At, 0, 0); FG_STAGE(FG_SA(1, 1), a1, ao + 2);
            FG_WAIT_V(8); FG_WAIT_L(0); FG_BAR; FG_MMA(0, 0, At, B0); FG_MMA(0, 1, At, B1); FG_BAR; FG_SCHED;
            FG_LDA(At, 0, 1); FG_STAGE(FG_SB(0, 0), b2, voffB); FG_STAGE(FG_SB(0, 1), b2 + hstepB, voffB); FG_STAGE(FG_SA(0, 0), a2, so);
            FG_WAIT_V(8); FG_WAIT_L(0); FG_BAR; FG_MMA(1, 0, At, B0); FG_MMA(1, 1, At, B1); FG_BAR; FG_SCHED;
            FG_LDB(B0, 1, 0); FG_LDB(B1, 1, 1); FG_SCHED; FG_LDA(At, 1, 0); FG_STAGE(FG_SA(0, 1), a2, so + 2);
            FG_WAIT_V(8); FG_WAIT_L(0); FG_BAR; FG_MMA(0, 0, At, B0); FG_MMA(0, 1, At, B1); FG_BAR; FG_SCHED;
            FG_LDA(At, 1, 1); FG_STAGE(FG_SB(1, 0), b3, voffB); FG_STAGE(FG_SB(1, 1), b3 + hstepB, voffB); FG_STAGE(FG_SA(1, 0), a3, so);
            FG_WAIT_V(8); FG_WAIT_L(0); FG_BAR; FG_MMA(1, 0, At, B0); FG_MMA(1, 1, At, B1); FG_BAR; FG_SCHED;
        }
        if (wr == 0) FG_BAR;
        p.epi(acc, cur, wr, wc, fr, fq);
        if (!has_next) break;
        const bool has_nn = p.next(ui + 2, nn);
        if (has_nn) p.a_off(nn, sR, sC, nnao); else { nn = nxt; _Pragma("unroll") for (int j = 0; j < 4; ++j) nnao[j] = nao[j]; }
#pragma unroll
        for (int a = 0; a < 2; ++a)
#pragma unroll
            for (int b = 0; b < 2; ++b)
#pragma unroll
                for (int m = 0; m < 4; ++m)
#pragma unroll
                    for (int n = 0; n < 2; ++n) acc[a][b][m][n] = (f32x4){0.f, 0.f, 0.f, 0.f};
        cur = nxt; cB = nB; nxt = nn; has_next = has_nn; ++ui;
#pragma unroll
        for (int j = 0; j < 4; ++j) { ao[j] = nao[j]; nao[j] = nnao[j]; }
        if (wr == 1) FG_BAR;
    }
    FG_WAIT_V(0);
    FG_BAR;
#undef FG_SA
#undef FG_SB
#undef FG_STAGE
#undef FG_LDA
#undef FG_LDB
#undef FG_MMA
#undef FG_WAIT_V
#undef FG_WAIT_L
#undef FG_BAR
#undef FG_SCHED
}

template <class Epi> struct DenseP {
    static constexpr bool PERM = Epi::PERM;
    const char* A; int lda; const char* Bt; int K; StaticOrder S; Epi E;
    __device__ __forceinline__ bool next(int i, Unit& u) const { return S.next(i, u); }
    __device__ __forceinline__ const char* b_base(const Unit& u) const { return Bt + (size_t)u.pn * BM * K * 2; }
    __device__ __forceinline__ void a_off(const Unit& u, const int (&sR)[2], const int (&sC)[2], unsigned (&ao)[4]) const {
#pragma unroll
        for (int h = 0; h < 2; ++h)
#pragma unroll
            for (int i = 0; i < 2; ++i) ao[h * 2 + i] = (unsigned)((u.pm * BM + h * HALF + sR[i]) * lda + sC[i]) * 2u;
    }
    __device__ __forceinline__ void epi(const Acc& acc, const Unit& u, int wr, int wc, int fr, int fq) const { E(acc, u, wr, wc, fr, fq); }
};

struct EpiGlu {
    static constexpr bool PERM = true;
    const float* rstd; const float* bias; bf16* U;
    __device__ __forceinline__ void operator()(const Acc& acc, const Unit& u, int wr, int wc, int fr, int fq) const {
        const int col = u.pn * 128 + wc * 32 + fq * 8, row0 = u.pm * BM + wr * 64 + fr;
        const f32x4 ba0 = *(const f32x4*)(bias + col), ba1 = *(const f32x4*)(bias + col + 4), bg0 = *(const f32x4*)(bias + 1024 + col), bg1 = *(const f32x4*)(bias + 1024 + col + 4);
        float rsv[8];
#pragma unroll
        for (int q = 0; q < 8; ++q) rsv[q] = rstd[row0 + (q >> 2) * HALF + (q & 3) * 16];
#pragma unroll
        for (int ai = 0; ai < 2; ++ai)
#pragma unroll
            for (int m = 0; m < 4; ++m) { const int row = row0 + ai * HALF + m * 16; const float rs = rsv[ai * 4 + m];
                const f32x4 a0 = acc[ai][0][m][0] * rs + ba0, a1 = acc[ai][0][m][1] * rs + ba1, g0 = acc[ai][1][m][0] * rs + bg0, g1 = acc[ai][1][m][1] * rs + bg1;
                float o[8];
#pragma unroll
                for (int j = 0; j < 4; ++j) { o[j] = a0[j] * fast_sigmoid(g0[j]); o[4 + j] = a1[j] * fast_sigmoid(g1[j]); }
                u32x4 w; w.x = cvt_pk_bf16(o[0], o[1]); w.y = cvt_pk_bf16(o[2], o[3]); w.z = cvt_pk_bf16(o[4], o[5]); w.w = cvt_pk_bf16(o[6], o[7]);
                *(u32x4*)(U + (size_t)row * D + col) = w; }
    }
};
struct EpiRes {
    static constexpr bool PERM = false;
    const float* base; const float* bias; float* out;
    __device__ __forceinline__ void operator()(const Acc& acc, const Unit& u, int wr, int wc, int fr, int fq) const {
        const int row0 = u.pm * BM + wr * 64 + fr, col0 = u.pn * BM + wc * 32 + 4 * fq;
        f32x4 bv[2][2];
#pragma unroll
        for (int bj = 0; bj < 2; ++bj)
#pragma unroll
            for (int n = 0; n < 2; ++n) bv[bj][n] = bias ? *(const f32x4*)(bias + col0 + bj * HALF + n * 16) : (f32x4){0.f, 0.f, 0.f, 0.f};
#pragma unroll
        for (int ai = 0; ai < 2; ++ai)
#pragma unroll
        for (int mh = 0; mh < 2; ++mh) {
            f32x4 bs[2][2][2];
#pragma unroll
            for (int m2 = 0; m2 < 2; ++m2) { const size_t off = (size_t)(row0 + ai * HALF + (mh * 2 + m2) * 16) * D + col0;
#pragma unroll
                for (int bj = 0; bj < 2; ++bj)
#pragma unroll
                    for (int n = 0; n < 2; ++n) bs[m2][bj][n] = *(const f32x4*)(base + off + bj * HALF + n * 16); }
            asm volatile("" ::: "memory");
#pragma unroll
            for (int m2 = 0; m2 < 2; ++m2) { const int m = mh * 2 + m2; const size_t off = (size_t)(row0 + ai * HALF + m * 16) * D + col0;
#pragma unroll
                for (int bj = 0; bj < 2; ++bj)
#pragma unroll
                    for (int n = 0; n < 2; ++n) *(f32x4*)(out + off + bj * HALF + n * 16) = bs[m2][bj][n] + acc[ai][bj][m][n] + bv[bj][n]; }
            asm volatile("" ::: "memory");
        }
    }
};
__device__ __forceinline__ float quad_sum(float s) { s += __shfl_xor(s, 16); s += __shfl_xor(s, 32); return s; }
__device__ __forceinline__ u32x4 pack8(const f32x4 a, const f32x4 b) { u32x4 w; w.x = cvt_pk_bf16(a[0], a[1]); w.y = cvt_pk_bf16(a[2], a[3]); w.z = cvt_pk_bf16(b[0], b[1]); w.w = cvt_pk_bf16(b[2], b[3]); return w; }
__device__ __forceinline__ float sumsq8(const f32x4 a, const f32x4 b) { return (a[0] * a[0] + a[1] * a[1]) + (a[2] * a[2] + a[3] * a[3]) + (b[0] * b[0] + b[1] * b[1]) + (b[2] * b[2] + b[3] * b[3]); }
struct EpiCL {
    static constexpr bool PERM = true;
    const float* rstd2; bf16* CL; float* SSP;
    __device__ __forceinline__ void operator()(const Acc& acc, const Unit& u, int wr, int wc, int fr, int fq) const {
        const int row0 = u.pm * BM + wr * 64 + fr;
        float rsv[8];
#pragma unroll
        for (int q = 0; q < 8; ++q) rsv[q] = rstd2[row0 + (q >> 2) * HALF + (q & 3) * 16];
#pragma unroll
        for (int ai = 0; ai < 2; ++ai)
#pragma unroll
            for (int m = 0; m < 4; ++m) { const int row = row0 + ai * HALF + m * 16; const float rs = rsv[ai * 4 + m];
#pragma unroll
                for (int bj = 0; bj < 2; ++bj) { const f32x4 v0 = acc[ai][bj][m][0] * rs, v1 = acc[ai][bj][m][1] * rs; const float ss = quad_sum(sumsq8(v0, v1));
                    *(u32x4*)(CL + (size_t)row * NCL + u.pn * BM + bj * HALF + wc * 32 + fq * 8) = pack8(v0, v1);
                    const int g = u.pn * 8 + bj * 4 + wc; if (fq == 0) SSP[row * 32 + (g < 10 ? g : g + 2)] = ss; } }
    }
};
struct EpiQ {
    static constexpr bool PERM = true;
    const float* SSP; bf16* QRAW; float* SSQ;
    __device__ __forceinline__ void operator()(const Acc& acc, const Unit& u, int wr, int wc, int fr, int fq) const {
        const int row0 = u.pm * BM + wr * 64 + fr;
        float rsv[8];
#pragma unroll
        for (int q = 0; q < 8; ++q) { const int row = row0 + (q >> 2) * HALF + (q & 3) * 16;
            const f32x4 s0 = *(const f32x4*)(SSP + row * 32 + 12), s1 = *(const f32x4*)(SSP + row * 32 + 16), s2 = *(const f32x4*)(SSP + row * 32 + 20);
            rsv[q] = ((s0[0] + s0[1]) + (s0[2] + s0[3])) + ((s1[0] + s1[1]) + (s1[2] + s1[3])) + ((s2[0] + s2[1]) + (s2[2] + s2[3]));
            if (q == 3) asm volatile("" : "+v"(rsv[0]), "+v"(rsv[1]), "+v"(rsv[2]), "+v"(rsv[3]) :: "memory"); }
#pragma unroll
        for (int q = 0; q < 8; ++q) rsv[q] = fast_rsqrt(rsv[q] * (1.0f / QLR) + EPS);
#pragma unroll
        for (int ai = 0; ai < 2; ++ai)
#pragma unroll
            for (int m = 0; m < 4; ++m) { const int row = row0 + ai * HALF + m * 16; const float rs = rsv[ai * 4 + m];
#pragma unroll
                for (int bj = 0; bj < 2; ++bj) { const f32x4 v0 = acc[ai][bj][m][0] * rs, v1 = acc[ai][bj][m][1] * rs; const float ss = quad_sum(sumsq8(v0, v1));
                    *(u32x4*)(QRAW + (size_t)row * 1536 + u.pn * BM + bj * HALF + wc * 32 + fq * 8) = pack8(v0, v1);
                    if (fq == 0) SSQ[row * 48 + u.pn * 8 + bj * 4 + wc] = ss; } }
    }
};
struct EpiKV {
    static constexpr bool PERM = true;
    const float* SSP; bf16* KN; bf16* VV; float* SSK;
    __device__ __forceinline__ void operator()(const Acc& acc, const Unit& u, int wr, int wc, int fr, int fq) const {
        const int row0 = u.pm * BM + wr * 64 + fr;
        float rsv[8];
#pragma unroll
        for (int q = 0; q < 8; ++q) { const int row = row0 + (q >> 2) * HALF + (q & 3) * 16;
            const f32x4 s0 = *(const f32x4*)(SSP + row * 32), s1 = *(const f32x4*)(SSP + row * 32 + 4);
            rsv[q] = ((s0[0] + s0[1]) + (s0[2] + s0[3])) + ((s1[0] + s1[1]) + (s1[2] + s1[3])); }
#pragma unroll
        for (int q = 0; q < 8; ++q) rsv[q] = fast_rsqrt(rsv[q] * (1.0f / KVR) + EPS);
#pragma unroll
        for (int ai = 0; ai < 2; ++ai)
#pragma unroll
            for (int m = 0; m < 4; ++m) { const int row = row0 + ai * HALF + m * 16; const float rs = rsv[ai * 4 + m];
                { const f32x4 v0 = acc[ai][0][m][0] * rs, v1 = acc[ai][0][m][1] * rs; const float ss = quad_sum(sumsq8(v0, v1));
                  *(u32x4*)(KN + (size_t)row * D + u.pn * 128 + wc * 32 + fq * 8) = pack8(v0, v1);
                  if (fq == 0) SSK[row * 32 + u.pn * 4 + wc] = ss; }
                { const f32x4 v0 = acc[ai][1][m][0] * rs, v1 = acc[ai][1][m][1] * rs; const int b = row / SEQ, sq = row % SEQ;
                  *(u32x4*)(VV + (((size_t)b * NH + u.pn) * SEQ + sq) * DV + wc * 32 + fq * 8) = pack8(v0, v1); } }
    }
};

__device__ __forceinline__ void moe_setup(const int* CNT, LAS int* pref, LAS int* cnts) {
    const int tid = threadIdx.x;
    if (tid < 64) { const int c = tid < 32 ? (int)__hip_atomic_load((const unsigned*)CNT + tid, __ATOMIC_RELAXED, __HIP_MEMORY_SCOPE_AGENT) : 0; int incl = (c + 255) >> 8;
#pragma unroll
        for (int o = 1; o < 32; o <<= 1) { const int v = __shfl_up(incl, o); if (tid >= o) incl += v; }
        if (tid < 32) { pref[tid + 1] = incl; cnts[tid] = c; } if (tid == 0) pref[0] = 0; }
    __syncthreads();
}
template <class Epi> struct MoeP {
    static constexpr bool PERM = true;
    const char* A; int lda; int a_shift; const char* Bt; size_t b_estride; int K; const int* LIST; const LAS int* pref; const LAS int* cnts; int G, c, nunits; Epi E;
    __device__ __forceinline__ bool next(int i, Unit& u) const {
        const int L = i * G + c; if (L >= nunits) return false;
        const int r = L >> 2, lane = threadIdx.x & 63; const int v = pref[(lane & 31) + 1];
        const int e = __builtin_popcountll(__ballot(lane < 32 && r >= v));
        u.pn = L & 3; u.e = e; u.pm = r - __builtin_amdgcn_readfirstlane(pref[e]); const int rem = __builtin_amdgcn_readfirstlane(cnts[e]) - BM * u.pm; u.nvalid = rem < BM ? rem : BM; return true;
    }
    __device__ __forceinline__ const char* b_base(const Unit& u) const { return Bt + (size_t)u.e * b_estride + (size_t)u.pn * BM * K * 2; }
    __device__ __forceinline__ void a_off(const Unit& u, const int (&sR)[2], const int (&sC)[2], unsigned (&ao)[4]) const {
        const int* lp = LIST + (size_t)u.e * T + u.pm * BM;
#pragma unroll
        for (int h = 0; h < 2; ++h)
#pragma unroll
            for (int i = 0; i < 2; ++i) { const int row = h * HALF + sR[i]; int ent = lp[row]; ent = row < u.nvalid ? ent : 0; ao[h * 2 + i] = (unsigned)((ent >> a_shift) * lda + sC[i]) * 2u; }
    }
    __device__ __forceinline__ void epi(const Acc& acc, const Unit& u, int wr, int wc, int fr, int fq) const { E(acc, u, wr, wc, fr, fq, LIST + (size_t)u.e * T + u.pm * BM); }
};
struct EpiSwiglu {
    const float* rstd; bf16* ACT;
    __device__ __forceinline__ void operator()(const Acc& acc, const Unit& u, int wr, int wc, int fr, int fq, const int* lp) const {
        int ent[8]; float rsv[8];
#pragma unroll
        for (int q = 0; q < 8; ++q) { const int row = (q >> 2) * HALF + wr * 64 + (q & 3) * 16 + fr; const int e0 = lp[row]; ent[q] = row < u.nvalid ? e0 : -1; }
#pragma unroll
        for (int q = 0; q < 8; ++q) rsv[q] = rstd[(ent[q] < 0 ? 0 : ent[q]) >> 1];
#pragma unroll
        for (int ai = 0; ai < 2; ++ai)
#pragma unroll
            for (int m = 0; m < 4; ++m) { const int q = ai * 4 + m; const float rs = rsv[q];
                const f32x4 a0 = acc[ai][0][m][0] * rs, a1 = acc[ai][0][m][1] * rs, b0 = acc[ai][1][m][0] * rs, b1 = acc[ai][1][m][1] * rs;
                float o[8];
#pragma unroll
                for (int j = 0; j < 4; ++j) { o[j] = a0[j] * fast_sigmoid(a0[j]) * b0[j]; o[4 + j] = a1[j] * fast_sigmoid(a1[j]) * b1[j]; }
                u32x4 w; w.x = cvt_pk_bf16(o[0], o[1]); w.y = cvt_pk_bf16(o[2], o[3]); w.z = cvt_pk_bf16(o[4], o[5]); w.w = cvt_pk_bf16(o[6], o[7]);
                if (ent[q] >= 0) *(u32x4*)(ACT + (size_t)ent[q] * DE + u.pn * 128 + wc * 32 + fq * 8) = w; }
    }
};
struct EpiDown {
    const float* gate; bf16* Y;
    __device__ __forceinline__ void operator()(const Acc& acc, const Unit& u, int wr, int wc, int fr, int fq, const int* lp) const {
        int ent[8]; float gv[8];
#pragma unroll
        for (int q = 0; q < 8; ++q) { const int row = (q >> 2) * HALF + wr * 64 + (q & 3) * 16 + fr; const int e0 = lp[row]; ent[q] = row < u.nvalid ? e0 : -1; }
#pragma unroll
        for (int q = 0; q < 8; ++q) gv[q] = gate[ent[q] < 0 ? 0 : ent[q]];
#pragma unroll
        for (int ai = 0; ai < 2; ++ai)
#pragma unroll
            for (int m = 0; m < 4; ++m) { const int q = ai * 4 + m; const float g = gv[q];
                if (ent[q] >= 0) {
#pragma unroll
                    for (int bj = 0; bj < 2; ++bj) *(u32x4*)(Y + (size_t)ent[q] * D + u.pn * BM + bj * HALF + wc * 32 + fq * 8) = pack8(acc[ai][bj][m][0] * g, acc[ai][bj][m][1] * g); } }
    }
};
}


namespace at {
typedef short s16x4 __attribute__((ext_vector_type(4)));
typedef float f32x16 __attribute__((ext_vector_type(16)));
constexpr int KTB = 64 * 384, VTB = 64 * 256, LDS_K = 0, LDS_V = 2 * KTB, LDS_AL = LDS_V + 2 * VTB, LDS_TOTAL = LDS_AL + 8 * 256;
constexpr float THR2 = 11.0f;
__device__ __forceinline__ int v_rd_base(int lane) { return ((lane & 3) << 3) | (((lane >> 2) & 3) << 6) | (((lane >> 4) & 1) << 5) | (((lane >> 5) & 1) << 8); }
constexpr int v_rd_off(int d0, int ks, int half) { return d0 * 512 + ks * 4096 + half * 2048; }
__device__ __forceinline__ int crow(int r, int hi) { return (r & 3) + 8 * (r >> 2) + 4 * hi; }
#define AT_SBAR() __builtin_amdgcn_sched_barrier(0)

template <int BUF>
__device__ __forceinline__ void tile_compute(f32x16 (&o)[4], const bf16x8 (&qr)[12], float& m_run, float& l_run, const LAS char* kb0, const LAS char* kb1, const LAS char* kb2, const LAS char* kb3,
                                             int vb0, LAS float* al_l, int r32, int hi) {
    f32x16 p0 = {}, p1 = {};
#pragma unroll
    for (int s = 0; s < 12; ++s) { const LAS char* a = ((s & 3) == 0 ? kb0 : (s & 3) == 1 ? kb1 : (s & 3) == 2 ? kb2 : kb3) + (s >> 2) * 128 + BUF * KTB;
        const bf16x8 k0 = *(const LAS bf16x8*)a, k1 = *(const LAS bf16x8*)(a + 32 * 384);
        p0 = __builtin_amdgcn_mfma_f32_32x32x16_bf16(k0, qr[s], p0, 0, 0, 0);
        p1 = __builtin_amdgcn_mfma_f32_32x32x16_bf16(k1, qr[s], p1, 0, 0, 0); }
    float pmax = p0[0];
#pragma unroll
    for (int r = 1; r < 16; ++r) pmax = fmaxf(pmax, p0[r]);
#pragma unroll
    for (int r = 0; r < 16; ++r) pmax = fmaxf(pmax, p1[r]);
    { auto rr = __builtin_amdgcn_permlane32_swap(__float_as_uint(pmax), __float_as_uint(pmax), false, false); pmax = fmaxf(__uint_as_float(rr[0]), __uint_as_float(rr[1])); }
    float alpha = 1.f;
    if (!__all(pmax - m_run <= THR2)) { const float mn = fmaxf(m_run, pmax); alpha = __builtin_amdgcn_exp2f(m_run - mn); m_run = mn; }
    const float mneg = -m_run;
#pragma unroll
    for (int r = 0; r < 16; ++r) { p0[r] = __builtin_amdgcn_exp2f(p0[r] + mneg); p1[r] = __builtin_amdgcn_exp2f(p1[r] + mneg); }
    float ps = 0.f;
#pragma unroll
    for (int r = 0; r < 16; ++r) ps += p0[r];
#pragma unroll
    for (int r = 0; r < 16; ++r) ps += p1[r];
    { auto rr = __builtin_amdgcn_permlane32_swap(__float_as_uint(ps), __float_as_uint(ps), false, false); ps = __uint_as_float(rr[0]) + __uint_as_float(rr[1]); }
    l_run = l_run * alpha + ps;
    bf16x8 pa0, pa1, pa2, pa3;
#define AT_PK4(P, B_, OUT) do { unsigned a0 = cvt_pk_bf16(P[B_+0], P[B_+1]), a1 = cvt_pk_bf16(P[B_+2], P[B_+3]); \
        unsigned b0 = cvt_pk_bf16(P[B_+4], P[B_+5]), b1 = cvt_pk_bf16(P[B_+6], P[B_+7]); \
        auto r0 = __builtin_amdgcn_permlane32_swap(a0, b0, false, false); auto r1 = __builtin_amdgcn_permlane32_swap(a1, b1, false, false); \
        u32x4 w = {r0[0], r1[0], r0[1], r1[1]}; OUT = *reinterpret_cast<bf16x8*>(&w); } while (0)
    AT_PK4(p0, 0, pa0); AT_PK4(p0, 8, pa1); AT_PK4(p1, 0, pa2); AT_PK4(p1, 8, pa3);
#undef AT_PK4
    if (__any(alpha < 1.f)) { if (hi == 0) al_l[r32] = alpha; asm volatile("s_waitcnt lgkmcnt(0)" ::: "memory");
#pragma unroll
        for (int d_ = 0; d_ < 4; ++d_)
#pragma unroll
            for (int r = 0; r < 16; ++r) o[d_][r] *= al_l[crow(r, hi)]; }
#define AT_TRRD(dst, off) asm volatile("ds_read_b64_tr_b16 %0, %1 offset:%2" : "=&v"(dst) : "v"(vb0), "i"(off) : "memory")
#define AT_PV_D0(d0) do { s16x4 l0, l1, l2, l3, h0, h1, h2, h3; constexpr int b_ = BUF * VTB + v_rd_off(d0, 0, 0); \
        AT_TRRD(l0, b_); AT_TRRD(h0, b_ + 2048); AT_TRRD(l1, b_ + 4096); AT_TRRD(h1, b_ + 6144); AT_TRRD(l2, b_ + 8192); AT_TRRD(h2, b_ + 10240); AT_TRRD(l3, b_ + 12288); AT_TRRD(h3, b_ + 14336); \
        asm volatile("s_waitcnt lgkmcnt(0)" ::: "memory"); AT_SBAR(); \
        o[d0] = __builtin_amdgcn_mfma_f32_32x32x16_bf16(pa0, (bf16x8){l0[0], l0[1], l0[2], l0[3], h0[0], h0[1], h0[2], h0[3]}, o[d0], 0, 0, 0); \
        o[d0] = __builtin_amdgcn_mfma_f32_32x32x16_bf16(pa1, (bf16x8){l1[0], l1[1], l1[2], l1[3], h1[0], h1[1], h1[2], h1[3]}, o[d0], 0, 0, 0); \
        o[d0] = __builtin_amdgcn_mfma_f32_32x32x16_bf16(pa2, (bf16x8){l2[0], l2[1], l2[2], l2[3], h2[0], h2[1], h2[2], h2[3]}, o[d0], 0, 0, 0); \
        o[d0] = __builtin_amdgcn_mfma_f32_32x32x16_bf16(pa3, (bf16x8){l3[0], l3[1], l3[2], l3[3], h3[0], h3[1], h3[2], h3[3]}, o[d0], 0, 0, 0); } while (0)
    AT_PV_D0(0); AT_PV_D0(1); AT_PV_D0(2); AT_PV_D0(3);
#undef AT_PV_D0
#undef AT_TRRD
}

struct AttnArgs { const bf16* QRAW; const float* SSQ; const float* qg; const float* CS; const bf16* KK; const bf16* VV; bf16* O; };

__device__ __forceinline__ void attn_phase(LAS unsigned char* lds, const AttnArgs& A, int G, int bx) {
    int tid_ = threadIdx.x; asm volatile("" : "+v"(tid_));
    const int tid = tid_, wid = __builtin_amdgcn_readfirstlane(tid >> 6), lane = tid & 63, r32 = lane & 31, hi = lane >> 5;
    unsigned koff[3], voff[2];
#pragma unroll
    for (int i = 0; i < 3; ++i) { const int p = (wid * 3 + i) * 64 + lane, r = p / 24, cs = p % 24, c = (cs & ~7) | ((cs & 7) ^ ((r >> 1) & 7)); koff[i] = (unsigned)(r * 384 + c * 16); }
#pragma unroll
    for (int i = 0; i < 2; ++i) { const int ob = ((wid * 2 + i) * 64 + lane) * 16, sub = ob >> 9, within = ob & 511, kk = (sub >> 2) * 8 + (within >> 6), cc = (sub & 3) * 32 + ((within & 63) >> 1);
        const int k = (kk & ~0xC) | ((kk & 4) << 1) | ((kk & 8) >> 1); voff[i] = (unsigned)(k * 256 + cc * 2); }
    const int fsw = (r32 >> 1) & 7;
    const LAS char* Kl = (const LAS char*)lds + LDS_K + r32 * 384;
    const LAS char* kb0 = Kl + (((0 + hi) ^ fsw) << 4); const LAS char* kb1 = Kl + (((2 + hi) ^ fsw) << 4); const LAS char* kb2 = Kl + (((4 + hi) ^ fsw) << 4); const LAS char* kb3 = Kl + (((6 + hi) ^ fsw) << 4);
    const int vb0 = LDS_V + v_rd_base(lane);
    LAS float* al_l = (LAS float*)(lds + LDS_AL) + wid * 64; LAS float* li_l = al_l + 32;
    const int vcu = (G % 8 == 0) ? (bx % 8) * (G / 8) + bx / 8 : bx;
#define AT_ISSUE(t, buf) do { const char* kg_ = Kg + (size_t)(t) * KTB; const char* vg_ = Vg + (size_t)(t) * VTB; \
        _Pragma("unroll") for (int i_ = 0; i_ < 3; ++i_) __builtin_amdgcn_global_load_lds((const unsigned*)(kg_ + koff[i_]), (LAS unsigned*)(lds + LDS_K + (buf) * KTB + (wid * 3 + i_) * 1024), 16, 0, 0); \
        _Pragma("unroll") for (int i_ = 0; i_ < 2; ++i_) __builtin_amdgcn_global_load_lds((const unsigned*)(vg_ + voff[i_]), (LAS unsigned*)(lds + LDS_V + (buf) * VTB + (wid * 2 + i_) * 1024), 16, 0, 0); } while (0)
    for (int item = vcu; item < NB * NH * 16; item += G) {
        const int bh = item >> 4, pr = item & 15, b = bh / NH, h = bh % NH;
        const char* Kg = (const char*)(A.KK + (size_t)bh * SEQ * DQK); const char* Vg = (const char*)(A.VV + (size_t)bh * SEQ * DV);
        for (int pass = 0; pass < 2; ++pass) {
            const int qb = pass == 0 ? 31 - pr : pr, NT = 4 * (qb + 1), myNT = 4 * qb + (wid >> 1) + 1;
            AT_ISSUE(0, 0);
            bf16x8 qr[12];
            { const int t = b * SEQ + qb * 256 + wid * 32 + r32; const bf16* qp = A.QRAW + (size_t)t * 1536 + h * DQK + hi * 8;
              const f32x2* sq = (const f32x2*)(A.SSQ + (size_t)t * 48 + h * 6); const f32x2 s0 = sq[0], s1 = sq[1], s2 = sq[2];
              const float rq = fast_rsqrt(((s0[0] + s0[1]) + (s1[0] + s1[1]) + (s2[0] + s2[1])) * (1.0f / DQK) + EPS) * (SM_SCALE * 1.4426950408889634f);
              float xt[4][8];
#pragma unroll
              for (int s = 0; s < 12; ++s) { const bf16x8 raw = *(const bf16x8*)(qp + s * 16); const f32x4 g0 = *(const f32x4*)(A.qg + s * 16 + hi * 8), g1 = *(const f32x4*)(A.qg + s * 16 + hi * 8 + 4);
                  float x[8];
#pragma unroll
                  for (int e = 0; e < 8; ++e) x[e] = __uint_as_float(((unsigned)(unsigned short)raw[e]) << 16) * (e < 4 ? g0[e] : g1[e - 4]) * rq;
                  if (s < 8) { u32x4 w; w.x = cvt_pk_bf16(x[0], x[1]); w.y = cvt_pk_bf16(x[2], x[3]); w.z = cvt_pk_bf16(x[4], x[5]); w.w = cvt_pk_bf16(x[6], x[7]); qr[s] = *reinterpret_cast<bf16x8*>(&w); }
                  else {
#pragma unroll
                      for (int e = 0; e < 8; ++e) xt[s - 8][e] = x[e]; } }
#pragma unroll
              for (int s = 0; s < 2; ++s) { const float* cp = A.CS + (size_t)t * 64 + s * 16 + hi * 8;
                  const f32x4 c0 = *(const f32x4*)cp, c1 = *(const f32x4*)(cp + 4), n0 = *(const f32x4*)(cp + 32), n1 = *(const f32x4*)(cp + 36);
                  float y1[8], y2[8];
#pragma unroll
                  for (int e = 0; e < 8; ++e) { const float c = e < 4 ? c0[e] : c1[e - 4], sn = e < 4 ? n0[e] : n1[e - 4]; const float x1 = xt[s][e], x2 = xt[s + 2][e]; y1[e] = x1 * c - x2 * sn; y2[e] = x1 * sn + x2 * c; }
                  u32x4 w; w.x = cvt_pk_bf16(y1[0], y1[1]); w.y = cvt_pk_bf16(y1[2], y1[3]); w.z = cvt_pk_bf16(y1[4], y1[5]); w.w = cvt_pk_bf16(y1[6], y1[7]); qr[8 + s] = *reinterpret_cast<bf16x8*>(&w);
                  u32x4 w2; w2.x = cvt_pk_bf16(y2[0], y2[1]); w2.y = cvt_pk_bf16(y2[2], y2[3]); w2.z = cvt_pk_bf16(y2[4], y2[5]); w2.w = cvt_pk_bf16(y2[6], y2[7]); qr[10 + s] = *reinterpret_cast<bf16x8*>(&w2); } }
            float m_run = -1e30f, l_run = 0.f; f32x16 o[4] = {};
            for (int t = 0; t < NT; t += 2) {
                asm volatile("s_waitcnt vmcnt(0)" ::: "memory"); __builtin_amdgcn_s_barrier();
                AT_ISSUE(t + 1, 1);
                if (t < myNT) tile_compute<0>(o, qr, m_run, l_run, kb0, kb1, kb2, kb3, vb0, al_l, r32, hi);
                asm volatile("s_waitcnt vmcnt(0)" ::: "memory"); __builtin_amdgcn_s_barrier();
                if (t + 2 < NT) AT_ISSUE(t + 2, 0);
                if (t + 1 < myNT) tile_compute<1>(o, qr, m_run, l_run, kb0, kb1, kb2, kb3, vb0, al_l, r32, hi);
            }
            if (hi == 0) li_l[r32] = l_run; asm volatile("s_waitcnt lgkmcnt(0)" ::: "memory");
            bf16* Ow = A.O + (size_t)(b * SEQ + qb * 256 + wid * 32) * D + h * DV + (size_t)(4 * hi) * D + r32;
            asm volatile("" : "+v"(Ow));
#pragma unroll
            for (int r = 0; r < 16; ++r) { const int orow = crow(r, hi); const float rl = __builtin_amdgcn_rcpf(li_l[orow]);
#pragma unroll
                for (int d0 = 0; d0 < 4; ++d0) { const float v = o[d0][r] * rl; const float vn = __shfl_xor(v, 1);
                    if ((r32 & 1) == 0) *(unsigned*)(Ow + (size_t)((r & 3) + 8 * (r >> 2)) * D + d0 * 32) = cvt_pk_bf16(v, vn); } }
        }
    }
    asm volatile("s_waitcnt vmcnt(0)" ::: "memory"); __builtin_amdgcn_s_barrier();
#undef AT_ISSUE
}
#undef AT_SBAR
}

#define XB_TMO      128
#define XB_XCNT(j)  (256  + 64 * (j))
#define XB_XSUB(j)  (1280 + 64 * (j))
#define XB_XGEN(j)  (2304 + 64 * (j))
#define XB_TOP      3328
#define XB_TOPGEN   3392
#define XCD_BAR_WORDS 3456
#define XB_SPIN_CAP (1u << 18)
__device__ __forceinline__ unsigned xb_ld(unsigned* p)              { return __hip_atomic_load(p, __ATOMIC_RELAXED, __HIP_MEMORY_SCOPE_AGENT); }
__device__ __forceinline__ unsigned xb_add(unsigned* p, unsigned v) { return __hip_atomic_fetch_add(p, v, __ATOMIC_RELAXED, __HIP_MEMORY_SCOPE_AGENT); }
__device__ __forceinline__ unsigned xb_xcc_id() { return (unsigned)__builtin_amdgcn_s_getreg((3 << 11) | 20) & 0xFu; }
#define XB_SPIN(cond, bar) do { unsigned _sp = 0; while (cond) { __builtin_amdgcn_s_sleep(1); \
    if ((++_sp & 255u) == 0u) { if (xb_ld(&(bar)[XB_TMO])) break; if (_sp > XB_SPIN_CAP) { atomicAdd(&(bar)[XB_TMO], 1u); break; } } } } while (0)
struct XcdBarrier { unsigned* bar; unsigned x; volatile LAS unsigned* st; };
__device__ __forceinline__ XcdBarrier xcd_barrier_post(unsigned* bar, volatile LAS unsigned* st) {
    XcdBarrier b; b.bar = bar; b.x = xb_xcc_id(); b.st = st;
    if (threadIdx.x == 0) (void)xb_add(&bar[XB_XCNT(b.x)], 1u);
    return b;
}
__device__ __forceinline__ void xcd_barrier_complete(unsigned* bar, unsigned x, unsigned& nloc, unsigned& nx) {
    const unsigned G = gridDim.x * gridDim.y * gridDim.z;
    unsigned sum, cnt, mine, sp = 0u;
    for (;;) {
        sum = 0u; cnt = 0u; mine = 0u;
#pragma unroll
        for (unsigned j = 0; j < 16; ++j) { const unsigned c = xb_ld(&bar[XB_XCNT(j)]); sum += c; cnt += (c > 0u) ? 1u : 0u; mine = (j == x) ? c : mine; }
        if (sum == G) break;
        __builtin_amdgcn_s_sleep(1);
        if ((++sp & 255u) == 0u) { if (xb_ld(&bar[XB_TMO])) break; if (sp > XB_SPIN_CAP) { atomicAdd(&bar[XB_TMO], 1u); break; } }
    }
    nloc = mine > 0u ? mine : 1u; nx = cnt > 0u ? cnt : 1u;
}
__device__ __forceinline__ void xcd_barrier(const XcdBarrier& b) {
    asm volatile("s_waitcnt vmcnt(0)" ::: "memory");
    __syncthreads();
    if (threadIdx.x == 0) {
        unsigned* bar = b.bar;
        __builtin_amdgcn_s_waitcnt(0);
        unsigned nloc = b.st[0], nx = b.st[1];
        if (nloc == 0u) { xcd_barrier_complete(bar, b.x, nloc, nx); b.st[0] = nloc; b.st[1] = nx; }
        const unsigned old = xb_add(&bar[XB_XSUB(b.x)], 1u);
        const unsigned gen = old / nloc;
        if (old + 1u == (gen + 1u) * nloc) {
            __builtin_amdgcn_fence(__ATOMIC_RELEASE, "agent");
            asm volatile("s_waitcnt vmcnt(0)" ::: "memory");
            const unsigned og = xb_add(&bar[XB_TOP], 1u);
            const unsigned tg = og / nx;
            if (og + 1u == (tg + 1u) * nx) xb_add(&bar[XB_TOPGEN], 1u);
            else XB_SPIN(xb_ld(&bar[XB_TOPGEN]) == tg, bar);
            __builtin_amdgcn_fence(__ATOMIC_ACQUIRE, "agent");
            xb_add(&bar[XB_XGEN(b.x)], 1u);
            asm volatile("s_waitcnt vmcnt(0)" ::: "memory");
        } else {
            XB_SPIN(xb_ld(&bar[XB_XGEN(b.x)]) == gen, bar);
            __builtin_amdgcn_fence(__ATOMIC_ACQUIRE, "agent");
            asm volatile("s_waitcnt vmcnt(0)" ::: "memory");
        }
    }
    __syncthreads();
}

constexpr int NWAVES = 8, LDS_BYTES = 160 * 1024, LDS_MISC = 128 * 1024;
constexpr int CW_BAR = 4096;
constexpr int NPHASE = 17;
struct Args { const float* in[30]; float* out; unsigned char* ws; int ph_lo, ph_hi; };

__global__ void __launch_bounds__(NWAVES * 64, 2) fwd(Args a) {
    extern __shared__ __attribute__((aligned(16))) unsigned char lds_raw[];
    LAS unsigned char* lds = (LAS unsigned char*)lds_raw;
    volatile LAS unsigned* MISC = (volatile LAS unsigned*)(lds + LDS_MISC);
    const int tid = threadIdx.x;
    if (tid < 64) MISC[tid] = 0u;
    __syncthreads();
    unsigned char* ws = a.ws; float* H = a.out;
    XcdBarrier bar = xcd_barrier_post((unsigned*)(ws + WS_CTL) + CW_BAR, MISC + 8);
    const int lo = a.ph_lo, hi = a.ph_hi, G = gridDim.x, bx = blockIdx.x;
#define IN(k) (lo <= (k) && (k) < hi)
#define SEAM(k) do { if (IN(k) && IN((k) + 1)) xcd_barrier(bar); } while (0)
    const float* x = a.in[0];
    bf16 *W1t = (bf16*)(ws + WS_W1T), *W2t = (bf16*)(ws + WS_W2T), *Wc = (bf16*)(ws + WS_WC), *Wukv = (bf16*)(ws + WS_WUKV), *Wuq = (bf16*)(ws + WS_WUQ), *Wo = (bf16*)(ws + WS_WO);
    float *RSTD0 = (float*)(ws + WS_RSTD0), *RSTD2 = (float*)(ws + WS_RSTD2), *SSP = (float*)(ws + WS_SSP), *SSQ = (float*)(ws + WS_SSQ), *SSK = (float*)(ws + WS_SSK);
    bf16 *XB = (bf16*)(ws + WS_R1), *HB = XB, *U = (bf16*)(ws + WS_R2), *O = U, *Vb = (bf16*)(ws + WS_R3), *KN = Vb, *VV = (bf16*)(ws + WS_R3 + 64 * MiB),
         *CL = (bf16*)(ws + WS_CL), *QRAW = (bf16*)(ws + WS_QRAW);

    if (IN(1)) { fg::DenseP<fg::EpiGlu> p{(const char*)XB, D, (const char*)W1t, D, {}, {RSTD0, a.in[4], U}}; p.S.init(T, 2048, G, bx); fg::gemm_phase(lds, p); }
    SEAM(1);
    if (IN(3)) { fg::DenseP<fg::EpiRes> p{(const char*)Vb, D, (const char*)W2t, D, {}, {x, a.in[10], H}}; p.S.init(T, D, G, bx); fg::gemm_phase(lds, p); }
    SEAM(3);
    LAS int* pref = (LAS int*)(lds + LDS_MISC + 256); LAS int* cnts = (LAS int*)(lds + LDS_MISC + 512);
    const int* LIST = (const int*)(ws + WS_LIST); const float* RSTD = (const float*)(ws + WS_RSTD); const float* GATE = (const float*)(ws + WS_GATE);
    bf16* XT = XB; bf16* ACT = U; bf16* Y = Vb; const bf16* Wgu = (const bf16*)(ws + WS_WGU); const bf16* Wd = (const bf16*)(ws + WS_WD);
#define MOE_GEMMS(l, p1, p2) do { \
        if (IN(p1)) { fg::moe_setup((const int*)(ws + WS_CTL) + (l) * NE, pref, cnts); \
            fg::MoeP<fg::EpiSwiglu> p{(const char*)XT, D, 1, (const char*)(Wgu + (size_t)(l) * NE * 1024 * D), (size_t)1024 * D * 2, D, LIST, pref, cnts, G, bx, 4 * __builtin_amdgcn_readfirstlane(pref[32]), {RSTD, ACT}}; \
            fg::gemm_phase(lds, p); } \
        SEAM(p1); \
        if (IN(p2)) { fg::moe_setup((const int*)(ws + WS_CTL) + (l) * NE, pref, cnts); \
            fg::MoeP<fg::EpiDown> p{(const char*)ACT, DE, 0, (const char*)(Wd + (size_t)(l) * NE * D * DE), (size_t)D * DE * 2, DE, LIST, pref, cnts, G, bx, 4 * __builtin_amdgcn_readfirstlane(pref[32]), {GATE, Y}}; \
            fg::gemm_phase(lds, p); } \
        SEAM(p2); } while (0)
    MOE_GEMMS(0, 5, 6);
    if (IN(8)) { fg::DenseP<fg::EpiCL> p{(const char*)HB, D, (const char*)Wc, D, {}, {RSTD2, CL, SSP}}; p.S.init(T, NCL, G, bx); fg::gemm_phase(lds, p); }
    SEAM(8);
    if (IN(9)) {
        { fg::DenseP<fg::EpiQ> p{(const char*)(CL + 320), NCL, (const char*)Wuq, QLR, {}, {SSP, QRAW, SSQ}}; p.S.init(T, 1536, G, bx); fg::gemm_phase(lds, p); }
        { fg::DenseP<fg::EpiKV> p{(const char*)CL, NCL, (const char*)Wukv, KVR, {}, {SSP, KN, VV, SSK}}; p.S.init(T, 2048, G, bx); fg::gemm_phase(lds, p); }
    }
    SEAM(9);
    if (IN(11)) { const at::AttnArgs aa{QRAW, SSQ, a.in[21], (const float*)(ws + WS_CS), (const bf16*)(ws + WS_KK), VV, O}; at::attn_phase(lds, aa, G, bx); }
    SEAM(11);
    if (IN(12)) { fg::DenseP<fg::EpiRes> p{(const char*)O, D, (const char*)Wo, D, {}, {H, nullptr, H}}; p.S.init(T, D, G, bx); fg::gemm_phase(lds, p); }
    SEAM(12);
    MOE_GEMMS(1, 14, 15);
#undef MOE_GEMMS
#undef IN
#undef SEAM
}

static inline void gemm_ref(hipStream_t st, const bf16* A, int lda, const bf16* Bt, int ldb, float* C, int ldc, int M, int N, int K) {
    hipLaunchKernelGGL(k_gemm_ref, dim3(N / 64, M / 64, 1), dim3(256), 0, st, A, lda, Bt, ldb, C, ldc, M, N, K, (const int*)nullptr, 0, (const int*)nullptr, (size_t)0);
}
extern "C" void kernel_launch(void* const* d_in, const int* in_sizes, int n_in, void* d_out, int out_size, void* d_ws, size_t ws_size, hipStream_t stream) {
    if (n_in != 30 || ws_size < WS_END || out_size != T * D) { fprintf(stderr, "kernel_launch: unexpected shapes (n_in %d, ws %zu, out %d)\n", n_in, ws_size, out_size); return; }
    static int grid = 0;
    if (!grid) {
        (void)hipFuncSetAttribute((const void*)k_attn_ref, hipFuncAttributeMaxDynamicSharedMemorySize, ATT_REF_LDS);
        (void)hipFuncSetAttribute((const void*)fwd, hipFuncAttributeMaxDynamicSharedMemorySize, LDS_BYTES);
        int dev = 0, cus = 0; (void)hipGetDevice(&dev); if (hipDeviceGetAttribute(&cus, hipDeviceAttributeMultiprocessorCount, dev) != hipSuccess || cus <= 0) cus = 256;
        grid = cus;
    }
    const float* x = (const float*)d_in[0]; const int* positions = (const int*)d_in[1];
    const float *a_norm_g = (const float*)d_in[2], *a_pw1_w = (const float*)d_in[3], *a_dw_w = (const float*)d_in[5], *a_dw_b = (const float*)d_in[6],
                *a_ln_g = (const float*)d_in[7], *a_ln_b = (const float*)d_in[8], *a_pw2_w = (const float*)d_in[9],
                *kv_norm_g = (const float*)d_in[11], *w_dkv = (const float*)d_in[12], *kv_latent_g = (const float*)d_in[13], *w_kr = (const float*)d_in[14], *w_ukv = (const float*)d_in[15],
                *k_norm_g = (const float*)d_in[16], *b_norm_g = (const float*)d_in[17], *w_dq = (const float*)d_in[18], *q_latent_g = (const float*)d_in[19], *w_uq = (const float*)d_in[20],
                *q_norm_g = (const float*)d_in[21], *w_o = (const float*)d_in[22], *ffn_norm_g = (const float*)d_in[23], *w_group = (const float*)d_in[24], *b_group = (const float*)d_in[25],
                *w_router = (const float*)d_in[26], *b_router = (const float*)d_in[27], *w_gate_up = (const float*)d_in[28], *w_down = (const float*)d_in[29];
    char* ws = (char*)d_ws; float* H = (float*)d_out;
    bf16 *W1t = (bf16*)(ws + WS_W1T), *W2t = (bf16*)(ws + WS_W2T), *Wc = (bf16*)(ws + WS_WC), *Wukv = (bf16*)(ws + WS_WUKV), *Wuq = (bf16*)(ws + WS_WUQ), *Wo = (bf16*)(ws + WS_WO),
         *Wgu = (bf16*)(ws + WS_WGU), *Wd = (bf16*)(ws + WS_WD);
    float *Wr = (float*)(ws + WS_WR), *RSTD0 = (float*)(ws + WS_RSTD0), *RSTD = (float*)(ws + WS_RSTD), *RSTD2 = (float*)(ws + WS_RSTD2), *GATE = (float*)(ws + WS_GATE),
          *CS = (float*)(ws + WS_CS), *SSP = (float*)(ws + WS_SSP), *SSQ = (float*)(ws + WS_SSQ), *SSK = (float*)(ws + WS_SSK), *SCR = (float*)(ws + WS_SCR);
    int *CNT = (int*)(ws + WS_CTL), *LIST = (int*)(ws + WS_LIST);
    bf16 *XB = (bf16*)(ws + WS_R1), *XT = XB, *HB = XB, *U = (bf16*)(ws + WS_R2), *ACT = U, *O = U, *Vb = (bf16*)(ws + WS_R3), *Y = Vb, *KN = Vb, *VV = (bf16*)(ws + WS_R3 + 64 * MiB),
         *CL = (bf16*)(ws + WS_CL), *QRAW = (bf16*)(ws + WS_QRAW), *KK = (bf16*)(ws + WS_KK);
    Args a{}; for (int i = 0; i < 30; ++i) a.in[i] = (const float*)d_in[i]; a.out = (float*)d_out; a.ws = (unsigned char*)d_ws;
#define FWD(k) do { a.ph_lo = (k); a.ph_hi = (k) + 1; hipLaunchKernelGGL(fwd, dim3(grid), dim3(NWAVES * 64), LDS_BYTES, stream, a); } while (0)

    (void)hipMemsetAsync(ws + WS_CTL, 0, 1 * MiB, stream);
    (void)hipMemsetAsync(ws + WS_WC + (size_t)704 * D * 2, 0, (size_t)64 * D * 2, stream);
    const dim3 tb(32, 8);
    hipLaunchKernelGGL(k_transpose, dim3(2048 / 32, D / 32, 1), tb, 0, stream, a_pw1_w, D, 2048, W1t, D, 0, a_norm_g, 1024, (size_t)0, (size_t)0, 1, 0);
    hipLaunchKernelGGL(k_transpose, dim3(D / 32, D / 32, 1), tb, 0, stream, a_pw2_w, D, D, W2t, D, 0, (const float*)nullptr, 0, (size_t)0, (size_t)0, 1, 0);
    hipLaunchKernelGGL(k_transpose, dim3(KVR / 32, D / 32, 1), tb, 0, stream, w_dkv, D, KVR, Wc, D, 0, kv_norm_g, 0, (size_t)0, (size_t)0, 1, 0);
    hipLaunchKernelGGL(k_transpose, dim3(DROPE / 32, D / 32, 1), tb, 0, stream, w_kr, D, DROPE, Wc, D, 256, kv_norm_g, 0, (size_t)0, (size_t)0, 1, 0);
    hipLaunchKernelGGL(k_transpose, dim3(QLR / 32, D / 32, 1), tb, 0, stream, w_dq, D, QLR, Wc, D, 320, b_norm_g, 0, (size_t)0, (size_t)0, 1, 0);
    hipLaunchKernelGGL(k_transpose, dim3(2048 / 32, KVR / 32, 1), tb, 0, stream, w_ukv, KVR, 2048, Wukv, KVR, 0, kv_latent_g, 0, (size_t)0, (size_t)0, 1, 0);
    hipLaunchKernelGGL(k_transpose, dim3(1536 / 32, QLR / 32, 1), tb, 0, stream, w_uq, QLR, 1536, Wuq, QLR, 0, q_latent_g, 0, (size_t)0, (size_t)0, 1, 0);
    hipLaunchKernelGGL(k_transpose, dim3(D / 32, D / 32, 1), tb, 0, stream, w_o, D, D, Wo, D, 0, (const float*)nullptr, 0, (size_t)0, (size_t)0, 1, 0);
    hipLaunchKernelGGL(k_transpose, dim3(1024 / 32, D / 32, 2 * NE), tb, 0, stream, w_gate_up, D, 1024, Wgu, D, 0, ffn_norm_g, 512, (size_t)D * 1024, (size_t)1024 * D, NE, D);
    hipLaunchKernelGGL(k_transpose, dim3(D / 32, DE / 32, 2 * NE), tb, 0, stream, w_down, DE, D, Wd, DE, 0, (const float*)nullptr, 0, (size_t)DE * D, (size_t)D * DE, 1, 0);
    hipLaunchKernelGGL(k_router_w, dim3((2 * D * NRT + 255) / 256), dim3(256), 0, stream, w_group, w_router, ffn_norm_g, Wr);
    hipLaunchKernelGGL(k_x_prep, dim3(T / 4), dim3(256), 0, stream, x, XB, RSTD0);
    hipLaunchKernelGGL(k_cs, dim3(T * 32 / 256), dim3(256), 0, stream, positions, CS);
    FWD(1);
    hipLaunchKernelGGL(k_conv, dim3(T * 1024 / 256), dim3(256), 0, stream, U, a_dw_w, a_dw_b, SCR);
    hipLaunchKernelGGL(k_ln_silu, dim3(T / 4), dim3(256), 0, stream, SCR, a_ln_g, a_ln_b, Vb);
    FWD(3);
    for (int l = 0; l < 2; ++l) {
        if (l == 1) {
            FWD(8);
            FWD(9);
            hipLaunchKernelGGL(k_kfin, dim3(T * 8 / 256), dim3(256), 0, stream, KN, CL, SSK, SSP, k_norm_g, CS, KK);
            FWD(11);
            FWD(12);
        }
        hipLaunchKernelGGL(k_route, dim3(T / 4), dim3(256), 0, stream, H, Wr + (size_t)l * D * NRT, b_group + l * NG, b_router + l * NE, XT, RSTD, LIST, CNT + l * NE, GATE);
        FWD(l ? 14 : 5);
        FWD(l ? 15 : 6);
        hipLaunchKernelGGL(k_combine, dim3(T / 4), dim3(256), 0, stream, H, Y, l == 0 ? HB : (bf16*)nullptr, l == 0 ? RSTD2 : (float*)nullptr);
    }
}
```

```cpp
#include <hip/hip_runtime.h>
#include <stdint.h>
#include <stdio.h>

typedef unsigned short bf16;
constexpr int NB = 4, SEQ = 8192, T = NB * SEQ, D = 1024, NH = 8, DQK = 192, DNOPE = 128, DROPE = 64, DV = 128, KVR = 256, QLR = 384;
constexpr int NE = 32, NG = 4, EPG = 8, DE = 512, CONVW = 31, NCL = 768, NRT = 36;
constexpr float EPS = 1e-6f;
constexpr float SM_SCALE = 0.07216878364870322f;

constexpr size_t MiB = 1u << 20;
constexpr size_t WS_CTL = 0, WS_W1T = 1 * MiB, WS_W2T = 5 * MiB, WS_WC = 7 * MiB, WS_WUKV = 9 * MiB, WS_WUQ = 10 * MiB, WS_WO = 12 * MiB, WS_WR = 14 * MiB,
                 WS_WGU = 16 * MiB, WS_WD = 144 * MiB, WS_RSTD0 = 208 * MiB, WS_RSTD = WS_RSTD0 + 256 * 1024, WS_RSTD2 = WS_RSTD0 + 512 * 1024,
                 WS_GATE = 209 * MiB, WS_LIST = 210 * MiB, WS_CS = 214 * MiB, WS_SSP = 222 * MiB, WS_SSQ = 226 * MiB, WS_SSK = 232 * MiB,
                 WS_R1 = 236 * MiB, WS_R2 = 300 * MiB, WS_R3 = 364 * MiB, WS_CL = 492 * MiB, WS_QRAW = 540 * MiB, WS_KK = 636 * MiB, WS_SCR = 732 * MiB, WS_END = 988 * MiB;

__device__ const float INV_FREQ[32] = {
    1.0f, 0.7498942093324559f, 0.5623413251903491f, 0.4216965034285822f, 0.31622776601683794f, 0.23713737056616552f, 0.1778279410038923f, 0.1333521432163324f,
    0.1f, 0.07498942093324558f, 0.05623413251903491f, 0.04216965034285822f, 0.03162277660168379f, 0.023713737056616554f, 0.01778279410038923f, 0.01333521432163324f,
    0.01f, 0.007498942093324558f, 0.005623413251903491f, 0.004216965034285823f, 0.0031622776601683794f, 0.0023713737056616554f, 0.001778279410038923f, 0.001333521432163324f,
    0.001f, 0.0007498942093324559f, 0.0005623413251903491f, 0.00042169650342858224f, 0.00031622776601683794f, 0.00023713737056616554f, 0.0001778279410038923f, 0.0001333521432163324f};

__device__ __forceinline__ float bf2f(bf16 b) { return __uint_as_float(((unsigned)b) << 16); }
__device__ __forceinline__ bf16 f2bf(float f) { unsigned u = __float_as_uint(f); u += 0x7fffu + ((u >> 16) & 1u); return (bf16)(u >> 16); }
__device__ __forceinline__ float wave_sum(float v) {
#pragma unroll
    for (int o = 1; o < 64; o <<= 1) v += __shfl_xor(v, o);
    return v;
}
__device__ __forceinline__ float sigmoidf_(float x) { return 1.0f / (1.0f + __expf(-x)); }
__device__ __forceinline__ float siluf_(float x) { return x / (1.0f + __expf(-x)); }
__host__ __device__ __forceinline__ int pair_row(int n, int half) { const int j = n % half, hf = n / half; return 256 * (j / 128) + 128 * hf + (j % 128); }

__device__ __forceinline__ void sincos_d(double a, double& s, double& c) {
    const double TWO_PI = 6.283185307179586476925287, PI = 3.14159265358979323846;
    double k = __builtin_rint(a / TWO_PI); double r = a - k * TWO_PI;
    double q = __builtin_rint(r / (PI * 0.5)); double y = r - q * (PI * 0.5); int qi = ((int)q) & 3;
    const double y2 = y * y;
    double sp = y * (1.0 + y2 * (-1.0 / 6 + y2 * (1.0 / 120 + y2 * (-1.0 / 5040 + y2 * (1.0 / 362880 + y2 * (-1.0 / 39916800 + y2 * (1.0 / 6227020800.0)))))));
    double cp = 1.0 + y2 * (-0.5 + y2 * (1.0 / 24 + y2 * (-1.0 / 720 + y2 * (1.0 / 40320 + y2 * (-1.0 / 3628800 + y2 * (1.0 / 479001600.0 + y2 * (-1.0 / 87178291200.0)))))));
    if (qi == 0) { s = sp; c = cp; } else if (qi == 1) { s = cp; c = -sp; } else if (qi == 2) { s = -sp; c = -cp; } else { s = -cp; c = sp; }
}

constexpr int NWAVES_ = 8;
#define LAS __attribute__((address_space(3)))
#define GAS __attribute__((address_space(1)))
typedef short bf16x8 __attribute__((ext_vector_type(8)));
typedef float f32x4 __attribute__((ext_vector_type(4)));
typedef float f32x2 __attribute__((ext_vector_type(2)));
typedef unsigned u32x4 __attribute__((ext_vector_type(4)));
typedef unsigned u32x2 __attribute__((ext_vector_type(2)));

__device__ __forceinline__ unsigned cvt_pk_bf16(float lo, float hi) { unsigned r; asm volatile("v_cvt_pk_bf16_f32 %0, %1, %2" : "=v"(r) : "v"(lo), "v"(hi)); return r; }
__device__ __forceinline__ float fast_sigmoid(float x) { return __builtin_amdgcn_rcpf(1.0f + __builtin_amdgcn_exp2f(-1.4426950408889634f * x)); }
__device__ __forceinline__ float fast_rsqrt(float x) { return 1.0f / sqrtf(x); }

namespace fg {
constexpr int BM = 256, BK = 64, HALF = 128, HTB = HALF * BK * 2, STAGE_BYTES = 8 * HTB, NXCD = 8, WGM = 8;
__host__ __device__ __forceinline__ int lds_byte(int r, int c) { const int st = (r >> 4) * 2 + (c >> 5), rr = r & 15, cc = c & 31, ob = rr * 64 + cc * 2; return st * 1024 + (ob ^ (((ob >> 9) & 1) << 5)); }
__host__ __device__ __forceinline__ void stage_rc(int b, int& R, int& C) { const int st = b / 1024, sb = b % 1024, swz = sb ^ (((sb >> 9) & 1) << 5); R = (st >> 1) * 16 + swz / 64; C = (st & 1) * 32 + (swz % 64) / 2; }
__host__ __device__ __forceinline__ int perm32(int rho) { const int n = rho >> 4, i = rho & 15; return 8 * (i >> 2) + 4 * n + (i & 3); }
struct Unit { int pm, pn, e, nvalid; };
typedef f32x4 Acc[2][2][4][2];

struct StaticOrder {
    int nM, nN, nwg, G, c;
    __device__ void init(int M, int N, int G_, int c_) { nM = M / BM; nN = N / BM; nwg = nM * nN; G = G_; c = c_; }
    __device__ bool next(int i, Unit& u) const {
        const long L = (long)i * G + c; if (L >= nwg) return false;
        int wgid = (int)L; { const int q = nwg / NXCD, r = nwg % NXCD, xcd = wgid % NXCD, off = wgid / NXCD; wgid = (xcd < r ? xcd * (q + 1) : r * (q + 1) + (xcd - r) * q) + off; }
        const int nig = WGM * nN, gid = wgid / nig, fm = gid * WGM, gsz = (nM - fm) < WGM ? (nM - fm) : WGM;
        u.pm = fm + ((wgid % nig) % gsz); u.pn = (wgid % nig) / gsz; u.e = 0; u.nvalid = 256; return true;
    }
};

template <class P>
__device__ __forceinline__ void gemm_phase(LAS unsigned char* lds, const P& p) {
    int tid_ = threadIdx.x; asm volatile("" : "+v"(tid_));
    const int tid = tid_, wid = __builtin_amdgcn_readfirstlane(tid >> 6), lane = tid & 63, wr = wid >> 2, wc = wid & 3, fr = lane & 15, fq = lane >> 4;
    const int K = p.K, nt = K / BK;
    int sR[2], sC[2]; unsigned voffB[2];
#pragma unroll
    for (int i = 0; i < 2; ++i) { int R, C; stage_rc(tid * 16 + i * 8192, R, C); sR[i] = R; sC[i] = C; const int Rb = P::PERM ? ((R & ~31) + perm32(R & 31)) : R; voffB[i] = (unsigned)(Rb * K + C) * 2u; }
    const size_t kstep = (size_t)(BK * 2), hstepB = (size_t)HALF * K * 2;
    const unsigned ldsw = (unsigned)wid * 1024u;
    const int aoff = lds_byte(wr * 64 + fr, fq * 8), boff = lds_byte(wc * 32 + fr, fq * 8);
#define FG_SA(b, h) (((b) * 2 + (h)) * HTB)
#define FG_SB(b, h) ((4 + (b) * 2 + (h)) * HTB)
#define FG_STAGE(bufoff, gbase, voff) do { _Pragma("unroll") for (int _i = 0; _i < 2; ++_i) \
        __builtin_amdgcn_global_load_lds((const unsigned*)((const char*)(gbase) + (voff)[_i]), (LAS unsigned*)(lds + (bufoff) + ldsw + _i * 8192), 16, 0, 0); } while (0)
#define FG_LDA(dst, b, h) do { _Pragma("unroll") for (int m = 0; m < 4; ++m) _Pragma("unroll") for (int k = 0; k < 2; ++k) dst[m][k] = *(const LAS bf16x8*)(lds + FG_SA(b, h) + aoff + m * 2048 + k * 1024); } while (0)
#define FG_LDB(dst, b, h) do { _Pragma("unroll") for (int n = 0; n < 2; ++n) _Pragma("unroll") for (int k = 0; k < 2; ++k) dst[n][k] = *(const LAS bf16x8*)(lds + FG_SB(b, h) + boff + n * 2048 + k * 1024); } while (0)
#define FG_MMA(ai, bj, At, Bt) do { __builtin_amdgcn_s_setprio(1); _Pragma("unroll") for (int m = 0; m < 4; ++m) _Pragma("unroll") for (int n = 0; n < 2; ++n) _Pragma("unroll") for (int k = 0; k < 2; ++k) \
        acc[ai][bj][m][n] = __builtin_amdgcn_mfma_f32_16x16x32_bf16(Bt[n][k], At[m][k], acc[ai][bj][m][n], 0, 0, 0); __builtin_amdgcn_s_setprio(0); } while (0)
#define FG_WAIT_V(n) asm volatile("s_waitcnt vmcnt(" #n ")" ::: "memory")
#define FG_WAIT_L(n) asm volatile("s_waitcnt lgkmcnt(" #n ")" ::: "memory")
#define FG_BAR __builtin_amdgcn_s_barrier()
#define FG_SCHED __builtin_amdgcn_sched_barrier(0)
    Unit cur, nxt, nn; int ui = 0;
    if (!p.next(0, cur)) return;
    unsigned ao[4], nao[4], nnao[4];
    p.a_off(cur, sR, sC, ao);
    bool has_next = p.next(1, nxt);
    if (has_next) p.a_off(nxt, sR, sC, nao); else { nxt = cur; _Pragma("unroll") for (int j = 0; j < 4; ++j) nao[j] = ao[j]; }
    Acc acc;
#pragma unroll
    for (int a = 0; a < 2; ++a)
#pragma unroll
        for (int b = 0; b < 2; ++b)
#pragma unroll
            for (int m = 0; m < 4; ++m)
#pragma unroll
                for (int n = 0; n < 2; ++n) acc[a][b][m][n] = (f32x4){0.f, 0.f, 0.f, 0.f};
    bf16x8 At[4][2], B0[2][2], B1[2][2];
    const char* const Ab = p.A;
    const char* cB = p.b_base(cur);
    FG_STAGE(FG_SB(0, 0), cB, voffB); FG_STAGE(FG_SB(0, 1), cB + hstepB, voffB); FG_STAGE(FG_SA(0, 0), Ab, ao); FG_STAGE(FG_SA(0, 1), Ab, ao + 2);
    if (wr == 1) FG_BAR;
    FG_WAIT_V(2); FG_BAR;
    FG_STAGE(FG_SB(1, 0), cB + kstep, voffB); FG_STAGE(FG_SA(1, 0), Ab + kstep, ao); FG_STAGE(FG_SB(1, 1), cB + hstepB + kstep, voffB);
    FG_WAIT_V(6); FG_BAR;
    for (;;) {
        const char* nB = has_next ? p.b_base(nxt) : cB;
        for (int t = 0; t < nt; t += 2) {
            const bool last = (t == nt - 2);
            const char* a1 = Ab + (size_t)(t + 1) * kstep;
            const char* a2 = last ? Ab : Ab + (size_t)(t + 2) * kstep; const char* b2 = last ? nB : cB + (size_t)(t + 2) * kstep;
            const char* a3 = a2 + kstep; const char* b3 = b2 + kstep;
            unsigned so[4];
#pragma unroll
            for (int j = 0; j < 4; ++j) so[j] = last ? nao[j] : ao[j];
            FG_LDB(B0, 0, 0); FG_LDB(B1, 0, 1); FG_SCHED; FG_LDA(At, 0, 0); FG_STAGE(FG_SA(1, 1), a1, ao + 2);
            FG_WAIT_V(8); FG_WAIT_L(0); FG_BAR; FG_MMA(0, 0, At, B0); FG_MMA(0, 1, At, B1); FG_BAR; FG_SCHED;
            FG_LDA(At, 0, 1); FG_STAGE(FG_SB(0, 0), b2, voffB); FG_STAGE(FG_SB(0, 1), b2 + hstepB, voffB); FG_STAGE(FG_SA(0, 0), a2, so);
            FG_WAIT_V(8); FG_WAIT_L(0); FG_BAR; FG_MMA(1, 0, At, B0); FG_MMA(1, 1, At, B1); FG_BAR; FG_SCHED;
            FG_LDB(B0, 1, 0); FG_LDB(B1, 1, 1); FG_SCHED; FG_LDA(At, 1, 0); FG_STAGE(FG_SA(0, 1), a2, so + 2);
            FG_WAIT_V(8); FG_WAIT_L(0); FG_BAR; FG_MMA(0, 0, At, B0); FG_MMA(0, 1, At, B1); FG_BAR; FG_SCHED;
            FG_LDA(At, 1, 1); FG_STAGE(FG_SB(1, 0), b3, voffB); FG_STAGE(FG_SB(1, 1), b3 + hstepB, voffB); FG_STAGE(FG_SA(1, 0), a3, so);
            FG_WAIT_V(8); FG_WAIT_L(0); FG_BAR; FG_MMA(1, 0, At, B0); FG_MMA(1, 1, At, B1); FG_BAR; FG_SCHED;
        }
        if (wr == 0) FG_BAR;
        p.epi(acc, cur, wr, wc, fr, fq);
        if (!has_next) break;
        const bool has_nn = p.next(ui + 2, nn);
        if (has_nn) p.a_off(nn, sR, sC, nnao); else { nn = nxt; _Pragma("unroll") for (int j = 0; j < 4; ++j) nnao[j] = nao[j]; }
#pragma unroll
        for (int a = 0; a < 2; ++a)
#pragma unroll
            for (int b = 0; b < 2; ++b)
#pragma unroll
                for (int m = 0; m < 4; ++m)
#pragma unroll
                    for (int n = 0; n < 2; ++n) acc[a][b][m][n] = (f32x4){0.f, 0.f, 0.f, 0.f};
        cur = nxt; cB = nB; nxt = nn; has_next = has_nn; ++ui;
#pragma unroll
        for (int j = 0; j < 4; ++j) { ao[j] = nao[j]; nao[j] = nnao[j]; }
        if (wr == 1) FG_BAR;
    }
    FG_WAIT_V(0);
    FG_BAR;
#undef FG_SA
#undef FG_SB
#undef FG_STAGE
#undef FG_LDA
#undef FG_LDB
#undef FG_MMA
#undef FG_WAIT_V
#undef FG_WAIT_L
#undef FG_BAR
#undef FG_SCHED
}

template <class Epi> struct DenseP {
    static constexpr bool PERM = Epi::PERM;
    const char* A; int lda; const char* Bt; int K; StaticOrder S; Epi E;
    __device__ __forceinline__ bool next(int i, Unit& u) const { return S.next(i, u); }
    __device__ __forceinline__ const char* b_base(const Unit& u) const { return Bt + (size_t)u.pn * BM * K * 2; }
    __device__ __forceinline__ void a_off(const Unit& u, const int (&sR)[2], const int (&sC)[2], unsigned (&ao)[4]) const {
#pragma unroll
        for (int h = 0; h < 2; ++h)
#pragma unroll
            for (int i = 0; i < 2; ++i) ao[h * 2 + i] = (unsigned)((u.pm * BM + h * HALF + sR[i]) * lda + sC[i]) * 2u;
    }
    __device__ __forceinline__ void epi(const Acc& acc, const Unit& u, int wr, int wc, int fr, int fq) const { E(acc, u, wr, wc, fr, fq); }
};

struct EpiGlu {
    static constexpr bool PERM = true;
    const float* rstd; const float* bias; bf16* U;
    __device__ __forceinline__ void operator()(const Acc& acc, const Unit& u, int wr, int wc, int fr, int fq) const {
        const int col = u.pn * 128 + wc * 32 + fq * 8, row0 = u.pm * BM + wr * 64 + fr;
        const f32x4 ba0 = *(const f32x4*)(bias + col), ba1 = *(const f32x4*)(bias + col + 4), bg0 = *(const f32x4*)(bias + 1024 + col), bg1 = *(const f32x4*)(bias + 1024 + col + 4);
        float rsv[8];
#pragma unroll
        for (int q = 0; q < 8; ++q) rsv[q] = rstd[row0 + (q >> 2) * HALF + (q & 3) * 16];
#pragma unroll
        for (int ai = 0; ai < 2; ++ai)
#pragma unroll
            for (int m = 0; m < 4; ++m) { const int row = row0 + ai * HALF + m * 16; const float rs = rsv[ai * 4 + m];
                const f32x4 a0 = acc[ai][0][m][0] * rs + ba0, a1 = acc[ai][0][m][1] * rs + ba1, g0 = acc[ai][1][m][0] * rs + bg0, g1 = acc[ai][1][m][1] * rs + bg1;
                float o[8];
#pragma unroll
                for (int j = 0; j < 4; ++j) { o[j] = a0[j] * fast_sigmoid(g0[j]); o[4 + j] = a1[j] * fast_sigmoid(g1[j]); }
                u32x4 w; w.x = cvt_pk_bf16(o[0], o[1]); w.y = cvt_pk_bf16(o[2], o[3]); w.z = cvt_pk_bf16(o[4], o[5]); w.w = cvt_pk_bf16(o[6], o[7]);
                *(u32x4*)(U + (size_t)row * D + col) = w; }
    }
};
struct EpiRes {
    static constexpr bool PERM = false;
    const float* base; const float* bias; float* out;
    __device__ __forceinline__ void operator()(const Acc& acc, const Unit& u, int wr, int wc, int fr, int fq) const {
        const int row0 = u.pm * BM + wr * 64 + fr, col0 = u.pn * BM + wc * 32 + 4 * fq;
        f32x4 bv[2][2];
#pragma unroll
        for (int bj = 0; bj < 2; ++bj)
#pragma unroll
            for (int n = 0; n < 2; ++n) bv[bj][n] = bias ? *(const f32x4*)(bias + col0 + bj * HALF + n * 16) : (f32x4){0.f, 0.f, 0.f, 0.f};
#pragma unroll
        for (int ai = 0; ai < 2; ++ai)
#pragma unroll
        for (int mh = 0; mh < 2; ++mh) {
            f32x4 bs[2][2][2];
#pragma unroll
            for (int m2 = 0; m2 < 2; ++m2) { const size_t off = (size_t)(row0 + ai * HALF + (mh * 2 + m2) * 16) * D + col0;
#pragma unroll
                for (int bj = 0; bj < 2; ++bj)
#pragma unroll
                    for (int n = 0; n < 2; ++n) bs[m2][bj][n] = *(const f32x4*)(base + off + bj * HALF + n * 16); }
            asm volatile("" ::: "memory");
#pragma unroll
            for (int m2 = 0; m2 < 2; ++m2) { const int m = mh * 2 + m2; const size_t off = (size_t)(row0 + ai * HALF + m * 16) * D + col0;
#pragma unroll
                for (int bj = 0; bj < 2; ++bj)
#pragma unroll
                    for (int n = 0; n < 2; ++n) *(f32x4*)(out + off + bj * HALF + n * 16) = bs[m2][bj][n] + acc[ai][bj][m][n] + bv[bj][n]; }
            asm volatile("" ::: "memory");
        }
    }
};
__device__ __forceinline__ float quad_sum(float s) { s += __shfl_xor(s, 16); s += __shfl_xor(s, 32); return s; }
__device__ __forceinline__ u32x4 pack8(const f32x4 a, const f32x4 b) { u32x4 w; w.x = cvt_pk_bf16(a[0], a[1]); w.y = cvt_pk_bf16(a[2], a[3]); w.z = cvt_pk_bf16(b[0], b[1]); w.w = cvt_pk_bf16(b[2], b[3]); return w; }
__device__ __forceinline__ float sumsq8(const f32x4 a, const f32x4 b) { return (a[0] * a[0] + a[1] * a[1]) + (a[2] * a[2] + a[3] * a[3]) + (b[0] * b[0] + b[1] * b[1]) + (b[2] * b[2] + b[3] * b[3]); }
struct EpiCL {
    static constexpr bool PERM = true;
    const float* rstd2; bf16* CL; float* SSP;
    __device__ __forceinline__ void operator()(const Acc& acc, const Unit& u, int wr, int wc, int fr, int fq) const {
        const int row0 = u.pm * BM + wr * 64 + fr;
        float rsv[8];
#pragma unroll
        for (int q = 0; q < 8; ++q) rsv[q] = rstd2[row0 + (q >> 2) * HALF + (q & 3) * 16];
#pragma unroll
        for (int ai = 0; ai < 2; ++ai)
#pragma unroll
            for (int m = 0; m < 4; ++m) { const int row = row0 + ai * HALF + m * 16; const float rs = rsv[ai * 4 + m];
#pragma unroll
                for (int bj = 0; bj < 2; ++bj) { const f32x4 v0 = acc[ai][bj][m][0] * rs, v1 = acc[ai][bj][m][1] * rs; const float ss = quad_sum(sumsq8(v0, v1));
                    *(u32x4*)(CL + (size_t)row * NCL + u.pn * BM + bj * HALF + wc * 32 + fq * 8) = pack8(v0, v1);
                    const int g = u.pn * 8 + bj * 4 + wc; if (fq == 0) SSP[row * 32 + (g < 10 ? g : g + 2)] = ss; } }
    }
};
struct EpiQ {
    static constexpr bool PERM = true;
    const float* SSP; bf16* QRAW; float* SSQ;
    __device__ __forceinline__ void operator()(const Acc& acc, const Unit& u, int wr, int wc, int fr, int fq) const {
        const int row0 = u.pm * BM + wr * 64 + fr;
        float rsv[8];
#pragma unroll
        for (int q = 0; q < 8; ++q) { const int row = row0 + (q >> 2) * HALF + (q & 3) * 16;
            const f32x4 s0 = *(const f32x4*)(SSP + row * 32 + 12), s1 = *(const f32x4*)(SSP + row * 32 + 16), s2 = *(const f32x4*)(SSP + row * 32 + 20);
            rsv[q] = ((s0[0] + s0[1]) + (s0[2] + s0[3])) + ((s1[0] + s1[1]) + (s1[2] + s1[3])) + ((s2[0] + s2[1]) + (s2[2] + s2[3]));
            if (q == 3) asm volatile("" : "+v"(rsv[0]), "+v"(rsv[1]), "+v"(rsv[2]), "+v"(rsv[3]) :: "memory"); }
#pragma unroll
        for (int q = 0; q < 8; ++q) rsv[q] = fast_rsqrt(rsv[q] * (1.0f / QLR) + EPS);
#pragma unroll
        for (int ai = 0; ai < 2; ++ai)
#pragma unroll
            for (int m = 0; m < 4; ++m) { const int row = row0 + ai * HALF + m * 16; const float rs = rsv[ai * 4 + m];
#pragma unroll
                for (int bj = 0; bj < 2; ++bj) { const f32x4 v0 = acc[ai][bj][m][0] * rs, v1 = acc[ai][bj][m][1] * rs; const float ss = quad_sum(sumsq8(v0, v1));
                    *(u32x4*)(QRAW + (size_t)row * 1536 + u.pn * BM + bj * HALF + wc * 32 + fq * 8) = pack8(v0, v1);
                    if (fq == 0) SSQ[row * 48 + u.pn * 8 + bj * 4 + wc] = ss; } }
    }
};
struct EpiKV {
    static constexpr bool PERM = true;
    const float* SSP; bf16* KN; bf16* VV; float* SSK;
    __device__ __forceinline__ void operator()(const Acc& acc, const Unit& u, int wr, int wc, int fr, int fq) const {
        const int row0 = u.pm * BM + wr * 64 + fr;
        float rsv[8];
#pragma unroll
        for (int q = 0; q < 8; ++q) { const int row = row0 + (q >> 2) * HALF + (q & 3) * 16;
            const f32x4 s0 = *(const f32x4*)(SSP + row * 32), s1 = *(const f32x4*)(SSP + row * 32 + 4);
            rsv[q] = ((s0[0] + s0[1]) + (s0[2] + s0[3])) + ((s1[0] + s1[1]) + (s1[2] + s1[3])); }
#pragma unroll
        for (int q = 0; q < 8; ++q) rsv[q] = fast_rsqrt(rsv[q] * (1.0f / KVR) + EPS);
#pragma unroll
        for (int ai = 0; ai < 2; ++ai)
#pragma unroll
            for (int m = 0; m < 4; ++m) { const int row = row0 + ai * HALF + m * 16; const float rs = rsv[ai * 4 + m];
                { const f32x4 v0 = acc[ai][0][m][0] * rs, v1 = acc[ai][0][m][1] * rs; const float ss = quad_sum(sumsq8(v0, v1));
                  *(u32x4*)(KN + (size_t)row * D + u.pn * 128 + wc * 32 + fq * 8) = pack8(v0, v1);
                  if (fq == 0) SSK[row * 32 + u.pn * 4 + wc] = ss; }
                { const f32x4 v0 = acc[ai][1][m][0] * rs, v1 = acc[ai][1][m][1] * rs; const int b = row / SEQ, sq = row % SEQ;
                  *(u32x4*)(VV + (((size_t)b * NH + u.pn) * SEQ + sq) * DV + wc * 32 + fq * 8) = pack8(v0, v1); } }
    }
};

__device__ __forceinline__ void moe_setup(const int* CNT, LAS int* pref, LAS int* cnts) {
    const int tid = threadIdx.x;
    if (tid < 64) { const int c = tid < 32 ? (int)__hip_atomic_load((const unsigned*)CNT + tid, __ATOMIC_RELAXED, __HIP_MEMORY_SCOPE_AGENT) : 0; int incl = (c + 255) >> 8;
#pragma unroll
        for (int o = 1; o < 32; o <<= 1) { const int v = __shfl_up(incl, o); if (tid >= o) incl += v; }
        if (tid < 32) { pref[tid + 1] = incl; cnts[tid] = c; } if (tid == 0) pref[0] = 0; }
    __syncthreads();
}
template <class Epi> struct MoeP {
    static constexpr bool PERM = true;
    const char* A; int lda; int a_shift; const char* Bt; size_t b_estride; int K; const int* LIST; const LAS int* pref; const LAS int* cnts; int G, c, nunits; Epi E;
    __device__ __forceinline__ bool next(int i, Unit& u) const {
        const int L = i * G + c; if (L >= nunits) return false;
        const int r = L >> 2, lane = threadIdx.x & 63; const int v = pref[(lane & 31) + 1];
        const int e = __builtin_popcountll(__ballot(lane < 32 && r >= v));
        u.pn = L & 3; u.e = e; u.pm = r - __builtin_amdgcn_readfirstlane(pref[e]); const int rem = __builtin_amdgcn_readfirstlane(cnts[e]) - BM * u.pm; u.nvalid = rem < BM ? rem : BM; return true;
    }
    __device__ __forceinline__ const char* b_base(const Unit& u) const { return Bt + (size_t)u.e * b_estride + (size_t)u.pn * BM * K * 2; }
    __device__ __forceinline__ void a_off(const Unit& u, const int (&sR)[2], const int (&sC)[2], unsigned (&ao)[4]) const {
        const int* lp = LIST + (size_t)u.e * T + u.pm * BM;
#pragma unroll
        for (int h = 0; h < 2; ++h)
#pragma unroll
            for (int i = 0; i < 2; ++i) { const int row = h * HALF + sR[i]; int ent = lp[row]; ent = row < u.nvalid ? ent : 0; ao[h * 2 + i] = (unsigned)((ent >> a_shift) * lda + sC[i]) * 2u; }
    }
    __device__ __forceinline__ void epi(const Acc& acc, const Unit& u, int wr, int wc, int fr, int fq) const { E(acc, u, wr, wc, fr, fq, LIST + (size_t)u.e * T + u.pm * BM); }
};
struct EpiSwiglu {
    const float* rstd; bf16* ACT;
    __device__ __forceinline__ void operator()(const Acc& acc, const Unit& u, int wr, int wc, int fr, int fq, const int* lp) const {
        int ent[8]; float rsv[8];
#pragma unroll
        for (int q = 0; q < 8; ++q) { const int row = (q >> 2) * HALF + wr * 64 + (q & 3) * 16 + fr; const int e0 = lp[row]; ent[q] = row < u.nvalid ? e0 : -1; }
#pragma unroll
        for (int q = 0; q < 8; ++q) rsv[q] = rstd[(ent[q] < 0 ? 0 : ent[q]) >> 1];
#pragma unroll
        for (int ai = 0; ai < 2; ++ai)
#pragma unroll
            for (int m = 0; m < 4; ++m) { const int q = ai * 4 + m; const float rs = rsv[q];
                const f32x4 a0 = acc[ai][0][m][0] * rs, a1 = acc[ai][0][m][1] * rs, b0 = acc[ai][1][m][0] * rs, b1 = acc[ai][1][m][1] * rs;
                float o[8];
#pragma unroll
                for (int j = 0; j < 4; ++j) { o[j] = a0[j] * fast_sigmoid(a0[j]) * b0[j]; o[4 + j] = a1[j] * fast_sigmoid(a1[j]) * b1[j]; }
                u32x4 w; w.x = cvt_pk_bf16(o[0], o[1]); w.y = cvt_pk_bf16(o[2], o[3]); w.z = cvt_pk_bf16(o[4], o[5]); w.w = cvt_pk_bf16(o[6], o[7]);
                if (ent[q] >= 0) *(u32x4*)(ACT + (size_t)ent[q] * DE + u.pn * 128 + wc * 32 + fq * 8) = w; }
    }
};
struct EpiDown {
    const float* gate; bf16* Y;
    __device__ __forceinline__ void operator()(const Acc& acc, const Unit& u, int wr, int wc, int fr, int fq, const int* lp) const {
        int ent[8]; float gv[8];
#pragma unroll
        for (int q = 0; q < 8; ++q) { const int row = (q >> 2) * HALF + wr * 64 + (q & 3) * 16 + fr; const int e0 = lp[row]; ent[q] = row < u.nvalid ? e0 : -1; }
#pragma unroll
        for (int q = 0; q < 8; ++q) gv[q] = gate[ent[q] < 0 ? 0 : ent[q]];
#pragma unroll
        for (int ai = 0; ai < 2; ++ai)
#pragma unroll
            for (int m = 0; m < 4; ++m) { const int q = ai * 4 + m; const float g = gv[q];
                if (ent[q] >= 0) {
#pragma unroll
                    for (int bj = 0; bj < 2; ++bj) *(u32x4*)(Y + (size_t)ent[q] * D + u.pn * BM + bj * HALF + wc * 32 + fq * 8) = pack8(acc[ai][bj][m][0] * g, acc[ai][bj][m][1] * g); } }
    }
};
}


namespace at {
typedef short s16x4 __attribute__((ext_vector_type(4)));
typedef float f32x16 __attribute__((ext_vector_type(16)));
constexpr int KTB = 64 * 384, VTB = 64 * 256, LDS_K = 0, LDS_V = 2 * KTB, LDS_AL = LDS_V + 2 * VTB, LDS_TOTAL = LDS_AL + 8 * 256;
constexpr float THR2 = 11.0f;
__device__ __forceinline__ int v_rd_base(int lane) { return ((lane & 3) << 3) | (((lane >> 2) & 3) << 6) | (((lane >> 4) & 1) << 5) | (((lane >> 5) & 1) << 8); }
constexpr int v_rd_off(int d0, int ks, int half) { return d0 * 512 + ks * 4096 + half * 2048; }
__device__ __forceinline__ int crow(int r, int hi) { return (r & 3) + 8 * (r >> 2) + 4 * hi; }
#define AT_SBAR() __builtin_amdgcn_sched_barrier(0)

template <int BUF>
__device__ __forceinline__ void tile_compute(f32x16 (&o)[4], const bf16x8 (&qr)[12], float& m_run, float& l_run, const LAS char* kb0, const LAS char* kb1, const LAS char* kb2, const LAS char* kb3,
                                             int vb0, LAS float* al_l, int r32, int hi) {
    f32x16 p0 = {}, p1 = {};
#pragma unroll
    for (int s = 0; s < 12; ++s) { const LAS char* a = ((s & 3) == 0 ? kb0 : (s & 3) == 1 ? kb1 : (s & 3) == 2 ? kb2 : kb3) + (s >> 2) * 128 + BUF * KTB;
        const bf16x8 k0 = *(const LAS bf16x8*)a, k1 = *(const LAS bf16x8*)(a + 32 * 384);
        p0 = __builtin_amdgcn_mfma_f32_32x32x16_bf16(k0, qr[s], p0, 0, 0, 0);
        p1 = __builtin_amdgcn_mfma_f32_32x32x16_bf16(k1, qr[s], p1, 0, 0, 0); }
    float pmax = p0[0];
#pragma unroll
    for (int r = 1; r < 16; ++r) pmax = fmaxf(pmax, p0[r]);
#pragma unroll
    for (int r = 0; r < 16; ++r) pmax = fmaxf(pmax, p1[r]);
    { auto rr = __builtin_amdgcn_permlane32_swap(__float_as_uint(pmax), __float_as_uint(pmax), false, false); pmax = fmaxf(__uint_as_float(rr[0]), __uint_as_float(rr[1])); }
    float alpha = 1.f;
    if (!__all(pmax - m_run <= THR2)) { const float mn = fmaxf(m_run, pmax); alpha = __builtin_amdgcn_exp2f(m_run - mn); m_run = mn; }
    const float mneg = -m_run;
#pragma unroll
    for (int r = 0; r < 16; ++r) { p0[r] = __builtin_amdgcn_exp2f(p0[r] + mneg); p1[r] = __builtin_amdgcn_exp2f(p1[r] + mneg); }
    float ps = 0.f;
#pragma unroll
    for (int r = 0; r < 16; ++r) ps += p0[r];
#pragma unroll
    for (int r = 0; r < 16; ++r) ps += p1[r];
    { auto rr = __builtin_amdgcn_permlane32_swap(__float_as_uint(ps), __float_as_uint(ps), false, false); ps = __uint_as_float(rr[0]) + __uint_as_float(rr[1]); }
    l_run = l_run * alpha + ps;
    bf16x8 pa0, pa1, pa2, pa3;
#define AT_PK4(P, B_, OUT) do { unsigned a0 = cvt_pk_bf16(P[B_+0], P[B_+1]), a1 = cvt_pk_bf16(P[B_+2], P[B_+3]); \
        unsigned b0 = cvt_pk_bf16(P[B_+4], P[B_+5]), b1 = cvt_pk_bf16(P[B_+6], P[B_+7]); \
        auto r0 = __builtin_amdgcn_permlane32_swap(a0, b0, false, false); auto r1 = __builtin_amdgcn_permlane32_swap(a1, b1, false, false); \
        u32x4 w = {r0[0], r1[0], r0[1], r1[1]}; OUT = *reinterpret_cast<bf16x8*>(&w); } while (0)
    AT_PK4(p0, 0, pa0); AT_PK4(p0, 8, pa1); AT_PK4(p1, 0, pa2); AT_PK4(p1, 8, pa3);
#undef AT_PK4
    if (__any(alpha < 1.f)) { if (hi == 0) al_l[r32] = alpha; asm volatile("s_waitcnt lgkmcnt(0)" ::: "memory");
#pragma unroll
        for (int d_ = 0; d_ < 4; ++d_)
#pragma unroll
            for (int r = 0; r < 16; ++r) o[d_][r] *= al_l[crow(r, hi)]; }
#define AT_TRRD(dst, off) asm volatile("ds_read_b64_tr_b16 %0, %1 offset:%2" : "=&v"(dst) : "v"(vb0), "i"(off) : "memory")
#define AT_PV_D0(d0) do { s16x4 l0, l1, l2, l3, h0, h1, h2, h3; constexpr int b_ = BUF * VTB + v_rd_off(d0, 0, 0); \
        AT_TRRD(l0, b_); AT_TRRD(h0, b_ + 2048); AT_TRRD(l1, b_ + 4096); AT_TRRD(h1, b_ + 6144); AT_TRRD(l2, b_ + 8192); AT_TRRD(h2, b_ + 10240); AT_TRRD(l3, b_ + 12288); AT_TRRD(h3, b_ + 14336); \
        asm volatile("s_waitcnt lgkmcnt(0)" ::: "memory"); AT_SBAR(); \
        o[d0] = __builtin_amdgcn_mfma_f32_32x32x16_bf16(pa0, (bf16x8){l0[0], l0[1], l0[2], l0[3], h0[0], h0[1], h0[2], h0[3]}, o[d0], 0, 0, 0); \
        o[d0] = __builtin_amdgcn_mfma_f32_32x32x16_bf16(pa1, (bf16x8){l1[0], l1[1], l1[2], l1[3], h1[0], h1[1], h1[2], h1[3]}, o[d0], 0, 0, 0); \
        o[d0] = __builtin_amdgcn_mfma_f32_32x32x16_bf16(pa2, (bf16x8){l2[0], l2[1], l2[2], l2[3], h2[0], h2[1], h2[2], h2[3]}, o[d0], 0, 0, 0); \
        o[d0] = __builtin_amdgcn_mfma_f32_32x32x16_bf16(pa3, (bf16x8){l3[0], l3[1], l3[2], l3[3], h3[0], h3[1], h3[2], h3[3]}, o[d0], 0, 0, 0); } while (0)
    AT_PV_D0(0); AT_PV_D0(1); AT_PV_D0(2); AT_PV_D0(3);
#undef AT_PV_D0
#undef AT_TRRD
}

struct AttnArgs { const bf16* QRAW; const float* SSQ; const float* qg; const float* CS; const bf16* KK; const bf16* VV; bf16* O; };

__device__ __forceinline__ void attn_phase(LAS unsigned char* lds, const AttnArgs& A, int G, int bx) {
    int tid_ = threadIdx.x; asm volatile("" : "+v"(tid_));
    const int tid = tid_, wid = __builtin_amdgcn_readfirstlane(tid >> 6), lane = tid & 63, r32 = lane & 31, hi = lane >> 5;
    unsigned koff[3], voff[2];
#pragma unroll
    for (int i = 0; i < 3; ++i) { const int p = (wid * 3 + i) * 64 + lane, r = p / 24, cs = p % 24, c = (cs & ~7) | ((cs & 7) ^ ((r >> 1) & 7)); koff[i] = (unsigned)(r * 384 + c * 16); }
#pragma unroll
    for (int i = 0; i < 2; ++i) { const int ob = ((wid * 2 + i) * 64 + lane) * 16, sub = ob >> 9, within = ob & 511, kk = (sub >> 2) * 8 + (within >> 6), cc = (sub & 3) * 32 + ((within & 63) >> 1);
        const int k = (kk & ~0xC) | ((kk & 4) << 1) | ((kk & 8) >> 1); voff[i] = (unsigned)(k * 256 + cc * 2); }
    const int fsw = (r32 >> 1) & 7;
    const LAS char* Kl = (const LAS char*)lds + LDS_K + r32 * 384;
    const LAS char* kb0 = Kl + (((0 + hi) ^ fsw) << 4); const LAS char* kb1 = Kl + (((2 + hi) ^ fsw) << 4); const LAS char* kb2 = Kl + (((4 + hi) ^ fsw) << 4); const LAS char* kb3 = Kl + (((6 + hi) ^ fsw) << 4);
    const int vb0 = LDS_V + v_rd_base(lane);
    LAS float* al_l = (LAS float*)(lds + LDS_AL) + wid * 64; LAS float* li_l = al_l + 32;
    const int vcu = (G % 8 == 0) ? (bx % 8) * (G / 8) + bx / 8 : bx;
#define AT_ISSUE(t, buf) do { const char* kg_ = Kg + (size_t)(t) * KTB; const char* vg_ = Vg + (size_t)(t) * VTB; \
        _Pragma("unroll") for (int i_ = 0; i_ < 3; ++i_) __builtin_amdgcn_global_load_lds((const unsigned*)(kg_ + koff[i_]), (LAS unsigned*)(lds + LDS_K + (buf) * KTB + (wid * 3 + i_) * 1024), 16, 0, 0); \
        _Pragma("unroll") for (int i_ = 0; i_ < 2; ++i_) __builtin_amdgcn_global_load_lds((const unsigned*)(vg_ + voff[i_]), (LAS unsigned*)(lds + LDS_V + (buf) * VTB + (wid * 2 + i_) * 1024), 16, 0, 0); } while (0)
    for (int item = vcu; item < NB * NH * 16; item += G) {
        const int bh = item >> 4, pr = item & 15, b = bh / NH, h = bh % NH;
        const char* Kg = (const char*)(A.KK + (size_t)bh * SEQ * DQK); const char* Vg = (const char*)(A.VV + (size_t)bh * SEQ * DV);
        for (int pass = 0; pass < 2; ++pass) {
            const int qb = pass == 0 ? 31 - pr : pr, NT = 4 * (qb + 1), myNT = 4 * qb + (wid >> 1) + 1;
            AT_ISSUE(0, 0);
            bf16x8 qr[12];
            { const int t = b * SEQ + qb * 256 + wid * 32 + r32; const bf16* qp = A.QRAW + (size_t)t * 1536 + h * DQK + hi * 8;
              const f32x2* sq = (const f32x2*)(A.SSQ + (size_t)t * 48 + h * 6); const f32x2 s0 = sq[0], s1 = sq[1], s2 = sq[2];
              const float rq = fast_rsqrt(((s0[0] + s0[1]) + (s1[0] + s1[1]) + (s2[0] + s2[1])) * (1.0f / DQK) + EPS) * (SM_SCALE * 1.4426950408889634f);
              float xt[4][8];
#pragma unroll
              for (int s = 0; s < 12; ++s) { const bf16x8 raw = *(const bf16x8*)(qp + s * 16); const f32x4 g0 = *(const f32x4*)(A.qg + s * 16 + hi * 8), g1 = *(const f32x4*)(A.qg + s * 16 + hi * 8 + 4);
                  float x[8];
#pragma unroll
                  for (int e = 0; e < 8; ++e) x[e] = __uint_as_float(((unsigned)(unsigned short)raw[e]) << 16) * (e < 4 ? g0[e] : g1[e - 4]) * rq;
                  if (s < 8) { u32x4 w; w.x = cvt_pk_bf16(x[0], x[1]); w.y = cvt_pk_bf16(x[2], x[3]); w.z = cvt_pk_bf16(x[4], x[5]); w.w = cvt_pk_bf16(x[6], x[7]); qr[s] = *reinterpret_cast<bf16x8*>(&w); }
                  else {
#pragma unroll
                      for (int e = 0; e < 8; ++e) xt[s - 8][e] = x[e]; } }
#pragma unroll
              for (int s = 0; s < 2; ++s) { const float* cp = A.CS + (size_t)t * 64 + s * 16 + hi * 8;
                  const f32x4 c0 = *(const f32x4*)cp, c1 = *(const f32x4*)(cp + 4), n0 = *(const f32x4*)(cp + 32), n1 = *(const f32x4*)(cp + 36);
                  float y1[8], y2[8];
#pragma unroll
                  for (int e = 0; e < 8; ++e) { const float c = e < 4 ? c0[e] : c1[e - 4], sn = e < 4 ? n0[e] : n1[e - 4]; const float x1 = xt[s][e], x2 = xt[s + 2][e]; y1[e] = x1 * c - x2 * sn; y2[e] = x1 * sn + x2 * c; }
                  u32x4 w; w.x = cvt_pk_bf16(y1[0], y1[1]); w.y = cvt_pk_bf16(y1[2], y1[3]); w.z = cvt_pk_bf16(y1[4], y1[5]); w.w = cvt_pk_bf16(y1[6], y1[7]); qr[8 + s] = *reinterpret_cast<bf16x8*>(&w);
                  u32x4 w2; w2.x = cvt_pk_bf16(y2[0], y2[1]); w2.y = cvt_pk_bf16(y2[2], y2[3]); w2.z = cvt_pk_bf16(y2[4], y2[5]); w2.w = cvt_pk_bf16(y2[6], y2[7]); qr[10 + s] = *reinterpret_cast<bf16x8*>(&w2); } }
            float m_run = -1e30f, l_run = 0.f; f32x16 o[4] = {};
            for (int t = 0; t < NT; t += 2) {
                asm volatile("s_waitcnt vmcnt(0)" ::: "memory"); __builtin_amdgcn_s_barrier();
                AT_ISSUE(t + 1, 1);
                if (t < myNT) tile_compute<0>(o, qr, m_run, l_run, kb0, kb1, kb2, kb3, vb0, al_l, r32, hi);
                asm volatile("s_waitcnt vmcnt(0)" ::: "memory"); __builtin_amdgcn_s_barrier();
                if (t + 2 < NT) AT_ISSUE(t + 2, 0);
                if (t + 1 < myNT) tile_compute<1>(o, qr, m_run, l_run, kb0, kb1, kb2, kb3, vb0, al_l, r32, hi);
            }
            if (hi == 0) li_l[r32] = l_run; asm volatile("s_waitcnt lgkmcnt(0)" ::: "memory");
            bf16* Ow = A.O + (size_t)(b * SEQ + qb * 256 + wid * 32) * D + h * DV + (size_t)(4 * hi) * D + r32;
            asm volatile("" : "+v"(Ow));
#pragma unroll
            for (int r = 0; r < 16; ++r) { const int orow = crow(r, hi); const float rl = __builtin_amdgcn_rcpf(li_l[orow]);
#pragma unroll
                for (int d0 = 0; d0 < 4; ++d0) { const float v = o[d0][r] * rl; const float vn = __shfl_xor(v, 1);
                    if ((r32 & 1) == 0) *(unsigned*)(Ow + (size_t)((r & 3) + 8 * (r >> 2)) * D + d0 * 32) = cvt_pk_bf16(v, vn); } }
        }
    }
    asm volatile("s_waitcnt vmcnt(0)" ::: "memory"); __builtin_amdgcn_s_barrier();
#undef AT_ISSUE
}
#undef AT_SBAR
}


namespace th {
#define TH_LDS_WAIT() asm volatile("s_waitcnt lgkmcnt(0)" ::: "memory")
__device__ __forceinline__ void tr_item(const float* W, int K, int N, bf16* Wt, int row_off, const float* gain, int half, LAS float* scr, int item, int lane) {
    const int nblk = N / 32, kb = item / nblk, nb = item % nblk, k0 = 64 * kb, n0 = 32 * nb;
#pragma unroll 8
    for (int i = 0; i < 32; ++i) { const int kk = 2 * i + (lane >> 5); scr[kk * 33 + (lane & 31)] = W[(size_t)(k0 + kk) * N + n0 + (lane & 31)] * (gain ? gain[k0 + kk] : 1.0f); }
    TH_LDS_WAIT(); asm volatile("" ::: "memory");
    const int c = lane & 7;
#pragma unroll
    for (int j = 0; j < 4; ++j) { const int n = (lane >> 3) + 8 * j; const LAS float* sp = scr + (8 * c) * 33 + n; const int nn = n0 + n, nr = half ? pair_row(nn, half) : nn;
        u32x4 o; o.x = cvt_pk_bf16(sp[0 * 33], sp[1 * 33]); o.y = cvt_pk_bf16(sp[2 * 33], sp[3 * 33]); o.z = cvt_pk_bf16(sp[4 * 33], sp[5 * 33]); o.w = cvt_pk_bf16(sp[6 * 33], sp[7 * 33]);
        *(u32x4*)(Wt + (size_t)(row_off + nr) * K + k0 + 8 * c) = o; }
    TH_LDS_WAIT(); asm volatile("" ::: "memory");
}
struct P0Args { const float* const* in; unsigned char* ws; };
__device__ __forceinline__ void prologue(LAS unsigned char* lds, const float* const (&in)[30], unsigned char* ws, int G, int bx) {
    const int tid = threadIdx.x, lane = tid & 63, wave = __builtin_amdgcn_readfirstlane(tid >> 6);
    LAS float* scr = (LAS float*)(lds + wave * 16384);
    const int gw = bx * NWAVES_ + wave, NGW = G * NWAVES_;
    bf16 *W1t = (bf16*)(ws + WS_W1T), *W2t = (bf16*)(ws + WS_W2T), *Wc = (bf16*)(ws + WS_WC), *Wukv = (bf16*)(ws + WS_WUKV), *Wuq = (bf16*)(ws + WS_WUQ), *Wo = (bf16*)(ws + WS_WO),
         *Wgu = (bf16*)(ws + WS_WGU), *Wd = (bf16*)(ws + WS_WD);
    constexpr int I_W1 = 16 * 64, I_W2 = 16 * 32, I_DKV = 16 * 8, I_KR = 16 * 2, I_DQ = 16 * 12, I_UKV = 4 * 64, I_UQ = 6 * 48, I_WO = 16 * 32, I_GU1 = 16 * 32, I_D1 = 8 * 32;
    constexpr int NIT = I_W1 + I_W2 + I_DKV + I_KR + I_DQ + I_UKV + I_UQ + I_WO + 64 * I_GU1 + 64 * I_D1;
    for (int it = gw; it < NIT; it += NGW) {
        int r = it;
        if (r < 64 * I_GU1) { const int e = r / I_GU1; tr_item(in[28] + (size_t)e * D * 1024, D, 1024, Wgu + (size_t)e * 1024 * D, 0, in[23] + (e / NE) * D, 512, scr, r % I_GU1, lane); continue; } r -= 64 * I_GU1;
        if (r < 64 * I_D1) { const int e = r / I_D1; tr_item(in[29] + (size_t)e * DE * D, DE, D, Wd + (size_t)e * D * DE, 0, nullptr, 0, scr, r % I_D1, lane); continue; } r -= 64 * I_D1;
        if (r < I_W1) { tr_item(in[3], D, 2048, W1t, 0, in[2], 1024, scr, r, lane); continue; } r -= I_W1;
        if (r < I_W2) { tr_item(in[9], D, D, W2t, 0, nullptr, 0, scr, r, lane); continue; } r -= I_W2;
        if (r < I_DKV) { tr_item(in[12], D, KVR, Wc, 0, in[11], 0, scr, r, lane); continue; } r -= I_DKV;
        if (r < I_KR) { tr_item(in[14], D, DROPE, Wc, 256, in[11], 0, scr, r, lane); continue; } r -= I_KR;
        if (r < I_DQ) { tr_item(in[18], D, QLR, Wc, 320, in[17], 0, scr, r, lane); continue; } r -= I_DQ;
        if (r < I_UKV) { tr_item(in[15], KVR, 2048, Wukv, 0, in[13], 0, scr, r, lane); continue; } r -= I_UKV;
        if (r < I_UQ) { tr_item(in[20], QLR, 1536, Wuq, 0, in[19], 0, scr, r, lane); continue; } r -= I_UQ;
        tr_item(in[22], D, D, Wo, 0, nullptr, 0, scr, r, lane);
    }
    const int gt = bx * (NWAVES_ * 64) + tid, NGT = G * NWAVES_ * 64;
    for (int i = gt; i < 64 * D / 8; i += NGT) ((u32x4*)(Wc + (size_t)704 * D))[i] = (u32x4){0u, 0u, 0u, 0u};
    { float* Wr = (float*)(ws + WS_WR);
      for (int i = gt; i < 2 * D * NRT; i += NGT) { const int c = i % NRT, k = (i / NRT) % D, l = i / (NRT * D);
          const float w = c < NG ? in[24][((size_t)l * D + k) * NG + c] : in[26][((size_t)l * D + k) * NE + (c - NG)]; Wr[i] = w * in[23][l * D + k]; } }
    { float* cs = (float*)(ws + WS_CS); const int* pos = (const int*)in[1];
      for (int i = gt; i < T * 32; i += NGT) { const int t = i >> 5, f = i & 31; const float ang = (float)pos[t] * INV_FREQ[f]; double sn, c; sincos_d((double)ang, sn, c); cs[(size_t)t * 64 + f] = (float)c; cs[(size_t)t * 64 + 32 + f] = (float)sn; } }
    { const float* x = in[0]; bf16* xb = (bf16*)(ws + WS_R1); float* rstd = (float*)(ws + WS_RSTD0);
      for (int row = gw; row < T; row += NGW) { const f32x4* xr = (const f32x4*)(x + (size_t)row * D); float ss = 0.f;
#pragma unroll
          for (int j = 0; j < 4; ++j) { const f32x4 v = xr[lane + 64 * j]; ss += (v[0] * v[0] + v[1] * v[1]) + (v[2] * v[2] + v[3] * v[3]);
              u32x2 o; o.x = cvt_pk_bf16(v[0], v[1]); o.y = cvt_pk_bf16(v[2], v[3]); ((u32x2*)(xb + (size_t)row * D))[lane + 64 * j] = o; }
          ss = wave_sum(ss); if (lane == 0) rstd[row] = fast_rsqrt(ss * (1.0f / D) + EPS); } }
}
__device__ __forceinline__ void conv_ln(LAS unsigned char* lds, const bf16* U, const float* dw_w, const float* dw_b, const float* ln_g, const float* ln_b, bf16* Vb, int G, int bx) {
    const int tid = threadIdx.x, lane = tid & 63, wave = __builtin_amdgcn_readfirstlane(tid >> 6);
    LAS float* tile = (LAS float*)lds;
    const int c0 = tid * 2;
    float w0[CONVW], w1[CONVW];
#pragma unroll
    for (int j = 0; j < CONVW; ++j) { const f32x2 w = *(const f32x2*)(dw_w + j * D + c0); w0[j] = w[0]; w1[j] = w[1]; }
    const f32x2 bb = *(const f32x2*)(dw_b + c0);
    for (int unit = bx; unit < T / 16; unit += G) {
        const int t0 = unit * 16, s0 = t0 & (SEQ - 1);
        float a0[16], a1[16];
#pragma unroll
        for (int r = 0; r < 16; ++r) { a0[r] = bb[0]; a1[r] = bb[1]; }
#pragma unroll
        for (int ib = 0; ib < 46; ib += 8) {
            unsigned uv[8];
#pragma unroll
            for (int k = 0; k < 8; ++k) { const int i = ib + k; uv[k] = (i < 46 && s0 - 30 + i >= 0) ? *(const unsigned*)(U + (size_t)(t0 - 30 + i) * D + c0) : 0u; }
#pragma unroll
            for (int k = 0; k < 8; ++k) { const int i = ib + k; if (i < 46) { const float u0 = __uint_as_float(uv[k] << 16), u1 = __uint_as_float(uv[k] & 0xffff0000u);
#pragma unroll
                for (int r = 0; r < 16; ++r) { const int j = i - r; if (j >= 0 && j < CONVW) { a0[r] = fmaf(w0[j], u0, a0[r]); a1[r] = fmaf(w1[j], u1, a1[r]); } } } }
            asm volatile("" ::: "memory");
        }
#pragma unroll
        for (int r = 0; r < 16; ++r) *(LAS f32x2*)(tile + r * D + c0) = (f32x2){a0[r], a1[r]};
        __syncthreads();
#pragma unroll
        for (int rr = 0; rr < 2; ++rr) { const int r = wave * 2 + rr; const LAS f32x4* xr = (const LAS f32x4*)(tile + r * D); f32x4 v[4]; float sm = 0.f;
#pragma unroll
            for (int j = 0; j < 4; ++j) { v[j] = xr[lane + 64 * j]; sm += (v[j][0] + v[j][1]) + (v[j][2] + v[j][3]); }
            const float mean = wave_sum(sm) * (1.0f / D); float q = 0.f;
#pragma unroll
            for (int j = 0; j < 4; ++j) { v[j] = v[j] - mean; q += (v[j][0] * v[j][0] + v[j][1] * v[j][1]) + (v[j][2] * v[j][2] + v[j][3] * v[j][3]); }
            const float rs = fast_rsqrt(wave_sum(q) * (1.0f / D) + EPS);
#pragma unroll
            for (int j = 0; j < 4; ++j) { const int c = (lane + 64 * j) * 4; const f32x4 gg = *(const f32x4*)(ln_g + c), bv = *(const f32x4*)(ln_b + c); const f32x4 y = v[j] * rs * gg + bv;
                u32x2 o; o.x = cvt_pk_bf16(y[0] * fast_sigmoid(y[0]), y[1] * fast_sigmoid(y[1])); o.y = cvt_pk_bf16(y[2] * fast_sigmoid(y[2]), y[3] * fast_sigmoid(y[3]));
                ((u32x2*)(Vb + (size_t)(t0 + r) * D))[lane + 64 * j] = o; } }
        __syncthreads();
    }
}
__device__ __forceinline__ void route(const float* H, const float* Wr, const float* bg, const float* br, bf16* XT, float* RSTD, int* LIST, int* CNT, float* GATE, int G, int bx) {
    const int tid = threadIdx.x, lane = tid & 63, wave = __builtin_amdgcn_readfirstlane(tid >> 6);
    for (int t = bx * NWAVES_ + wave; t < T; t += G * NWAVES_) {
        const f32x4* xr = (const f32x4*)(H + (size_t)t * D); float acc[NRT];
#pragma unroll
        for (int c = 0; c < NRT; ++c) acc[c] = 0.f;
        float ss = 0.f;
#pragma unroll
        for (int j = 0; j < 4; ++j) { const f32x4 v = xr[lane + 64 * j]; ss += (v[0] * v[0] + v[1] * v[1]) + (v[2] * v[2] + v[3] * v[3]);
            u32x2 o; o.x = cvt_pk_bf16(v[0], v[1]); o.y = cvt_pk_bf16(v[2], v[3]); ((u32x2*)(XT + (size_t)t * D))[lane + 64 * j] = o;
            const float* w = Wr + (size_t)((lane + 64 * j) * 4) * NRT;
#pragma unroll
            for (int q = 0; q < 4; ++q)
#pragma unroll
                for (int c = 0; c < NRT; ++c) acc[c] = fmaf(v[q], w[q * NRT + c], acc[c]); }
        ss = wave_sum(ss);
#pragma unroll
        for (int c = 0; c < NRT; ++c) acc[c] = wave_sum(acc[c]);
        if (lane == 0) {
            const float rs = fast_rsqrt(ss * (1.0f / D) + EPS); RSTD[t] = rs;
            float lg[NG]; int gi = 0; float gm = -3.0e38f;
#pragma unroll
            for (int c = 0; c < NG; ++c) { lg[c] = acc[c] * rs + bg[c]; if (lg[c] > gm) { gm = lg[c]; gi = c; } }
            float gs = 0.f;
#pragma unroll
            for (int c = 0; c < NG; ++c) gs += __expf(lg[c] - gm);
            const float gw = 1.0f / gs;
            float le[EPG]; float em = -3.0e38f;
#pragma unroll
            for (int c = 0; c < EPG; ++c) { float v = 0.f;
#pragma unroll
                for (int g2 = 0; g2 < NG; ++g2) if (g2 == gi) v = acc[NG + g2 * EPG + c] * rs + br[g2 * EPG + c];
                le[c] = v; em = fmaxf(em, v); }
            int i0 = 0; float v0 = -3.0e38f;
#pragma unroll
            for (int c = 0; c < EPG; ++c) if (le[c] > v0) { v0 = le[c]; i0 = c; }
            int i1 = 0; float v1 = -3.0e38f;
#pragma unroll
            for (int c = 0; c < EPG; ++c) if (c != i0 && le[c] > v1) { v1 = le[c]; i1 = c; }
            const float p0 = __expf(v0 - em), p1 = __expf(v1 - em); const float inv = 1.0f / (p0 + p1);
            const int e0 = gi * EPG + i0, e1 = gi * EPG + i1;
            GATE[2 * t] = gw * p0 * inv; GATE[2 * t + 1] = gw * p1 * inv;
            const int s0 = atomicAdd(CNT + e0, 1); LIST[(size_t)e0 * T + s0] = 2 * t;
            const int s1 = atomicAdd(CNT + e1, 1); LIST[(size_t)e1 * T + s1] = 2 * t + 1;
        }
    }
}
__device__ __forceinline__ void combine(float* H, const bf16* Y, bf16* HB, float* RSTD2, int G, int bx) {
    const int tid = threadIdx.x, lane = tid & 63, wave = __builtin_amdgcn_readfirstlane(tid >> 6);
    for (int t = bx * NWAVES_ + wave; t < T; t += G * NWAVES_) {
        f32x4* hr = (f32x4*)(H + (size_t)t * D); const u32x2* y0 = (const u32x2*)(Y + (size_t)(2 * t) * D); const u32x2* y1 = (const u32x2*)(Y + (size_t)(2 * t + 1) * D);
        float ss = 0.f;
#pragma unroll
        for (int j = 0; j < 4; ++j) { f32x4 v = hr[lane + 64 * j]; const u32x2 p = y0[lane + 64 * j], q = y1[lane + 64 * j];
            v[0] += __uint_as_float(p.x << 16) + __uint_as_float(q.x << 16); v[1] += __uint_as_float(p.x & 0xffff0000u) + __uint_as_float(q.x & 0xffff0000u);
            v[2] += __uint_as_float(p.y << 16) + __uint_as_float(q.y << 16); v[3] += __uint_as_float(p.y & 0xffff0000u) + __uint_as_float(q.y & 0xffff0000u);
            hr[lane + 64 * j] = v; ss += (v[0] * v[0] + v[1] * v[1]) + (v[2] * v[2] + v[3] * v[3]);
            if (HB) { u32x2 o; o.x = cvt_pk_bf16(v[0], v[1]); o.y = cvt_pk_bf16(v[2], v[3]); ((u32x2*)(HB + (size_t)t * D))[lane + 64 * j] = o; } }
        if (RSTD2) { ss = wave_sum(ss); if (lane == 0) RSTD2[t] = fast_rsqrt(ss * (1.0f / D) + EPS); }
    }
}
__device__ __forceinline__ void kfin(const bf16* KN, const bf16* CL, const float* SSK, const float* SSP, const float* kg, const float* cs, bf16* KK, int G, int bx) {
    const int tid = threadIdx.x, lane = tid & 63, wave = __builtin_amdgcn_readfirstlane(tid >> 6), h = lane >> 3, part = lane & 7;
    for (int t = bx * NWAVES_ + wave; t < T; t += G * NWAVES_) {
        const int b = t / SEQ, sq = t % SEQ;
        const f32x4 sk = *(const f32x4*)(SSK + t * 32 + h * 4); const f32x2 sr = *(const f32x2*)(SSP + t * 32 + 8);
        const float rk = fast_rsqrt((((sk[0] + sk[1]) + (sk[2] + sk[3])) + (sr[0] + sr[1])) * (1.0f / DQK) + EPS);
        bf16* o = KK + (((size_t)b * NH + h) * SEQ + sq) * DQK;
        { const bf16x8 r0 = *(const bf16x8*)(KN + (size_t)t * D + h * 128 + part * 16), r1 = *(const bf16x8*)(KN + (size_t)t * D + h * 128 + part * 16 + 8);
          const float* g = kg + part * 16; float y[16];
#pragma unroll
          for (int e = 0; e < 8; ++e) { y[e] = __uint_as_float(((unsigned)(unsigned short)r0[e]) << 16) * rk * g[e]; y[8 + e] = __uint_as_float(((unsigned)(unsigned short)r1[e]) << 16) * rk * g[8 + e]; }
          u32x4 w0, w1; w0.x = cvt_pk_bf16(y[0], y[1]); w0.y = cvt_pk_bf16(y[2], y[3]); w0.z = cvt_pk_bf16(y[4], y[5]); w0.w = cvt_pk_bf16(y[6], y[7]);
          w1.x = cvt_pk_bf16(y[8], y[9]); w1.y = cvt_pk_bf16(y[10], y[11]); w1.z = cvt_pk_bf16(y[12], y[13]); w1.w = cvt_pk_bf16(y[14], y[15]);
          *(u32x4*)(o + part * 16) = w0; *(u32x4*)(o + part * 16 + 8) = w1; }
        { const int j0 = part * 4;
          const u32x2 a = *(const u32x2*)(CL + (size_t)t * NCL + 256 + j0), bq = *(const u32x2*)(CL + (size_t)t * NCL + 288 + j0);
          const f32x4 c = *(const f32x4*)(cs + (size_t)t * 64 + j0), sn = *(const f32x4*)(cs + (size_t)t * 64 + 32 + j0), g1 = *(const f32x4*)(kg + 128 + j0), g2 = *(const f32x4*)(kg + 160 + j0);
          const float x1[4] = {__uint_as_float(a.x << 16), __uint_as_float(a.x & 0xffff0000u), __uint_as_float(a.y << 16), __uint_as_float(a.y & 0xffff0000u)};
          const float x2[4] = {__uint_as_float(bq.x << 16), __uint_as_float(bq.x & 0xffff0000u), __uint_as_float(bq.y << 16), __uint_as_float(bq.y & 0xffff0000u)};
          float y1[4], y2[4];
#pragma unroll
          for (int e = 0; e < 4; ++e) { const float p = x1[e] * rk * g1[e], q = x2[e] * rk * g2[e]; y1[e] = p * c[e] - q * sn[e]; y2[e] = p * sn[e] + q * c[e]; }
          u32x2 w1, w2; w1.x = cvt_pk_bf16(y1[0], y1[1]); w1.y = cvt_pk_bf16(y1[2], y1[3]); w2.x = cvt_pk_bf16(y2[0], y2[1]); w2.y = cvt_pk_bf16(y2[2], y2[3]);
          *(u32x2*)(o + 128 + j0) = w1; *(u32x2*)(o + 160 + j0) = w2; }
    }
}
#undef TH_LDS_WAIT
}

#define XB_TMO      128
#define XB_XCNT(j)  (256  + 64 * (j))
#define XB_XSUB(j)  (1280 + 64 * (j))
#define XB_XGEN(j)  (2304 + 64 * (j))
#define XB_TOP      3328
#define XB_TOPGEN   3392
#define XCD_BAR_WORDS 3456
#define XB_SPIN_CAP (1u << 18)
__device__ __forceinline__ unsigned xb_ld(unsigned* p)              { return __hip_atomic_load(p, __ATOMIC_RELAXED, __HIP_MEMORY_SCOPE_AGENT); }
__device__ __forceinline__ unsigned xb_add(unsigned* p, unsigned v) { return __hip_atomic_fetch_add(p, v, __ATOMIC_RELAXED, __HIP_MEMORY_SCOPE_AGENT); }
__device__ __forceinline__ unsigned xb_xcc_id() { return (unsigned)__builtin_amdgcn_s_getreg((3 << 11) | 20) & 0xFu; }
#define XB_SPIN(cond, bar) do { unsigned _sp = 0; while (cond) { __builtin_amdgcn_s_sleep(1); \
    if ((++_sp & 255u) == 0u) { if (xb_ld(&(bar)[XB_TMO])) break; if (_sp > XB_SPIN_CAP) { atomicAdd(&(bar)[XB_TMO], 1u); break; } } } } while (0)
struct XcdBarrier { unsigned* bar; unsigned x; volatile LAS unsigned* st; };
__device__ __forceinline__ XcdBarrier xcd_barrier_post(unsigned* bar, volatile LAS unsigned* st) {
    XcdBarrier b; b.bar = bar; b.x = xb_xcc_id(); b.st = st;
    if (threadIdx.x == 0) (void)xb_add(&bar[XB_XCNT(b.x)], 1u);
    return b;
}
__device__ __forceinline__ void xcd_barrier_complete(unsigned* bar, unsigned x, unsigned& nloc, unsigned& nx) {
    const unsigned G = gridDim.x * gridDim.y * gridDim.z;
    unsigned sum, cnt, mine, sp = 0u;
    for (;;) {
        sum = 0u; cnt = 0u; mine = 0u;
#pragma unroll
        for (unsigned j = 0; j < 16; ++j) { const unsigned c = xb_ld(&bar[XB_XCNT(j)]); sum += c; cnt += (c > 0u) ? 1u : 0u; mine = (j == x) ? c : mine; }
        if (sum == G) break;
        __builtin_amdgcn_s_sleep(1);
        if ((++sp & 255u) == 0u) { if (xb_ld(&bar[XB_TMO])) break; if (sp > XB_SPIN_CAP) { atomicAdd(&bar[XB_TMO], 1u); break; } }
    }
    nloc = mine > 0u ? mine : 1u; nx = cnt > 0u ? cnt : 1u;
}
__device__ __forceinline__ void xcd_barrier(const XcdBarrier& b) {
    asm volatile("s_waitcnt vmcnt(0)" ::: "memory");
    __syncthreads();
    if (threadIdx.x == 0) {
        unsigned* bar = b.bar;
        __builtin_amdgcn_s_waitcnt(0);
        unsigned nloc = b.st[0], nx = b.st[1];
        if (nloc == 0u) { xcd_barrier_complete(bar, b.x, nloc, nx); b.st[0] = nloc; b.st[1] = nx; }
        const unsigned old = xb_add(&bar[XB_XSUB(b.x)], 1u);
        const unsigned gen = old / nloc;
        if (old + 1u == (gen + 1u) * nloc) {
            __builtin_amdgcn_fence(__ATOMIC_RELEASE, "agent");
            asm volatile("s_waitcnt vmcnt(0)" ::: "memory");
            const unsigned og = xb_add(&bar[XB_TOP], 1u);
            const unsigned tg = og / nx;
            if (og + 1u == (tg + 1u) * nx) xb_add(&bar[XB_TOPGEN], 1u);
            else XB_SPIN(xb_ld(&bar[XB_TOPGEN]) == tg, bar);
            __builtin_amdgcn_fence(__ATOMIC_ACQUIRE, "agent");
            xb_add(&bar[XB_XGEN(b.x)], 1u);
            asm volatile("s_waitcnt vmcnt(0)" ::: "memory");
        } else {
            XB_SPIN(xb_ld(&bar[XB_XGEN(b.x)]) == gen, bar);
            __builtin_amdgcn_fence(__ATOMIC_ACQUIRE, "agent");
            asm volatile("s_waitcnt vmcnt(0)" ::: "memory");
        }
    }
    __syncthreads();
}

constexpr int NWAVES = 8, LDS_BYTES = 160 * 1024, LDS_MISC = 128 * 1024;
constexpr int CW_BAR = 4096;
constexpr int NPHASE = 17;
struct Args { const float* in[30]; float* out; unsigned char* ws; int ph_lo, ph_hi; };

__global__ void __launch_bounds__(NWAVES * 64, 2) fwd(Args a) {
    extern __shared__ __attribute__((aligned(16))) unsigned char lds_raw[];
    LAS unsigned char* lds = (LAS unsigned char*)lds_raw;
    volatile LAS unsigned* MISC = (volatile LAS unsigned*)(lds + LDS_MISC);
    const int tid = threadIdx.x;
    if (tid < 64) MISC[tid] = 0u;
    __syncthreads();
    unsigned char* ws = a.ws; float* H = a.out;
    XcdBarrier bar = xcd_barrier_post((unsigned*)(ws + WS_CTL) + CW_BAR, MISC + 8);
    const int lo = a.ph_lo, hi = a.ph_hi, G = gridDim.x, bx = blockIdx.x;
#define IN(k) (lo <= (k) && (k) < hi)
#define SEAM(k) do { if (IN(k) && IN((k) + 1)) xcd_barrier(bar); } while (0)
    const float* x = a.in[0];
    bf16 *W1t = (bf16*)(ws + WS_W1T), *W2t = (bf16*)(ws + WS_W2T), *Wc = (bf16*)(ws + WS_WC), *Wukv = (bf16*)(ws + WS_WUKV), *Wuq = (bf16*)(ws + WS_WUQ), *Wo = (bf16*)(ws + WS_WO);
    float *RSTD0 = (float*)(ws + WS_RSTD0), *RSTD2 = (float*)(ws + WS_RSTD2), *SSP = (float*)(ws + WS_SSP), *SSQ = (float*)(ws + WS_SSQ), *SSK = (float*)(ws + WS_SSK);
    bf16 *XB = (bf16*)(ws + WS_R1), *HB = XB, *U = (bf16*)(ws + WS_R2), *O = U, *Vb = (bf16*)(ws + WS_R3), *KN = Vb, *VV = (bf16*)(ws + WS_R3 + 64 * MiB),
         *CL = (bf16*)(ws + WS_CL), *QRAW = (bf16*)(ws + WS_QRAW);

    if (IN(0)) th::prologue(lds, a.in, ws, G, bx);
    SEAM(0);
    if (IN(1)) { fg::DenseP<fg::EpiGlu> p{(const char*)XB, D, (const char*)W1t, D, {}, {RSTD0, a.in[4], U}}; p.S.init(T, 2048, G, bx); fg::gemm_phase(lds, p); }
    SEAM(1);
    if (IN(2)) th::conv_ln(lds, U, a.in[5], a.in[6], a.in[7], a.in[8], Vb, G, bx);
    SEAM(2);
    if (IN(3)) { fg::DenseP<fg::EpiRes> p{(const char*)Vb, D, (const char*)W2t, D, {}, {x, a.in[10], H}}; p.S.init(T, D, G, bx); fg::gemm_phase(lds, p); }
    SEAM(3);
    LAS int* pref = (LAS int*)(lds + LDS_MISC + 256); LAS int* cnts = (LAS int*)(lds + LDS_MISC + 512);
    const int* LIST = (const int*)(ws + WS_LIST); const float* RSTD = (const float*)(ws + WS_RSTD); const float* GATE = (const float*)(ws + WS_GATE);
    bf16* XT = XB; bf16* ACT = U; bf16* Y = Vb; const bf16* Wgu = (const bf16*)(ws + WS_WGU); const bf16* Wd = (const bf16*)(ws + WS_WD);
#define MOE_GEMMS(l, p1, p2) do { \
        if (IN(p1)) { fg::moe_setup((const int*)(ws + WS_CTL) + (l) * NE, pref, cnts); \
            fg::MoeP<fg::EpiSwiglu> p{(const char*)XT, D, 1, (const char*)(Wgu + (size_t)(l) * NE * 1024 * D), (size_t)1024 * D * 2, D, LIST, pref, cnts, G, bx, 4 * __builtin_amdgcn_readfirstlane(pref[32]), {RSTD, ACT}}; \
            fg::gemm_phase(lds, p); } \
        SEAM(p1); \
        if (IN(p2)) { fg::moe_setup((const int*)(ws + WS_CTL) + (l) * NE, pref, cnts); \
            fg::MoeP<fg::EpiDown> p{(const char*)ACT, DE, 0, (const char*)(Wd + (size_t)(l) * NE * D * DE), (size_t)D * DE * 2, DE, LIST, pref, cnts, G, bx, 4 * __builtin_amdgcn_readfirstlane(pref[32]), {GATE, Y}}; \
            fg::gemm_phase(lds, p); } \
        SEAM(p2); } while (0)
    float* Wr = (float*)(ws + WS_WR); int* CNT = (int*)(ws + WS_CTL);
    if (IN(4)) th::route(H, Wr, a.in[25], a.in[27], XT, (float*)RSTD, (int*)LIST, CNT, (float*)GATE, G, bx);
    SEAM(4);
    MOE_GEMMS(0, 5, 6);
    if (IN(7)) th::combine(H, Y, HB, RSTD2, G, bx);
    SEAM(7);
    if (IN(8)) { fg::DenseP<fg::EpiCL> p{(const char*)HB, D, (const char*)Wc, D, {}, {RSTD2, CL, SSP}}; p.S.init(T, NCL, G, bx); fg::gemm_phase(lds, p); }
    SEAM(8);
    if (IN(9)) {
        { fg::DenseP<fg::EpiQ> p{(const char*)(CL + 320), NCL, (const char*)Wuq, QLR, {}, {SSP, QRAW, SSQ}}; p.S.init(T, 1536, G, bx); fg::gemm_phase(lds, p); }
        { fg::DenseP<fg::EpiKV> p{(const char*)CL, NCL, (const char*)Wukv, KVR, {}, {SSP, KN, VV, SSK}}; p.S.init(T, 2048, G, bx); fg::gemm_phase(lds, p); }
    }
    SEAM(9);
    if (IN(10)) th::kfin(KN, CL, SSK, SSP, a.in[16], (const float*)(ws + WS_CS), (bf16*)(ws + WS_KK), G, bx);
    SEAM(10);
    if (IN(11)) { const at::AttnArgs aa{QRAW, SSQ, a.in[21], (const float*)(ws + WS_CS), (const bf16*)(ws + WS_KK), VV, O}; at::attn_phase(lds, aa, G, bx); }
    SEAM(11);
    if (IN(12)) { fg::DenseP<fg::EpiRes> p{(const char*)O, D, (const char*)Wo, D, {}, {H, nullptr, H}}; p.S.init(T, D, G, bx); fg::gemm_phase(lds, p); }
    SEAM(12);
    if (IN(13)) th::route(H, Wr + (size_t)D * NRT, a.in[25] + NG, a.in[27] + NE, XT, (float*)RSTD, (int*)LIST, CNT + NE, (float*)GATE, G, bx);
    SEAM(13);
    MOE_GEMMS(1, 14, 15);
    if (IN(16)) th::combine(H, Y, nullptr, nullptr, G, bx);
#undef MOE_GEMMS
#undef IN
#undef SEAM
}

extern "C" void kernel_launch(void* const* d_in, const int* in_sizes, int n_in, void* d_out, int out_size, void* d_ws, size_t ws_size, hipStream_t stream) {
    if (n_in != 30 || ws_size < WS_END || out_size != T * D) { fprintf(stderr, "kernel_launch: unexpected shapes (n_in %d, ws %zu, out %d)\n", n_in, ws_size, out_size); return; }
    static int grid = 0;
    if (!grid) {
        (void)hipFuncSetAttribute((const void*)fwd, hipFuncAttributeMaxDynamicSharedMemorySize, LDS_BYTES);
        int dev = 0, cus = 0; (void)hipGetDevice(&dev); if (hipDeviceGetAttribute(&cus, hipDeviceAttributeMultiprocessorCount, dev) != hipSuccess || cus <= 0) cus = 256;
        grid = cus;
    }
    char* ws = (char*)d_ws;
    Args a{}; for (int i = 0; i < 30; ++i) a.in[i] = (const float*)d_in[i]; a.out = (float*)d_out; a.ws = (unsigned char*)d_ws;
    (void)hipMemsetAsync(ws + WS_CTL, 0, 1 * MiB, stream);
    a.ph_lo = 0; a.ph_hi = NPHASE;
    hipLaunchKernelGGL(fwd, dim3(grid), dim3(NWAVES * 64), LDS_BYTES, stream, a);
}
```

```cpp
#include <hip/hip_runtime.h>
#include <stdint.h>
#include <stdio.h>

typedef unsigned short bf16;
constexpr int NB = 4, SEQ = 8192, T = NB * SEQ, D = 1024, NH = 8, DQK = 192, DNOPE = 128, DROPE = 64, DV = 128, KVR = 256, QLR = 384;
constexpr int NE = 32, NG = 4, EPG = 8, DE = 512, CONVW = 31, NCL = 768, NRT = 36;
constexpr float EPS = 1e-6f;
constexpr float SM_SCALE = 0.07216878364870322f;

constexpr size_t MiB = 1u << 20;
constexpr size_t WS_CTL = 0, WS_W1T = 1 * MiB, WS_W2T = 5 * MiB, WS_WC = 7 * MiB, WS_WUKV = 9 * MiB, WS_WUQ = 10 * MiB, WS_WO = 12 * MiB, WS_WR = 14 * MiB,
                 WS_WGU = 16 * MiB, WS_WD = 144 * MiB, WS_RSTD0 = 208 * MiB, WS_RSTD = WS_RSTD0 + 256 * 1024, WS_RSTD2 = WS_RSTD0 + 512 * 1024,
                 WS_GATE = 209 * MiB, WS_LIST = 210 * MiB, WS_CS = 214 * MiB, WS_SSP = 222 * MiB, WS_SSQ = 226 * MiB, WS_SSK = 232 * MiB,
                 WS_R1 = 236 * MiB, WS_R2 = 300 * MiB, WS_R3 = 364 * MiB, WS_CL = 492 * MiB, WS_QRAW = 540 * MiB, WS_KK = 636 * MiB, WS_LISTR = 732 * MiB  , WS_ACTS = 748 * MiB  , WS_YS = 828 * MiB  ,  WS_END = 988 * MiB;

__device__ const float INV_FREQ[32] = {
    1.0f, 0.7498942093324559f, 0.5623413251903491f, 0.4216965034285822f, 0.31622776601683794f, 0.23713737056616552f, 0.1778279410038923f, 0.1333521432163324f,
    0.1f, 0.07498942093324558f, 0.05623413251903491f, 0.04216965034285822f, 0.03162277660168379f, 0.023713737056616554f, 0.01778279410038923f, 0.01333521432163324f,
    0.01f, 0.007498942093324558f, 0.005623413251903491f, 0.004216965034285823f, 0.0031622776601683794f, 0.0023713737056616554f, 0.001778279410038923f, 0.001333521432163324f,
    0.001f, 0.0007498942093324559f, 0.0005623413251903491f, 0.00042169650342858224f, 0.00031622776601683794f, 0.00023713737056616554f, 0.0001778279410038923f, 0.0001333521432163324f};

__device__ __forceinline__ float bf2f(bf16 b) { return __uint_as_float(((unsigned)b) << 16); }
__device__ __forceinline__ bf16 f2bf(float f) { unsigned u = __float_as_uint(f); u += 0x7fffu + ((u >> 16) & 1u); return (bf16)(u >> 16); }
__device__ __forceinline__ float wave_sum(float v) {
#pragma unroll
    for (int o = 1; o < 64; o <<= 1) v += __shfl_xor(v, o);
    return v;
}
__device__ __forceinline__ float sigmoidf_(float x) { return 1.0f / (1.0f + __expf(-x)); }
__device__ __forceinline__ float siluf_(float x) { return x / (1.0f + __expf(-x)); }
__host__ __device__ __forceinline__ int pair_row(int n, int half) { const int j = n % half, hf = n / half; return 256 * (j / 128) + 128 * hf + (j % 128); }

__device__ __forceinline__ void sincos_d(double a, double& s, double& c) {
    const double TWO_PI = 6.283185307179586476925287, PI = 3.14159265358979323846;
    double k = __builtin_rint(a / TWO_PI); double r = a - k * TWO_PI;
    double q = __builtin_rint(r / (PI * 0.5)); double y = r - q * (PI * 0.5); int qi = ((int)q) & 3;
    const double y2 = y * y;
    double sp = y * (1.0 + y2 * (-1.0 / 6 + y2 * (1.0 / 120 + y2 * (-1.0 / 5040 + y2 * (1.0 / 362880 + y2 * (-1.0 / 39916800 + y2 * (1.0 / 6227020800.0)))))));
    double cp = 1.0 + y2 * (-0.5 + y2 * (1.0 / 24 + y2 * (-1.0 / 720 + y2 * (1.0 / 40320 + y2 * (-1.0 / 3628800 + y2 * (1.0 / 479001600.0 + y2 * (-1.0 / 87178291200.0)))))));
    if (qi == 0) { s = sp; c = cp; } else if (qi == 1) { s = cp; c = -sp; } else if (qi == 2) { s = -sp; c = -cp; } else { s = -cp; c = sp; }
}

constexpr int NWAVES_ = 8;
#define LAS __attribute__((address_space(3)))
#define GAS __attribute__((address_space(1)))
typedef short bf16x8 __attribute__((ext_vector_type(8)));
typedef float f32x4 __attribute__((ext_vector_type(4)));
typedef float f32x2 __attribute__((ext_vector_type(2)));
typedef unsigned u32x4 __attribute__((ext_vector_type(4)));
typedef unsigned u32x2 __attribute__((ext_vector_type(2)));

__device__ __forceinline__ unsigned cvt_pk_bf16(float lo, float hi) { unsigned r; asm volatile("v_cvt_pk_bf16_f32 %0, %1, %2" : "=v"(r) : "v"(lo), "v"(hi)); return r; }
__device__ __forceinline__ float fast_sigmoid(float x) { return __builtin_amdgcn_rcpf(1.0f + __builtin_amdgcn_exp2f(-1.4426950408889634f * x)); }
__device__ __forceinline__ float fast_rsqrt(float x) { return 1.0f / sqrtf(x); }

namespace fg {
constexpr int BM = 256, BK = 64, HALF = 128, HTB = HALF * BK * 2, STAGE_BYTES = 8 * HTB, NXCD = 8, WGM = 8;
__host__ __device__ __forceinline__ int lds_byte(int r, int c) { const int st = (r >> 4) * 2 + (c >> 5), rr = r & 15, cc = c & 31, ob = rr * 64 + cc * 2; return st * 1024 + (ob ^ (((ob >> 9) & 1) << 5)); }
__host__ __device__ __forceinline__ void stage_rc(int b, int& R, int& C) { const int st = b / 1024, sb = b % 1024, swz = sb ^ (((sb >> 9) & 1) << 5); R = (st >> 1) * 16 + swz / 64; C = (st & 1) * 32 + (swz % 64) / 2; }
__host__ __device__ __forceinline__ int perm32(int rho) { const int n = rho >> 4, i = rho & 15; return 8 * (i >> 2) + 4 * n + (i & 3); }
struct Unit { int pm, pn, e, nvalid, r; };
typedef f32x4 Acc[2][2][4][2];

struct StaticOrder {
    int nM, nN, nwg, G, c;
    __device__ void init(int M, int N, int G_, int c_) { nM = M / BM; nN = N / BM; nwg = nM * nN; G = G_; c = c_; }
    __device__ bool next(int i, Unit& u) const {
        const long L = (long)i * G + c; if (L >= nwg) return false;
        int wgid = (int)L; { const int q = nwg / NXCD, r = nwg % NXCD, xcd = wgid % NXCD, off = wgid / NXCD; wgid = (xcd < r ? xcd * (q + 1) : r * (q + 1) + (xcd - r) * q) + off; }
        const int nig = WGM * nN, gid = wgid / nig, fm = gid * WGM, gsz = (nM - fm) < WGM ? (nM - fm) : WGM;
        u.pm = fm + ((wgid % nig) % gsz); u.pn = (wgid % nig) / gsz; u.e = 0; u.nvalid = 256; u.r = u.pm; return true;
    }
};

template <class P>
__device__ __forceinline__ void gemm_phase(LAS unsigned char* lds, const P& p) {
    int tid_ = threadIdx.x; asm volatile("" : "+v"(tid_));
    const int tid = tid_, wid = __builtin_amdgcn_readfirstlane(tid >> 6), lane = tid & 63, wr = wid >> 2, wc = wid & 3, fr = lane & 15, fq = lane >> 4;
    const int K = p.K, nt = K / BK;
    int sR[2], sC[2]; unsigned voffB[2];
#pragma unroll
    for (int i = 0; i < 2; ++i) { int R, C; stage_rc(tid * 16 + i * 8192, R, C); sR[i] = R; sC[i] = C; const int Rb = P::PERM ? ((R & ~31) + perm32(R & 31)) : R; voffB[i] = (unsigned)(Rb * K + C) * 2u; }
    const size_t kstep = (size_t)(BK * 2), hstepB = (size_t)HALF * K * 2;
    const unsigned ldsw = (unsigned)wid * 1024u;
    const int aoff = lds_byte(wr * 64 + fr, fq * 8), boff = lds_byte(wc * 32 + fr, fq * 8);
#define FG_SA(b, h) (((b) * 2 + (h)) * HTB)
#define FG_SB(b, h) ((4 + (b) * 2 + (h)) * HTB)
#define FG_STAGE(bufoff, gbase, voff) do { _Pragma("unroll") for (int _i = 0; _i < 2; ++_i) \
        __builtin_amdgcn_global_load_lds((const unsigned*)((const char*)(gbase) + (voff)[_i]), (LAS unsigned*)(lds + (bufoff) + ldsw + _i * 8192), 16, 0, 0); } while (0)
#define FG_LDA(dst, b, h) do { _Pragma("unroll") for (int m = 0; m < 4; ++m) _Pragma("unroll") for (int k = 0; k < 2; ++k) dst[m][k] = *(const LAS bf16x8*)(lds + FG_SA(b, h) + aoff + m * 2048 + k * 1024); } while (0)
#define FG_LDB(dst, b, h) do { _Pragma("unroll") for (int n = 0; n < 2; ++n) _Pragma("unroll") for (int k = 0; k < 2; ++k) dst[n][k] = *(const LAS bf16x8*)(lds + FG_SB(b, h) + boff + n * 2048 + k * 1024); } while (0)
#define FG_MMA(ai, bj, At, Bt) do { __builtin_amdgcn_s_setprio(1); _Pragma("unroll") for (int m = 0; m < 4; ++m) _Pragma("unroll") for (int n = 0; n < 2; ++n) _Pragma("unroll") for (int k = 0; k < 2; ++k) \
        acc[ai][bj][m][n] = __builtin_amdgcn_mfma_f32_16x16x32_bf16(Bt[n][k], At[m][k], acc[ai][bj][m][n], 0, 0, 0); __builtin_amdgcn_s_setprio(0); } while (0)
#define FG_WAIT_V(n) asm volatile("s_waitcnt vmcnt(" #n ")" ::: "memory")
#define FG_WAIT_L(n) asm volatile("s_waitcnt lgkmcnt(" #n ")" ::: "memory")
#define FG_BAR __builtin_amdgcn_s_barrier()
#define FG_SCHED __builtin_amdgcn_sched_barrier(0)
    Unit cur, nxt, nn; int ui = 0;
    if (!p.next(0, cur)) return;
    unsigned ao[4], nao[4], nnao[4];
    p.a_off(cur, sR, sC, ao);
    bool has_next = p.next(1, nxt);
    if (has_next) p.a_off(nxt, sR, sC, nao); else { nxt = cur; _Pragma("unroll") for (int j = 0; j < 4; ++j) nao[j] = ao[j]; }
    Acc acc;
#pragma unroll
    for (int a = 0; a < 2; ++a)
#pragma unroll
        for (int b = 0; b < 2; ++b)
#pragma unroll
            for (int m = 0; m < 4; ++m)
#pragma unroll
                for (int n = 0; n < 2; ++n) acc[a][b][m][n] = (f32x4){0.f, 0.f, 0.f, 0.f};
    bf16x8 At[4][2], B0[2][2], B1[2][2];
    const char* const Ab = p.A;
    const char* cB = p.b_base(cur);
    FG_STAGE(FG_SB(0, 0), cB, voffB); FG_STAGE(FG_SB(0, 1), cB + hstepB, voffB); FG_STAGE(FG_SA(0, 0), Ab, ao); FG_STAGE(FG_SA(0, 1), Ab, ao + 2);
    if (wr == 1) FG_BAR;
    FG_WAIT_V(2); FG_BAR;
    FG_STAGE(FG_SB(1, 0), cB + kstep, voffB); FG_STAGE(FG_SA(1, 0), Ab + kstep, ao); FG_STAGE(FG_SB(1, 1), cB + hstepB + kstep, voffB);
    FG_WAIT_V(6); FG_BAR;
    for (;;) {
        const char* nB = has_next ? p.b_base(nxt) : cB;
        for (int t = 0; t < nt; t += 2) {
            const bool last = (t == nt - 2);
            const char* a1 = Ab + (size_t)(t + 1) * kstep;
            const char* a2 = last ? Ab : Ab + (size_t)(t + 2) * kstep; const char* b2 = last ? nB : cB + (size_t)(t + 2) * kstep;
            const char* a3 = a2 + kstep; const char* b3 = b2 + kstep;
            unsigned so[4];
#pragma unroll
            for (int j = 0; j < 4; ++j) so[j] = last ? nao[j] : ao[j];
            FG_LDB(B0, 0, 0); FG_LDB(B1, 0, 1); FG_SCHED; FG_LDA(At, 0, 0); FG_STAGE(FG_SA(1, 1), a1, ao + 2);
            FG_WAIT_V(8); FG_WAIT_L(0); FG_BAR; FG_MMA(0, 0, At, B0); FG_MMA(0, 1, At, B1); FG_BAR; FG_SCHED;
            FG_LDA(At, 0, 1); FG_STAGE(FG_SB(0, 0), b2, voffB); FG_STAGE(FG_SB(0, 1), b2 + hstepB, voffB); FG_STAGE(FG_SA(0, 0), a2, so);
            FG_WAIT_V(8); FG_WAIT_L(0); FG_BAR; FG_MMA(1, 0, At, B0); FG_MMA(1, 1, At, B1); FG_BAR; FG_SCHED;
            FG_LDB(B0, 1, 0); FG_LDB(B1, 1, 1); FG_SCHED; FG_LDA(At, 1, 0); FG_STAGE(FG_SA(0, 1), a2, so + 2);
            FG_WAIT_V(8); FG_WAIT_L(0); FG_BAR; FG_MMA(0, 0, At, B0); FG_MMA(0, 1, At, B1); FG_BAR; FG_SCHED;
            FG_LDA(At, 1, 1); FG_STAGE(FG_SB(1, 0), b3, voffB); FG_STAGE(FG_SB(1, 1), b3 + hstepB, voffB); FG_STAGE(FG_SA(1, 0), a3, so);
            FG_WAIT_V(8); FG_WAIT_L(0); FG_BAR; FG_MMA(1, 0, At, B0); FG_MMA(1, 1, At, B1); FG_BAR; FG_SCHED;
        }
        if (wr == 0) FG_BAR;
        const bool has_nn = has_next && p.next(ui + 2, nn);
        if (has_nn) p.a_off(nn, sR, sC, nnao); else { nn = nxt; _Pragma("unroll") for (int j = 0; j < 4; ++j) nnao[j] = nao[j]; }
        p.epi(acc, cur, wr, wc, fr, fq);
        if (!has_next) break;
#pragma unroll
        for (int a = 0; a < 2; ++a)
#pragma unroll
            for (int b = 0; b < 2; ++b)
#pragma unroll
                for (int m = 0; m < 4; ++m)
#pragma unroll
                    for (int n = 0; n < 2; ++n) acc[a][b][m][n] = (f32x4){0.f, 0.f, 0.f, 0.f};
        cur = nxt; cB = nB; nxt = nn; has_next = has_nn; ++ui;
#pragma unroll
        for (int j = 0; j < 4; ++j) { ao[j] = nao[j]; nao[j] = nnao[j]; }
        if (wr == 1) FG_BAR;
    }
    FG_WAIT_V(0);
    FG_BAR;
#undef FG_SA
#undef FG_SB
#undef FG_STAGE
#undef FG_LDA
#undef FG_LDB
#undef FG_MMA
#undef FG_WAIT_V
#undef FG_WAIT_L
#undef FG_BAR
#undef FG_SCHED
}

template <class Epi> struct DenseP {
    static constexpr bool PERM = Epi::PERM;
    const char* A; int lda; const char* Bt; int K; StaticOrder S; Epi E;
    __device__ __forceinline__ bool next(int i, Unit& u) const { return S.next(i, u); }
    __device__ __forceinline__ const char* b_base(const Unit& u) const { return Bt + (size_t)u.pn * BM * K * 2; }
    __device__ __forceinline__ void a_off(const Unit& u, const int (&sR)[2], const int (&sC)[2], unsigned (&ao)[4]) const {
#pragma unroll
        for (int h = 0; h < 2; ++h)
#pragma unroll
            for (int i = 0; i < 2; ++i) ao[h * 2 + i] = (unsigned)((u.pm * BM + h * HALF + sR[i]) * lda + sC[i]) * 2u;
    }
    __device__ __forceinline__ void epi(const Acc& acc, const Unit& u, int wr, int wc, int fr, int fq) const { E(acc, u, wr, wc, fr, fq); }
};

struct EpiGlu {
    static constexpr bool PERM = true;
    const float* rstd; const float* bias; bf16* U;
    __device__ __forceinline__ void operator()(const Acc& acc, const Unit& u, int wr, int wc, int fr, int fq) const {
        const int col = u.pn * 128 + wc * 32 + fq * 8, row0 = u.pm * BM + wr * 64 + fr;
        const f32x4 ba0 = *(const f32x4*)(bias + col), ba1 = *(const f32x4*)(bias + col + 4), bg0 = *(const f32x4*)(bias + 1024 + col), bg1 = *(const f32x4*)(bias + 1024 + col + 4);
        float rsv[8];
#pragma unroll
        for (int q = 0; q < 8; ++q) rsv[q] = rstd[row0 + (q >> 2) * HALF + (q & 3) * 16];
#pragma unroll
        for (int ai = 0; ai < 2; ++ai)
#pragma unroll
            for (int m = 0; m < 4; ++m) { const int row = row0 + ai * HALF + m * 16; const float rs = rsv[ai * 4 + m];
                const f32x4 a0 = acc[ai][0][m][0] * rs + ba0, a1 = acc[ai][0][m][1] * rs + ba1, g0 = acc[ai][1][m][0] * rs + bg0, g1 = acc[ai][1][m][1] * rs + bg1;
                float o[8];
#pragma unroll
                for (int j = 0; j < 4; ++j) { o[j] = a0[j] * fast_sigmoid(g0[j]); o[4 + j] = a1[j] * fast_sigmoid(g1[j]); }
                u32x4 w; w.x = cvt_pk_bf16(o[0], o[1]); w.y = cvt_pk_bf16(o[2], o[3]); w.z = cvt_pk_bf16(o[4], o[5]); w.w = cvt_pk_bf16(o[6], o[7]);
                *(u32x4*)(U + (size_t)row * D + col) = w; }
    }
};
struct EpiRes {
    static constexpr bool PERM = false;
    const float* base; const float* bias; float* out;
    __device__ __forceinline__ void operator()(const Acc& acc, const Unit& u, int wr, int wc, int fr, int fq) const {
        const int row0 = u.pm * BM + wr * 64 + fr, col0 = u.pn * BM + wc * 32 + 4 * fq;
        f32x4 bv[2][2];
#pragma unroll
        for (int bj = 0; bj < 2; ++bj)
#pragma unroll
            for (int n = 0; n < 2; ++n) bv[bj][n] = bias ? *(const f32x4*)(bias + col0 + bj * HALF + n * 16) : (f32x4){0.f, 0.f, 0.f, 0.f};
#pragma unroll
        for (int ai = 0; ai < 2; ++ai)
#pragma unroll
        for (int mh = 0; mh < 2; ++mh) {
            f32x4 bs[2][2][2];
#pragma unroll
            for (int m2 = 0; m2 < 2; ++m2) { const size_t off = (size_t)(row0 + ai * HALF + (mh * 2 + m2) * 16) * D + col0;
#pragma unroll
                for (int bj = 0; bj < 2; ++bj)
#pragma unroll
                    for (int n = 0; n < 2; ++n) bs[m2][bj][n] = *(const f32x4*)(base + off + bj * HALF + n * 16); }
            asm volatile("" ::: "memory");
#pragma unroll
            for (int m2 = 0; m2 < 2; ++m2) { const int m = mh * 2 + m2; const size_t off = (size_t)(row0 + ai * HALF + m * 16) * D + col0;
#pragma unroll
                for (int bj = 0; bj < 2; ++bj)
#pragma unroll
                    for (int n = 0; n < 2; ++n) *(f32x4*)(out + off + bj * HALF + n * 16) = bs[m2][bj][n] + acc[ai][bj][m][n] + bv[bj][n]; }
            asm volatile("" ::: "memory");
        }
    }
};
__device__ __forceinline__ float quad_sum(float s) { s += __shfl_xor(s, 16); s += __shfl_xor(s, 32); return s; }
__device__ __forceinline__ u32x4 pack8(const f32x4 a, const f32x4 b) { u32x4 w; w.x = cvt_pk_bf16(a[0], a[1]); w.y = cvt_pk_bf16(a[2], a[3]); w.z = cvt_pk_bf16(b[0], b[1]); w.w = cvt_pk_bf16(b[2], b[3]); return w; }
__device__ __forceinline__ float sumsq8(const f32x4 a, const f32x4 b) { return (a[0] * a[0] + a[1] * a[1]) + (a[2] * a[2] + a[3] * a[3]) + (b[0] * b[0] + b[1] * b[1]) + (b[2] * b[2] + b[3] * b[3]); }
struct EpiCL {
    static constexpr bool PERM = true;
    const float* rstd2; bf16* CL; float* SSP;
    __device__ __forceinline__ void operator()(const Acc& acc, const Unit& u, int wr, int wc, int fr, int fq) const {
        const int row0 = u.pm * BM + wr * 64 + fr;
        float rsv[8];
#pragma unroll
        for (int q = 0; q < 8; ++q) rsv[q] = rstd2[row0 + (q >> 2) * HALF + (q & 3) * 16];
#pragma unroll
        for (int ai = 0; ai < 2; ++ai)
#pragma unroll
            for (int m = 0; m < 4; ++m) { const int row = row0 + ai * HALF + m * 16; const float rs = rsv[ai * 4 + m];
#pragma unroll
                for (int bj = 0; bj < 2; ++bj) { const f32x4 v0 = acc[ai][bj][m][0] * rs, v1 = acc[ai][bj][m][1] * rs; const float ss = quad_sum(sumsq8(v0, v1));
                    *(u32x4*)(CL + (size_t)row * NCL + u.pn * BM + bj * HALF + wc * 32 + fq * 8) = pack8(v0, v1);
                    const int g = u.pn * 8 + bj * 4 + wc; if (fq == 0) SSP[row * 32 + (g < 10 ? g : g + 2)] = ss; } }
    }
};
struct EpiQ {
    static constexpr bool PERM = true;
    const float* SSP; bf16* QRAW; float* SSQ;
    __device__ __forceinline__ void operator()(const Acc& acc, const Unit& u, int wr, int wc, int fr, int fq) const {
        const int row0 = u.pm * BM + wr * 64 + fr;
        float rsv[8];
#pragma unroll
        for (int q = 0; q < 8; ++q) { const int row = row0 + (q >> 2) * HALF + (q & 3) * 16;
            const f32x4 s0 = *(const f32x4*)(SSP + row * 32 + 12), s1 = *(const f32x4*)(SSP + row * 32 + 16), s2 = *(const f32x4*)(SSP + row * 32 + 20);
            rsv[q] = ((s0[0] + s0[1]) + (s0[2] + s0[3])) + ((s1[0] + s1[1]) + (s1[2] + s1[3])) + ((s2[0] + s2[1]) + (s2[2] + s2[3]));
            if (q == 3) asm volatile("" : "+v"(rsv[0]), "+v"(rsv[1]), "+v"(rsv[2]), "+v"(rsv[3]) :: "memory"); }
#pragma unroll
        for (int q = 0; q < 8; ++q) rsv[q] = fast_rsqrt(rsv[q] * (1.0f / QLR) + EPS);
#pragma unroll
        for (int ai = 0; ai < 2; ++ai)
#pragma unroll
            for (int m = 0; m < 4; ++m) { const int row = row0 + ai * HALF + m * 16; const float rs = rsv[ai * 4 + m];
#pragma unroll
                for (int bj = 0; bj < 2; ++bj) { const f32x4 v0 = acc[ai][bj][m][0] * rs, v1 = acc[ai][bj][m][1] * rs; const float ss = quad_sum(sumsq8(v0, v1));
                    *(u32x4*)(QRAW + (size_t)row * 1536 + u.pn * BM + bj * HALF + wc * 32 + fq * 8) = pack8(v0, v1);
                    if (fq == 0) SSQ[row * 48 + u.pn * 8 + bj * 4 + wc] = ss; } }
    }
};
struct EpiKV {
    static constexpr bool PERM = true;
    const float* SSP; bf16* KN; bf16* VV; float* SSK;
    __device__ __forceinline__ void operator()(const Acc& acc, const Unit& u, int wr, int wc, int fr, int fq) const {
        const int row0 = u.pm * BM + wr * 64 + fr;
        float rsv[8];
#pragma unroll
        for (int q = 0; q < 8; ++q) { const int row = row0 + (q >> 2) * HALF + (q & 3) * 16;
            const f32x4 s0 = *(const f32x4*)(SSP + row * 32), s1 = *(const f32x4*)(SSP + row * 32 + 4);
            rsv[q] = ((s0[0] + s0[1]) + (s0[2] + s0[3])) + ((s1[0] + s1[1]) + (s1[2] + s1[3])); }
#pragma unroll
        for (int q = 0; q < 8; ++q) rsv[q] = fast_rsqrt(rsv[q] * (1.0f / KVR) + EPS);
#pragma unroll
        for (int ai = 0; ai < 2; ++ai)
#pragma unroll
            for (int m = 0; m < 4; ++m) { const int row = row0 + ai * HALF + m * 16; const float rs = rsv[ai * 4 + m];
                { const f32x4 v0 = acc[ai][0][m][0] * rs, v1 = acc[ai][0][m][1] * rs; const float ss = quad_sum(sumsq8(v0, v1));
                  *(u32x4*)(KN + (size_t)row * D + u.pn * 128 + wc * 32 + fq * 8) = pack8(v0, v1);
                  if (fq == 0) SSK[row * 32 + u.pn * 4 + wc] = ss; }
                { const f32x4 v0 = acc[ai][1][m][0] * rs, v1 = acc[ai][1][m][1] * rs; const int b = row / SEQ, sq = row % SEQ;
                  *(u32x4*)(VV + (((size_t)b * NH + u.pn) * SEQ + sq) * DV + wc * 32 + fq * 8) = pack8(v0, v1); } }
    }
};

__device__ __forceinline__ void moe_setup(const int* CNT, LAS int* pref, LAS int* cnts) {
    const int tid = threadIdx.x;
    if (tid < 64) { const int c = tid < 32 ? (int)__hip_atomic_load((const unsigned*)CNT + tid * 64, __ATOMIC_RELAXED, __HIP_MEMORY_SCOPE_AGENT) : 0; int incl = (c + 255) >> 8;
#pragma unroll
        for (int o = 1; o < 32; o <<= 1) { const int v = __shfl_up(incl, o); if (tid >= o) incl += v; }
        if (tid < 32) { pref[tid + 1] = incl; cnts[tid] = c; } if (tid == 0) pref[0] = 0; }
    __syncthreads();
}
template <class Epi, bool GATHER> struct MoeP {
    static constexpr bool PERM = true;
    const char* A; int lda; int a_shift; const char* Bt; size_t b_estride; int K; const int4* LIST; const LAS int* pref; const LAS int* cnts; int G, c, nunits; Epi E;
    __device__ __forceinline__ bool next(int i, Unit& u) const {
        const int L = i * G + c; if (L >= nunits) return false;
        const int r = L >> 2, lane = threadIdx.x & 63; const int v = pref[(lane & 31) + 1];
        const int e = __builtin_popcountll(__ballot(lane < 32 && r >= v));
        u.pn = L & 3; u.e = e; u.r = r; u.pm = r - __builtin_amdgcn_readfirstlane(pref[e]); const int rem = __builtin_amdgcn_readfirstlane(cnts[e]) - BM * u.pm; u.nvalid = rem < BM ? rem : BM; return true;
    }
    __device__ __forceinline__ const char* b_base(const Unit& u) const { return Bt + (size_t)u.e * b_estride + (size_t)u.pn * BM * K * 2; }
    __device__ __forceinline__ void a_off(const Unit& u, const int (&sR)[2], const int (&sC)[2], unsigned (&ao)[4]) const {
        if constexpr (GATHER) {
            const int4* lp = LIST + (size_t)u.e * T + u.pm * BM;
#pragma unroll
            for (int h = 0; h < 2; ++h)
#pragma unroll
                for (int i = 0; i < 2; ++i) { const int row = h * HALF + sR[i]; int ent = lp[row].x; ent = row < u.nvalid ? ent : 0; ao[h * 2 + i] = (unsigned)((ent >> a_shift) * lda + sC[i]) * 2u; }
        } else {
#pragma unroll
            for (int h = 0; h < 2; ++h)
#pragma unroll
                for (int i = 0; i < 2; ++i) ao[h * 2 + i] = (unsigned)((u.r * BM + h * HALF + sR[i]) * lda + sC[i]) * 2u;
        }
    }
    __device__ __forceinline__ void epi(const Acc& acc, const Unit& u, int wr, int wc, int fr, int fq) const { E(acc, u, wr, wc, fr, fq, LIST + (size_t)u.e * T + u.pm * BM); }
};
struct EpiSwiglu {
    bf16* ACTS; int* POS;
    __device__ __forceinline__ void operator()(const Acc& acc, const Unit& u, int wr, int wc, int fr, int fq, const int4* lp) const {
        int4 rec[8];
#pragma unroll
        for (int q = 0; q < 8; ++q) { const int row = (q >> 2) * HALF + wr * 64 + (q & 3) * 16 + fr; rec[q] = lp[row]; }
#pragma unroll
        for (int ai = 0; ai < 2; ++ai)
#pragma unroll
            for (int m = 0; m < 4; ++m) { const int q = ai * 4 + m, row = ai * HALF + wr * 64 + m * 16 + fr; const float rs = __int_as_float(rec[q].y);
                const f32x4 a0 = acc[ai][0][m][0] * rs, a1 = acc[ai][0][m][1] * rs, b0 = acc[ai][1][m][0] * rs, b1 = acc[ai][1][m][1] * rs;
                float o[8];
#pragma unroll
                for (int j = 0; j < 4; ++j) { o[j] = a0[j] * fast_sigmoid(a0[j]) * b0[j]; o[4 + j] = a1[j] * fast_sigmoid(a1[j]) * b1[j]; }
                u32x4 w; w.x = cvt_pk_bf16(o[0], o[1]); w.y = cvt_pk_bf16(o[2], o[3]); w.z = cvt_pk_bf16(o[4], o[5]); w.w = cvt_pk_bf16(o[6], o[7]);
                *(u32x4*)(ACTS + (size_t)(u.r * BM + row) * DE + u.pn * 128 + wc * 32 + fq * 8) = w;
                if (u.pn == 0 && wc == 0 && fq == 0 && row < u.nvalid) POS[rec[q].x] = u.r * BM + row; }
    }
};
struct EpiDown {
    bf16* YS;
    __device__ __forceinline__ void operator()(const Acc& acc, const Unit& u, int wr, int wc, int fr, int fq, const int4*) const {
#pragma unroll
        for (int ai = 0; ai < 2; ++ai)
#pragma unroll
            for (int m = 0; m < 4; ++m) { const int row = ai * HALF + wr * 64 + m * 16 + fr;
#pragma unroll
                for (int bj = 0; bj < 2; ++bj) *(u32x4*)(YS + (size_t)(u.r * BM + row) * D + u.pn * BM + bj * HALF + wc * 32 + fq * 8) = pack8(acc[ai][bj][m][0], acc[ai][bj][m][1]); }
    }
};
}


namespace at {
typedef short s16x4 __attribute__((ext_vector_type(4)));
typedef float f32x16 __attribute__((ext_vector_type(16)));
constexpr int KTB = 64 * 384, VTB = 64 * 256, LDS_K = 0, LDS_V = 2 * KTB, LDS_AL = LDS_V + 2 * VTB, LDS_TOTAL = LDS_AL + 8 * 256;
constexpr float THR2 = 11.0f;
__device__ __forceinline__ int v_rd_base(int lane) { return ((lane & 3) << 3) | (((lane >> 2) & 3) << 6) | (((lane >> 4) & 1) << 5) | (((lane >> 5) & 1) << 8); }
constexpr int v_rd_off(int d0, int ks, int half) { return d0 * 512 + ks * 4096 + half * 2048; }
__device__ __forceinline__ int crow(int r, int hi) { return (r & 3) + 8 * (r >> 2) + 4 * hi; }
#define AT_SBAR() __builtin_amdgcn_sched_barrier(0)

template <int BUF>
__device__ __forceinline__ void tile_compute(f32x16 (&o)[4], const bf16x8 (&qr)[12], float& m_run, float& l_run, const LAS char* kb0, const LAS char* kb1, const LAS char* kb2, const LAS char* kb3,
                                             int vb0, LAS float* al_l, int r32, int hi) {
    f32x16 p0 = {}, p1 = {};
#define AT_KA(s) (((s & 3) == 0 ? kb0 : (s & 3) == 1 ? kb1 : (s & 3) == 2 ? kb2 : kb3) + (s >> 2) * 8192 + BUF * KTB)
#define AT_LOADB(kf, s_) do { const LAS char* a_ = AT_KA(s_); kf[0] = *(const LAS bf16x8*)a_; kf[1] = *(const LAS bf16x8*)(a_ + 32 * 128); } while (0)
#define AT_MMAB(kf, s_) do { __builtin_amdgcn_s_setprio(1); p0 = __builtin_amdgcn_mfma_f32_32x32x16_bf16(kf[0], qr[s_], p0, 0, 0, 0); p1 = __builtin_amdgcn_mfma_f32_32x32x16_bf16(kf[1], qr[s_], p1, 0, 0, 0); __builtin_amdgcn_s_setprio(0); } while (0)
    { bf16x8 kfA[2], kfB[2], kfC[2];
      AT_LOADB(kfA, 0); AT_LOADB(kfB, 1); AT_LOADB(kfC, 2); AT_SBAR();
      AT_MMAB(kfA, 0); AT_SBAR(); AT_LOADB(kfA, 3); AT_SBAR(); AT_MMAB(kfB, 1); AT_SBAR(); AT_LOADB(kfB, 4); AT_SBAR(); AT_MMAB(kfC, 2); AT_SBAR(); AT_LOADB(kfC, 5); AT_SBAR();
      AT_MMAB(kfA, 3); AT_SBAR(); AT_LOADB(kfA, 6); AT_SBAR(); AT_MMAB(kfB, 4); AT_SBAR(); AT_LOADB(kfB, 7); AT_SBAR(); AT_MMAB(kfC, 5); AT_SBAR(); AT_LOADB(kfC, 8); AT_SBAR();
      AT_MMAB(kfA, 6); AT_SBAR(); AT_LOADB(kfA, 9); AT_SBAR(); AT_MMAB(kfB, 7); AT_SBAR(); AT_LOADB(kfB, 10); AT_SBAR(); AT_MMAB(kfC, 8); AT_SBAR(); AT_LOADB(kfC, 11); AT_SBAR();
      AT_MMAB(kfA, 9); AT_SBAR(); AT_MMAB(kfB, 10); AT_SBAR(); AT_MMAB(kfC, 11); AT_SBAR(); }
#undef AT_KA
#undef AT_LOADB
#undef AT_MMAB
    float pmax = p0[0];
#pragma unroll
    for (int r = 1; r < 16; ++r) pmax = fmaxf(pmax, p0[r]);
#pragma unroll
    for (int r = 0; r < 16; ++r) pmax = fmaxf(pmax, p1[r]);
    { auto rr = __builtin_amdgcn_permlane32_swap(__float_as_uint(pmax), __float_as_uint(pmax), false, false); pmax = fmaxf(__uint_as_float(rr[0]), __uint_as_float(rr[1])); }
    float alpha = 1.f;
    if (!__all(pmax - m_run <= THR2)) { const float mn = fmaxf(m_run, pmax); alpha = __builtin_amdgcn_exp2f(m_run - mn); m_run = mn; }
    const float mneg = -m_run;
#pragma unroll
    for (int r = 0; r < 16; ++r) { p0[r] = __builtin_amdgcn_exp2f(p0[r] + mneg); p1[r] = __builtin_amdgcn_exp2f(p1[r] + mneg); }
    float ps = 0.f;
#pragma unroll
    for (int r = 0; r < 16; ++r) ps += p0[r];
#pragma unroll
    for (int r = 0; r < 16; ++r) ps += p1[r];
    { auto rr = __builtin_amdgcn_permlane32_swap(__float_as_uint(ps), __float_as_uint(ps), false, false); ps = __uint_as_float(rr[0]) + __uint_as_float(rr[1]); }
    l_run = l_run * alpha + ps;
    bf16x8 pa0, pa1, pa2, pa3;
#define AT_PK4(P, B_, OUT) do { unsigned a0 = cvt_pk_bf16(P[B_+0], P[B_+1]), a1 = cvt_pk_bf16(P[B_+2], P[B_+3]); \
        unsigned b0 = cvt_pk_bf16(P[B_+4], P[B_+5]), b1 = cvt_pk_bf16(P[B_+6], P[B_+7]); \
        auto r0 = __builtin_amdgcn_permlane32_swap(a0, b0, false, false); auto r1 = __builtin_amdgcn_permlane32_swap(a1, b1, false, false); \
        u32x4 w = {r0[0], r1[0], r0[1], r1[1]}; OUT = *reinterpret_cast<bf16x8*>(&w); } while (0)
    AT_PK4(p0, 0, pa0); AT_PK4(p0, 8, pa1); AT_PK4(p1, 0, pa2); AT_PK4(p1, 8, pa3);
#undef AT_PK4
    if (__any(alpha < 1.f)) { if (hi == 0) al_l[r32] = alpha; asm volatile("s_waitcnt lgkmcnt(0)" ::: "memory");
#pragma unroll
        for (int d_ = 0; d_ < 4; ++d_)
#pragma unroll
            for (int r = 0; r < 16; ++r) o[d_][r] *= al_l[crow(r, hi)]; }
#define AT_TRRD(dst, off) asm volatile("ds_read_b64_tr_b16 %0, %1 offset:%2" : "=&v"(dst) : "v"(vb0), "i"(off) : "memory")
#define AT_PV_D0(d0) do { s16x4 l0, l1, l2, l3, h0, h1, h2, h3; constexpr int b_ = BUF * VTB + v_rd_off(d0, 0, 0); \
        AT_TRRD(l0, b_); AT_TRRD(h0, b_ + 2048); AT_TRRD(l1, b_ + 4096); AT_TRRD(h1, b_ + 6144); AT_TRRD(l2, b_ + 8192); AT_TRRD(h2, b_ + 10240); AT_TRRD(l3, b_ + 12288); AT_TRRD(h3, b_ + 14336); \
        asm volatile("s_waitcnt lgkmcnt(0)" ::: "memory"); AT_SBAR(); \
        o[d0] = __builtin_amdgcn_mfma_f32_32x32x16_bf16(pa0, (bf16x8){l0[0], l0[1], l0[2], l0[3], h0[0], h0[1], h0[2], h0[3]}, o[d0], 0, 0, 0); \
        o[d0] = __builtin_amdgcn_mfma_f32_32x32x16_bf16(pa1, (bf16x8){l1[0], l1[1], l1[2], l1[3], h1[0], h1[1], h1[2], h1[3]}, o[d0], 0, 0, 0); \
        o[d0] = __builtin_amdgcn_mfma_f32_32x32x16_bf16(pa2, (bf16x8){l2[0], l2[1], l2[2], l2[3], h2[0], h2[1], h2[2], h2[3]}, o[d0], 0, 0, 0); \
        o[d0] = __builtin_amdgcn_mfma_f32_32x32x16_bf16(pa3, (bf16x8){l3[0], l3[1], l3[2], l3[3], h3[0], h3[1], h3[2], h3[3]}, o[d0], 0, 0, 0); } while (0)
    AT_PV_D0(0); AT_PV_D0(1); AT_PV_D0(2); AT_PV_D0(3);
#undef AT_PV_D0
#undef AT_TRRD
}

struct AttnArgs { const bf16* QRAW; const float* SSQ; const float* qg; const float* CS; const bf16* KK; const bf16* VV; bf16* O; };

__device__ __forceinline__ void attn_phase(LAS unsigned char* lds, const AttnArgs& A, int G, int bx) {
    int tid_ = threadIdx.x; asm volatile("" : "+v"(tid_));
    const int tid = tid_, wid = __builtin_amdgcn_readfirstlane(tid >> 6), lane = tid & 63, r32 = lane & 31, hi = lane >> 5;
    const int kr_ = wid * 8 + (lane >> 3); const unsigned voffK = (unsigned)(kr_ * 384 + (((lane & 7) ^ ((kr_ >> 1) & 7)) << 4));
    unsigned voffV; { const int ob = (wid * 2 * 64 + lane) * 16, sub = ob >> 9, within = ob & 511, kk = (sub >> 2) * 8 + (within >> 6), cc = (sub & 3) * 32 + ((within & 63) >> 1);
        const int k = (kk & ~0xC) | ((kk & 4) << 1) | ((kk & 8) >> 1); voffV = (unsigned)(k * 256 + cc * 2); }
    const __amdgpu_buffer_rsrc_t rsK = __builtin_amdgcn_make_buffer_rsrc((void*)A.KK, 0, T * NH * DQK * 2, 0x00020000), rsV = __builtin_amdgcn_make_buffer_rsrc((void*)A.VV, 0, T * NH * DV * 2, 0x00020000);
    const int fsw = (r32 >> 1) & 7;
    const LAS char* Kl = (const LAS char*)lds + LDS_K + r32 * 128;
    const LAS char* kb0 = Kl + (((0 + hi) ^ fsw) << 4); const LAS char* kb1 = Kl + (((2 + hi) ^ fsw) << 4); const LAS char* kb2 = Kl + (((4 + hi) ^ fsw) << 4); const LAS char* kb3 = Kl + (((6 + hi) ^ fsw) << 4);
    const int vb0 = LDS_V + v_rd_base(lane);
    LAS float* al_l = (LAS float*)(lds + LDS_AL) + wid * 64; LAS float* li_l = al_l + 32;
    const int vcu = (G % 8 == 0) ? (bx % 8) * (G / 8) + bx / 8 : bx;
#define AT_ISSUE(t, buf) do { const int ks_ = kbase + (t) * KTB, vs_ = vbase + (t) * VTB; \
        _Pragma("unroll") for (int i_ = 0; i_ < 3; ++i_) __builtin_amdgcn_raw_ptr_buffer_load_lds(rsK, (LAS void*)(lds + LDS_K + (buf) * KTB + i_ * 8192 + wid * 1024), 16, voffK, ks_ + i_ * 128, 0, 0); \
        _Pragma("unroll") for (int i_ = 0; i_ < 2; ++i_) __builtin_amdgcn_raw_ptr_buffer_load_lds(rsV, (LAS void*)(lds + LDS_V + (buf) * VTB + (wid * 2 + i_) * 1024), 16, voffV, vs_ + i_ * 128, 0, 0); } while (0)
    for (int item = vcu; item < NB * NH * 16; item += G) {
        const int bh = item >> 4, pr = item & 15, b = bh / NH, h = bh % NH;
        const int kbase = bh * (SEQ * DQK * 2), vbase = bh * (SEQ * DV * 2);
        for (int pass = 0; pass < 2; ++pass) {
            const int qb = pass == 0 ? 31 - pr : pr, NT = 4 * (qb + 1), myNT = 4 * qb + (wid >> 1) + 1;
            AT_ISSUE(0, 0);
            bf16x8 qr[12];
            { const int t = b * SEQ + qb * 256 + wid * 32 + r32; const bf16* qp = A.QRAW + (size_t)t * 1536 + h * DQK + hi * 8;
              const f32x2* sq = (const f32x2*)(A.SSQ + (size_t)t * 48 + h * 6); const f32x2 s0 = sq[0], s1 = sq[1], s2 = sq[2];
              const float rq = fast_rsqrt(((s0[0] + s0[1]) + (s1[0] + s1[1]) + (s2[0] + s2[1])) * (1.0f / DQK) + EPS) * (SM_SCALE * 1.4426950408889634f);
              float xt[4][8];
#pragma unroll
              for (int s = 0; s < 12; ++s) { const bf16x8 raw = *(const bf16x8*)(qp + s * 16); const f32x4 g0 = *(const f32x4*)(A.qg + s * 16 + hi * 8), g1 = *(const f32x4*)(A.qg + s * 16 + hi * 8 + 4);
                  float x[8];
#pragma unroll
                  for (int e = 0; e < 8; ++e) x[e] = __uint_as_float(((unsigned)(unsigned short)raw[e]) << 16) * (e < 4 ? g0[e] : g1[e - 4]) * rq;
                  if (s < 8) { u32x4 w; w.x = cvt_pk_bf16(x[0], x[1]); w.y = cvt_pk_bf16(x[2], x[3]); w.z = cvt_pk_bf16(x[4], x[5]); w.w = cvt_pk_bf16(x[6], x[7]); qr[s] = *reinterpret_cast<bf16x8*>(&w); }
                  else {
#pragma unroll
                      for (int e = 0; e < 8; ++e) xt[s - 8][e] = x[e]; } }
#pragma unroll
              for (int s = 0; s < 2; ++s) { const float* cp = A.CS + (size_t)t * 64 + s * 16 + hi * 8;
                  const f32x4 c0 = *(const f32x4*)cp, c1 = *(const f32x4*)(cp + 4), n0 = *(const f32x4*)(cp + 32), n1 = *(const f32x4*)(cp + 36);
                  float y1[8], y2[8];
#pragma unroll
                  for (int e = 0; e < 8; ++e) { const float c = e < 4 ? c0[e] : c1[e - 4], sn = e < 4 ? n0[e] : n1[e - 4]; const float x1 = xt[s][e], x2 = xt[s + 2][e]; y1[e] = x1 * c - x2 * sn; y2[e] = x1 * sn + x2 * c; }
                  u32x4 w; w.x = cvt_pk_bf16(y1[0], y1[1]); w.y = cvt_pk_bf16(y1[2], y1[3]); w.z = cvt_pk_bf16(y1[4], y1[5]); w.w = cvt_pk_bf16(y1[6], y1[7]); qr[8 + s] = *reinterpret_cast<bf16x8*>(&w);
                  u32x4 w2; w2.x = cvt_pk_bf16(y2[0], y2[1]); w2.y = cvt_pk_bf16(y2[2], y2[3]); w2.z = cvt_pk_bf16(y2[4], y2[5]); w2.w = cvt_pk_bf16(y2[6], y2[7]); qr[10 + s] = *reinterpret_cast<bf16x8*>(&w2); } }
            float m_run = -1e30f, l_run = 0.f; f32x16 o[4] = {};
            for (int t = 0; t < NT; t += 2) {
                asm volatile("s_waitcnt vmcnt(0)" ::: "memory"); __builtin_amdgcn_s_barrier();
                AT_ISSUE(t + 1, 1);
                if (t < myNT) tile_compute<0>(o, qr, m_run, l_run, kb0, kb1, kb2, kb3, vb0, al_l, r32, hi);
                asm volatile("s_waitcnt vmcnt(0)" ::: "memory"); __builtin_amdgcn_s_barrier();
                if (t + 2 < NT) AT_ISSUE(t + 2, 0);
                if (t + 1 < myNT) tile_compute<1>(o, qr, m_run, l_run, kb0, kb1, kb2, kb3, vb0, al_l, r32, hi);
            }
            if (hi == 0) li_l[r32] = l_run; asm volatile("s_waitcnt lgkmcnt(0)" ::: "memory");
            bf16* Ow = A.O + (size_t)(b * SEQ + qb * 256 + wid * 32) * D + h * DV + (size_t)(4 * hi) * D + r32;
            asm volatile("" : "+v"(Ow));
#pragma unroll
            for (int r = 0; r < 16; ++r) { const int orow = crow(r, hi); const float rl = __builtin_amdgcn_rcpf(li_l[orow]);
#pragma unroll
                for (int d0 = 0; d0 < 4; ++d0) { const float v = o[d0][r] * rl; const float vn = __shfl_xor(v, 1);
                    if ((r32 & 1) == 0) *(unsigned*)(Ow + (size_t)((r & 3) + 8 * (r >> 2)) * D + d0 * 32) = cvt_pk_bf16(v, vn); } }
        }
    }
    asm volatile("s_waitcnt vmcnt(0)" ::: "memory"); __builtin_amdgcn_s_barrier();
#undef AT_ISSUE
}
#undef AT_SBAR
}


namespace th {
#define TH_LDS_WAIT() asm volatile("s_waitcnt lgkmcnt(0)" ::: "memory")
__device__ __forceinline__ void tr_item(const float* W, int K, int N, bf16* Wt, int row_off, const float* gain, int half, LAS float* scr, int item, int lane) {
    const int nblk = N / 32, kb = item / nblk, nb = item % nblk, k0 = 64 * kb, n0 = 32 * nb;
    const int kr = lane >> 3, c4 = (lane & 7) * 4;
    f32x4 v[8]; float g[8];
#pragma unroll
    for (int i = 0; i < 8; ++i) { v[i] = __builtin_nontemporal_load((const f32x4*)(W + (size_t)(k0 + 8 * i + kr) * N + n0 + c4)); g[i] = gain ? gain[k0 + 8 * i + kr] : 1.0f; }
#pragma unroll
    for (int i = 0; i < 8; ++i) { LAS float* d = scr + (8 * i + kr) * 33 + c4; d[0] = v[i][0] * g[i]; d[1] = v[i][1] * g[i]; d[2] = v[i][2] * g[i]; d[3] = v[i][3] * g[i]; }
    TH_LDS_WAIT(); asm volatile("" ::: "memory");
    const int c = lane & 7;
#pragma unroll
    for (int j = 0; j < 4; ++j) { const int n = (lane >> 3) + 8 * j; const LAS float* sp = scr + (8 * c) * 33 + n; const int nn = n0 + n, nr = half ? pair_row(nn, half) : nn;
        u32x4 o; o.x = cvt_pk_bf16(sp[0 * 33], sp[1 * 33]); o.y = cvt_pk_bf16(sp[2 * 33], sp[3 * 33]); o.z = cvt_pk_bf16(sp[4 * 33], sp[5 * 33]); o.w = cvt_pk_bf16(sp[6 * 33], sp[7 * 33]);
        *(u32x4*)(Wt + (size_t)(row_off + nr) * K + k0 + 8 * c) = o; }
    TH_LDS_WAIT(); asm volatile("" ::: "memory");
}
struct P0Args { const float* const* in; unsigned char* ws; };
__device__ __forceinline__ void prologue(LAS unsigned char* lds, const float* const (&in)[30], unsigned char* ws, int G, int bx) {
    const int tid = threadIdx.x, lane = tid & 63, wave = __builtin_amdgcn_readfirstlane(tid >> 6);
    LAS float* scr = (LAS float*)(lds + wave * 16384);
    const int gw = bx * NWAVES_ + wave, NGW = G * NWAVES_;
    bf16 *W1t = (bf16*)(ws + WS_W1T), *W2t = (bf16*)(ws + WS_W2T), *Wc = (bf16*)(ws + WS_WC), *Wukv = (bf16*)(ws + WS_WUKV), *Wuq = (bf16*)(ws + WS_WUQ), *Wo = (bf16*)(ws + WS_WO),
         *Wgu = (bf16*)(ws + WS_WGU), *Wd = (bf16*)(ws + WS_WD);
    constexpr int I_W1 = 16 * 64, I_W2 = 16 * 32, I_DKV = 16 * 8, I_KR = 16 * 2, I_DQ = 16 * 12, I_UKV = 4 * 64, I_UQ = 6 * 48, I_WO = 16 * 32, I_GU1 = 16 * 32, I_D1 = 8 * 32;
    constexpr int NIT = I_W1 + I_W2 + I_DKV + I_KR + I_DQ + I_UKV + I_UQ + I_WO + 64 * I_GU1 + 64 * I_D1;
    for (int it = gw; it < NIT; it += NGW) {
        int r = it;
        if (r < 64 * I_GU1) { const int e = r / I_GU1; tr_item(in[28] + (size_t)e * D * 1024, D, 1024, Wgu + (size_t)e * 1024 * D, 0, in[23] + (e / NE) * D, 512, scr, r % I_GU1, lane); continue; } r -= 64 * I_GU1;
        if (r < 64 * I_D1) { const int e = r / I_D1; tr_item(in[29] + (size_t)e * DE * D, DE, D, Wd + (size_t)e * D * DE, 0, nullptr, 0, scr, r % I_D1, lane); continue; } r -= 64 * I_D1;
        if (r < I_W1) { tr_item(in[3], D, 2048, W1t, 0, in[2], 1024, scr, r, lane); continue; } r -= I_W1;
        if (r < I_W2) { tr_item(in[9], D, D, W2t, 0, nullptr, 0, scr, r, lane); continue; } r -= I_W2;
        if (r < I_DKV) { tr_item(in[12], D, KVR, Wc, 0, in[11], 0, scr, r, lane); continue; } r -= I_DKV;
        if (r < I_KR) { tr_item(in[14], D, DROPE, Wc, 256, in[11], 0, scr, r, lane); continue; } r -= I_KR;
        if (r < I_DQ) { tr_item(in[18], D, QLR, Wc, 320, in[17], 0, scr, r, lane); continue; } r -= I_DQ;
        if (r < I_UKV) { tr_item(in[15], KVR, 2048, Wukv, 0, in[13], 0, scr, r, lane); continue; } r -= I_UKV;
        if (r < I_UQ) { tr_item(in[20], QLR, 1536, Wuq, 0, in[19], 0, scr, r, lane); continue; } r -= I_UQ;
        tr_item(in[22], D, D, Wo, 0, nullptr, 0, scr, r, lane);
    }
    const int gt = bx * (NWAVES_ * 64) + tid, NGT = G * NWAVES_ * 64;
    for (int i = gt; i < 64 * D / 8; i += NGT) ((u32x4*)(Wc + (size_t)704 * D))[i] = (u32x4){0u, 0u, 0u, 0u};
    { float* Wr = (float*)(ws + WS_WR);
      for (int i = gt; i < 2 * D * NRT; i += NGT) { const int c = i % NRT, k = (i / NRT) % D, l = i / (NRT * D);
          const float w = c < NG ? in[24][((size_t)l * D + k) * NG + c] : in[26][((size_t)l * D + k) * NE + (c - NG)];
          Wr[(size_t)l * D * NRT + ((((k >> 5) * 4 + ((k >> 3) & 3)) * NRT + c) * 8) + (k & 7)] = w * in[23][l * D + k]; } }
    { float* cs = (float*)(ws + WS_CS); const int* pos = (const int*)in[1];
      for (int i = gt; i < T * 32; i += NGT) { const int t = i >> 5, f = i & 31; const float ang = (float)pos[t] * INV_FREQ[f]; double sn, c; sincos_d((double)ang, sn, c); cs[(size_t)t * 64 + f] = (float)c; cs[(size_t)t * 64 + 32 + f] = (float)sn; } }
    { const float* x = in[0]; bf16* xb = (bf16*)(ws + WS_R1); float* rstd = (float*)(ws + WS_RSTD0);
      for (int row = gw; row < T; row += NGW) { const f32x4* xr = (const f32x4*)(x + (size_t)row * D); float ss = 0.f;
#pragma unroll
          for (int j = 0; j < 4; ++j) { const f32x4 v = xr[lane + 64 * j]; ss += (v[0] * v[0] + v[1] * v[1]) + (v[2] * v[2] + v[3] * v[3]);
              u32x2 o; o.x = cvt_pk_bf16(v[0], v[1]); o.y = cvt_pk_bf16(v[2], v[3]); ((u32x2*)(xb + (size_t)row * D))[lane + 64 * j] = o; }
          ss = wave_sum(ss); if (lane == 0) rstd[row] = fast_rsqrt(ss * (1.0f / D) + EPS); } }
}
__device__ __forceinline__ void conv_ln(LAS unsigned char* lds, const bf16* U, const float* dw_w, const float* dw_b, const float* ln_g, const float* ln_b, bf16* Vb, int G, int bx) {
    const int tid = threadIdx.x, lane = tid & 63, wave = __builtin_amdgcn_readfirstlane(tid >> 6);
    LAS float* tile = (LAS float*)lds;
    const int c0 = tid * 2;
    float w0[CONVW], w1[CONVW];
#pragma unroll
    for (int j = 0; j < CONVW; ++j) { const f32x2 w = *(const f32x2*)(dw_w + j * D + c0); w0[j] = w[0]; w1[j] = w[1]; }
    const f32x2 bb = *(const f32x2*)(dw_b + c0);
    for (int unit = bx; unit < T / 16; unit += G) {
        const int t0 = unit * 16, s0 = t0 & (SEQ - 1);
        float a0[16], a1[16];
#pragma unroll
        for (int r = 0; r < 16; ++r) { a0[r] = bb[0]; a1[r] = bb[1]; }
#pragma unroll
        for (int ib = 0; ib < 46; ib += 8) {
            unsigned uv[8];
#pragma unroll
            for (int k = 0; k < 8; ++k) { const int i = ib + k; uv[k] = (i < 46 && s0 - 30 + i >= 0) ? *(const unsigned*)(U + (size_t)(t0 - 30 + i) * D + c0) : 0u; }
#pragma unroll
            for (int k = 0; k < 8; ++k) { const int i = ib + k; if (i < 46) { const float u0 = __uint_as_float(uv[k] << 16), u1 = __uint_as_float(uv[k] & 0xffff0000u);
#pragma unroll
                for (int r = 0; r < 16; ++r) { const int j = i - r; if (j >= 0 && j < CONVW) { a0[r] = fmaf(w0[j], u0, a0[r]); a1[r] = fmaf(w1[j], u1, a1[r]); } } } }
            asm volatile("" ::: "memory");
        }
#pragma unroll
        for (int r = 0; r < 16; ++r) *(LAS f32x2*)(tile + r * D + c0) = (f32x2){a0[r], a1[r]};
        __syncthreads();
#pragma unroll
        for (int rr = 0; rr < 2; ++rr) { const int r = wave * 2 + rr; const LAS f32x4* xr = (const LAS f32x4*)(tile + r * D); f32x4 v[4]; float sm = 0.f;
#pragma unroll
            for (int j = 0; j < 4; ++j) { v[j] = xr[lane + 64 * j]; sm += (v[j][0] + v[j][1]) + (v[j][2] + v[j][3]); }
            const float mean = wave_sum(sm) * (1.0f / D); float q = 0.f;
#pragma unroll
            for (int j = 0; j < 4; ++j) { v[j] = v[j] - mean; q += (v[j][0] * v[j][0] + v[j][1] * v[j][1]) + (v[j][2] * v[j][2] + v[j][3] * v[j][3]); }
            const float rs = fast_rsqrt(wave_sum(q) * (1.0f / D) + EPS);
#pragma unroll
            for (int j = 0; j < 4; ++j) { const int c = (lane + 64 * j) * 4; const f32x4 gg = *(const f32x4*)(ln_g + c), bv = *(const f32x4*)(ln_b + c); const f32x4 y = v[j] * rs * gg + bv;
                u32x2 o; o.x = cvt_pk_bf16(y[0] * fast_sigmoid(y[0]), y[1] * fast_sigmoid(y[1])); o.y = cvt_pk_bf16(y[2] * fast_sigmoid(y[2]), y[3] * fast_sigmoid(y[3]));
                ((u32x2*)(Vb + (size_t)(t0 + r) * D))[lane + 64 * j] = o; } }
        __syncthreads();
    }
}
__device__ __forceinline__ void route(LAS unsigned char* lds, const float* H, const float* WrP, const float* bg, const float* br, bf16* XT, int4* LIST, int* CNT, float* GATE, int G, int bx) {
    int tid_ = threadIdx.x; asm volatile("" : "+v"(tid_));
    const int tid = tid_, lane = tid & 63, wave = __builtin_amdgcn_readfirstlane(tid >> 6), r16 = lane & 15, kq = lane >> 4;
    LAS float* Bs = (LAS float*)lds; LAS float* LG = (LAS float*)(lds + 73728) + wave * (16 * 37);
    constexpr int NTILES = T / 16; const int NW = G * NWAVES_;
    LAS int* lcnt = (LAS int*)(lds + 73728 + 8 * 16 * 37 * 4); LAS int* gbase = lcnt + NE;
    if (tid < NE) lcnt[tid] = 0;
    int e0 = 0, e1 = 0, sl0 = 0, sl1 = 0; float rsv = 0.f, gt0 = 0.f, gt1 = 0.f;
    for (int base = 0; base < NTILES; base += NW) {
        const int tile = base + bx * NWAVES_ + wave; const bool act = tile < NTILES; const int t0 = tile * 16;
        f32x4 c0 = {0.f, 0.f, 0.f, 0.f}, c1 = c0, c2 = c0; float ss = 0.f;
#pragma unroll 1
        for (int half = 0; half < 2; ++half) {
            __syncthreads();
#pragma unroll
            for (int i = 0; i < 9; ++i) ((LAS f32x4*)Bs)[tid + 512 * i] = ((const f32x4*)(WrP + half * 18432))[tid + 512 * i];
            __syncthreads();
            if (act) {
                const float* hp = H + (size_t)(t0 + r16) * D + half * 512 + 8 * kq; bf16* xp = XT + (size_t)(t0 + r16) * D + half * 512 + 8 * kq;
#pragma unroll 4
                for (int jj = 0; jj < 16; ++jj) {
                    const f32x4 a0 = *(const f32x4*)(hp + 32 * jj), a1 = *(const f32x4*)(hp + 32 * jj + 4);
                    ss += ((a0[0] * a0[0] + a0[1] * a0[1]) + (a0[2] * a0[2] + a0[3] * a0[3])) + ((a1[0] * a1[0] + a1[1] * a1[1]) + (a1[2] * a1[2] + a1[3] * a1[3]));
                    u32x4 w; w.x = cvt_pk_bf16(a0[0], a0[1]); w.y = cvt_pk_bf16(a0[2], a0[3]); w.z = cvt_pk_bf16(a1[0], a1[1]); w.w = cvt_pk_bf16(a1[2], a1[3]); *(u32x4*)(xp + 32 * jj) = w;
                    const LAS float* bp = Bs + ((jj * 4 + kq) * NRT + r16) * 8;
                    const f32x4 b00 = *(const LAS f32x4*)bp, b01 = *(const LAS f32x4*)(bp + 4), b10 = *(const LAS f32x4*)(bp + 128), b11 = *(const LAS f32x4*)(bp + 132), b20 = *(const LAS f32x4*)(bp + 256), b21 = *(const LAS f32x4*)(bp + 260);
#pragma unroll
                    for (int i = 0; i < 4; ++i) { c0 = __builtin_amdgcn_mfma_f32_16x16x4f32(a0[i], b00[i], c0, 0, 0, 0); c1 = __builtin_amdgcn_mfma_f32_16x16x4f32(a0[i], b10[i], c1, 0, 0, 0); c2 = __builtin_amdgcn_mfma_f32_16x16x4f32(a0[i], b20[i], c2, 0, 0, 0); }
#pragma unroll
                    for (int i = 0; i < 4; ++i) { c0 = __builtin_amdgcn_mfma_f32_16x16x4f32(a1[i], b01[i], c0, 0, 0, 0); c1 = __builtin_amdgcn_mfma_f32_16x16x4f32(a1[i], b11[i], c1, 0, 0, 0); c2 = __builtin_amdgcn_mfma_f32_16x16x4f32(a1[i], b21[i], c2, 0, 0, 0); }
                }
            }
        }
        if (act) {
            ss += __shfl_xor(ss, 16); ss += __shfl_xor(ss, 32);
#pragma unroll
            for (int rg = 0; rg < 4; ++rg) { LG[(4 * kq + rg) * 37 + r16] = c0[rg]; LG[(4 * kq + rg) * 37 + 16 + r16] = c1[rg]; if (r16 < 4) LG[(4 * kq + rg) * 37 + 32 + r16] = c2[rg]; }
            asm volatile("s_waitcnt lgkmcnt(0)" ::: "memory");
            if (lane < 16) {
                const int t = t0 + lane; const LAS float* lr = LG + lane * 37;
                const float rs = fast_rsqrt(ss * (1.0f / D) + EPS);
                float lg[NG]; int gi = 0; float gm = -3.0e38f;
#pragma unroll
                for (int c = 0; c < NG; ++c) { lg[c] = lr[c] * rs + bg[c]; if (lg[c] > gm) { gm = lg[c]; gi = c; } }
                float gs = 0.f;
#pragma unroll
                for (int c = 0; c < NG; ++c) gs += __expf(lg[c] - gm);
                const float gw = 1.0f / gs;
                float le[EPG]; float em = -3.0e38f;
#pragma unroll
                for (int c = 0; c < EPG; ++c) { le[c] = lr[NG + gi * EPG + c] * rs + br[gi * EPG + c]; em = fmaxf(em, le[c]); }
                int i0 = 0; float v0 = -3.0e38f;
#pragma unroll
                for (int c = 0; c < EPG; ++c) if (le[c] > v0) { v0 = le[c]; i0 = c; }
                int i1 = 0; float v1 = -3.0e38f;
#pragma unroll
                for (int c = 0; c < EPG; ++c) if (c != i0 && le[c] > v1) { v1 = le[c]; i1 = c; }
                const float p0 = __expf(v0 - em), p1 = __expf(v1 - em); const float inv = 1.0f / (p0 + p1);
                e0 = gi * EPG + i0; e1 = gi * EPG + i1; rsv = rs; gt0 = gw * p0 * inv; gt1 = gw * p1 * inv;
                GATE[2 * t] = gt0; GATE[2 * t + 1] = gt1;
                sl0 = __hip_atomic_fetch_add(lcnt + e0, 1, __ATOMIC_RELAXED, __HIP_MEMORY_SCOPE_WORKGROUP);
                sl1 = __hip_atomic_fetch_add(lcnt + e1, 1, __ATOMIC_RELAXED, __HIP_MEMORY_SCOPE_WORKGROUP);
            }
        }
        __syncthreads();
        if (tid < NE) { const int n = lcnt[tid]; gbase[tid] = n > 0 ? atomicAdd(CNT + tid * 64, n) : 0; }
        __syncthreads();
        if (act && lane < 16) { const int t = t0 + lane;
            LIST[(size_t)e0 * T + gbase[e0] + sl0] = make_int4(2 * t, __float_as_int(rsv), __float_as_int(gt0), 0);
            LIST[(size_t)e1 * T + gbase[e1] + sl1] = make_int4(2 * t + 1, __float_as_int(rsv), __float_as_int(gt1), 0); }
        __syncthreads();
        if (tid < NE) lcnt[tid] = 0;
    }
    __syncthreads();
}
__device__ __forceinline__ void combine(float* H, const bf16* YS, const int* POS, const float* GATE, bf16* HB, float* RSTD2, int G, int bx) {
    const int tid = threadIdx.x, lane = tid & 63, wave = __builtin_amdgcn_readfirstlane(tid >> 6);
    for (int t = bx * NWAVES_ + wave; t < T; t += G * NWAVES_) {
        const int p0 = POS[2 * t], p1 = POS[2 * t + 1]; const float g0 = GATE[2 * t], g1 = GATE[2 * t + 1];
        f32x4* hr = (f32x4*)(H + (size_t)t * D); const u32x2* y0 = (const u32x2*)(YS + (size_t)p0 * D); const u32x2* y1 = (const u32x2*)(YS + (size_t)p1 * D);
        float ss = 0.f;
#pragma unroll
        for (int j = 0; j < 4; ++j) { f32x4 v = hr[lane + 64 * j]; const u32x2 p = y0[lane + 64 * j], q = y1[lane + 64 * j];
            v[0] += g0 * __uint_as_float(p.x << 16) + g1 * __uint_as_float(q.x << 16); v[1] += g0 * __uint_as_float(p.x & 0xffff0000u) + g1 * __uint_as_float(q.x & 0xffff0000u);
            v[2] += g0 * __uint_as_float(p.y << 16) + g1 * __uint_as_float(q.y << 16); v[3] += g0 * __uint_as_float(p.y & 0xffff0000u) + g1 * __uint_as_float(q.y & 0xffff0000u);
            hr[lane + 64 * j] = v; ss += (v[0] * v[0] + v[1] * v[1]) + (v[2] * v[2] + v[3] * v[3]);
            if (HB) { u32x2 o; o.x = cvt_pk_bf16(v[0], v[1]); o.y = cvt_pk_bf16(v[2], v[3]); ((u32x2*)(HB + (size_t)t * D))[lane + 64 * j] = o; } }
        if (RSTD2) { ss = wave_sum(ss); if (lane == 0) RSTD2[t] = fast_rsqrt(ss * (1.0f / D) + EPS); }
    }
}
__device__ __forceinline__ void kfin(const bf16* KN, const bf16* CL, const float* SSK, const float* SSP, const float* kg, const float* cs, bf16* KK, int G, int bx) {
    const int tid = threadIdx.x, lane = tid & 63, wave = __builtin_amdgcn_readfirstlane(tid >> 6), h = lane >> 3, part = lane & 7;
    for (int t = bx * NWAVES_ + wave; t < T; t += G * NWAVES_) {
        const int b = t / SEQ, sq = t % SEQ;
        const f32x4 sk = *(const f32x4*)(SSK + t * 32 + h * 4); const f32x2 sr = *(const f32x2*)(SSP + t * 32 + 8);
        const float rk = fast_rsqrt((((sk[0] + sk[1]) + (sk[2] + sk[3])) + (sr[0] + sr[1])) * (1.0f / DQK) + EPS);
        bf16* o = KK + (((size_t)b * NH + h) * SEQ + sq) * DQK;
        { const bf16x8 r0 = *(const bf16x8*)(KN + (size_t)t * D + h * 128 + part * 16), r1 = *(const bf16x8*)(KN + (size_t)t * D + h * 128 + part * 16 + 8);
          const float* g = kg + part * 16; float y[16];
#pragma unroll
          for (int e = 0; e < 8; ++e) { y[e] = __uint_as_float(((unsigned)(unsigned short)r0[e]) << 16) * rk * g[e]; y[8 + e] = __uint_as_float(((unsigned)(unsigned short)r1[e]) << 16) * rk * g[8 + e]; }
          u32x4 w0, w1; w0.x = cvt_pk_bf16(y[0], y[1]); w0.y = cvt_pk_bf16(y[2], y[3]); w0.z = cvt_pk_bf16(y[4], y[5]); w0.w = cvt_pk_bf16(y[6], y[7]);
          w1.x = cvt_pk_bf16(y[8], y[9]); w1.y = cvt_pk_bf16(y[10], y[11]); w1.z = cvt_pk_bf16(y[12], y[13]); w1.w = cvt_pk_bf16(y[14], y[15]);
          *(u32x4*)(o + part * 16) = w0; *(u32x4*)(o + part * 16 + 8) = w1; }
        { const int j0 = part * 4;
          const u32x2 a = *(const u32x2*)(CL + (size_t)t * NCL + 256 + j0), bq = *(const u32x2*)(CL + (size_t)t * NCL + 288 + j0);
          const f32x4 c = *(const f32x4*)(cs + (size_t)t * 64 + j0), sn = *(const f32x4*)(cs + (size_t)t * 64 + 32 + j0), g1 = *(const f32x4*)(kg + 128 + j0), g2 = *(const f32x4*)(kg + 160 + j0);
          const float x1[4] = {__uint_as_float(a.x << 16), __uint_as_float(a.x & 0xffff0000u), __uint_as_float(a.y << 16), __uint_as_float(a.y & 0xffff0000u)};
          const float x2[4] = {__uint_as_float(bq.x << 16), __uint_as_float(bq.x & 0xffff0000u), __uint_as_float(bq.y << 16), __uint_as_float(bq.y & 0xffff0000u)};
          float y1[4], y2[4];
#pragma unroll
          for (int e = 0; e < 4; ++e) { const float p = x1[e] * rk * g1[e], q = x2[e] * rk * g2[e]; y1[e] = p * c[e] - q * sn[e]; y2[e] = p * sn[e] + q * c[e]; }
          u32x2 w1, w2; w1.x = cvt_pk_bf16(y1[0], y1[1]); w1.y = cvt_pk_bf16(y1[2], y1[3]); w2.x = cvt_pk_bf16(y2[0], y2[1]); w2.y = cvt_pk_bf16(y2[2], y2[3]);
          *(u32x2*)(o + 128 + j0) = w1; *(u32x2*)(o + 160 + j0) = w2; }
    }
}
#undef TH_LDS_WAIT
}

#define XB_TMO      128
#define XB_XCNT(j)  (256  + 64 * (j))
#define XB_XSUB(j)  (1280 + 64 * (j))
#define XB_XGEN(j)  (2304 + 64 * (j))
#define XB_TOP      3328
#define XB_TOPGEN   3392
#define XCD_BAR_WORDS 3456
#define XB_SPIN_CAP (1u << 18)
__device__ __forceinline__ unsigned xb_ld(unsigned* p)              { return __hip_atomic_load(p, __ATOMIC_RELAXED, __HIP_MEMORY_SCOPE_AGENT); }
__device__ __forceinline__ unsigned xb_add(unsigned* p, unsigned v) { return __hip_atomic_fetch_add(p, v, __ATOMIC_RELAXED, __HIP_MEMORY_SCOPE_AGENT); }
__device__ __forceinline__ unsigned xb_xcc_id() { return (unsigned)__builtin_amdgcn_s_getreg((3 << 11) | 20) & 0xFu; }
#define XB_SPIN(cond, bar) do { unsigned _sp = 0; while (cond) { __builtin_amdgcn_s_sleep(1); \
    if ((++_sp & 255u) == 0u) { if (xb_ld(&(bar)[XB_TMO])) break; if (_sp > XB_SPIN_CAP) { atomicAdd(&(bar)[XB_TMO], 1u); break; } } } } while (0)
struct XcdBarrier { unsigned* bar; unsigned x; volatile LAS unsigned* st; };
__device__ __forceinline__ XcdBarrier xcd_barrier_post(unsigned* bar, volatile LAS unsigned* st) {
    XcdBarrier b; b.bar = bar; b.x = xb_xcc_id(); b.st = st;
    if (threadIdx.x == 0) (void)xb_add(&bar[XB_XCNT(b.x)], 1u);
    return b;
}
__device__ __forceinline__ void xcd_barrier_complete(unsigned* bar, unsigned x, unsigned& nloc, unsigned& nx) {
    const unsigned G = gridDim.x * gridDim.y * gridDim.z;
    unsigned sum, cnt, mine, sp = 0u;
    for (;;) {
        sum = 0u; cnt = 0u; mine = 0u;
#pragma unroll
        for (unsigned j = 0; j < 16; ++j) { const unsigned c = xb_ld(&bar[XB_XCNT(j)]); sum += c; cnt += (c > 0u) ? 1u : 0u; mine = (j == x) ? c : mine; }
        if (sum == G) break;
        __builtin_amdgcn_s_sleep(1);
        if ((++sp & 255u) == 0u) { if (xb_ld(&bar[XB_TMO])) break; if (sp > XB_SPIN_CAP) { atomicAdd(&bar[XB_TMO], 1u); break; } }
    }
    nloc = mine > 0u ? mine : 1u; nx = cnt > 0u ? cnt : 1u;
}
__device__ __forceinline__ void xcd_barrier(const XcdBarrier& b) {
    asm volatile("s_waitcnt vmcnt(0)" ::: "memory");
    __syncthreads();
    if (threadIdx.x == 0) {
        unsigned* bar = b.bar;
        __builtin_amdgcn_s_waitcnt(0);
        unsigned nloc = b.st[0], nx = b.st[1];
        if (nloc == 0u) { xcd_barrier_complete(bar, b.x, nloc, nx); b.st[0] = nloc; b.st[1] = nx; }
        const unsigned old = xb_add(&bar[XB_XSUB(b.x)], 1u);
        const unsigned gen = old / nloc;
        if (old + 1u == (gen + 1u) * nloc) {
            __builtin_amdgcn_fence(__ATOMIC_RELEASE, "agent");
            asm volatile("s_waitcnt vmcnt(0)" ::: "memory");
            const unsigned og = xb_add(&bar[XB_TOP], 1u);
            const unsigned tg = og / nx;
            if (og + 1u == (tg + 1u) * nx) xb_add(&bar[XB_TOPGEN], 1u);
            else XB_SPIN(xb_ld(&bar[XB_TOPGEN]) == tg, bar);
            __builtin_amdgcn_fence(__ATOMIC_ACQUIRE, "agent");
            xb_add(&bar[XB_XGEN(b.x)], 1u);
            asm volatile("s_waitcnt vmcnt(0)" ::: "memory");
        } else {
            XB_SPIN(xb_ld(&bar[XB_XGEN(b.x)]) == gen, bar);
            __builtin_amdgcn_fence(__ATOMIC_ACQUIRE, "agent");
            asm volatile("s_waitcnt vmcnt(0)" ::: "memory");
        }
    }
    __syncthreads();
}

constexpr int NWAVES = 8, LDS_BYTES = 160 * 1024, LDS_MISC = 159 * 1024;
constexpr int CW_BAR = 4096;
constexpr int NPHASE = 17;
constexpr int REP0 = 1, REP1 = 1, REP2 = 1, REP3 = 1, REP5 = 1, REP6 = 1, REP8 = 1, REP9 = 1, REP10 = 1, REP11 = 1, REP14 = 1, REP15 = 1;
struct Args { const float* in[30]; float* out; unsigned char* ws; int ph_lo, ph_hi; };

__global__ void __launch_bounds__(NWAVES * 64, 2) fwd(Args a) {
    extern __shared__ __attribute__((aligned(16))) unsigned char lds_raw[];
    LAS unsigned char* lds = (LAS unsigned char*)lds_raw;
    volatile LAS unsigned* MISC = (volatile LAS unsigned*)(lds + LDS_MISC);
    const int tid = threadIdx.x;
    if (tid < 64) MISC[tid] = 0u;
    __syncthreads();
    unsigned char* ws = a.ws; float* H = a.out;
    XcdBarrier bar = xcd_barrier_post((unsigned*)(ws + WS_CTL) + CW_BAR, MISC + 8);
    const int lo = a.ph_lo, hi = a.ph_hi, G = gridDim.x, bx = blockIdx.x;
    const int vcu = (G % 8 == 0) ? (bx % 8) * (G / 8) + bx / 8 : bx;
#define IN(k) (lo <= (k) && (k) < hi)
#define SEAM(k) do { if (IN(k) && IN((k) + 1)) xcd_barrier(bar); } while (0)
    const float* x = a.in[0];
    bf16 *W1t = (bf16*)(ws + WS_W1T), *W2t = (bf16*)(ws + WS_W2T), *Wc = (bf16*)(ws + WS_WC), *Wukv = (bf16*)(ws + WS_WUKV), *Wuq = (bf16*)(ws + WS_WUQ), *Wo = (bf16*)(ws + WS_WO);
    float *RSTD0 = (float*)(ws + WS_RSTD0), *RSTD2 = (float*)(ws + WS_RSTD2), *SSP = (float*)(ws + WS_SSP), *SSQ = (float*)(ws + WS_SSQ), *SSK = (float*)(ws + WS_SSK);
    bf16 *XB = (bf16*)(ws + WS_R1), *HB = XB, *U = (bf16*)(ws + WS_R2), *O = U, *Vb = (bf16*)(ws + WS_R3), *KN = Vb, *VV = (bf16*)(ws + WS_R3 + 64 * MiB),
         *CL = (bf16*)(ws + WS_CL), *QRAW = (bf16*)(ws + WS_QRAW);

    if (IN(0)) for (int rep_ = 0; rep_ < REP0; ++rep_) th::prologue(lds, a.in, ws, G, bx);
    SEAM(0);
    if (IN(1)) for (int rep_ = 0; rep_ < REP1; ++rep_) { fg::DenseP<fg::EpiGlu> p{(const char*)XB, D, (const char*)W1t, D, {}, {RSTD0, a.in[4], U}}; p.S.init(T, 2048, G, bx); fg::gemm_phase(lds, p); }
    SEAM(1);
    if (IN(2)) for (int rep_ = 0; rep_ < REP2; ++rep_) th::conv_ln(lds, U, a.in[5], a.in[6], a.in[7], a.in[8], Vb, G, bx);
    SEAM(2);
    if (IN(3)) for (int rep_ = 0; rep_ < REP3; ++rep_) { fg::DenseP<fg::EpiRes> p{(const char*)Vb, D, (const char*)W2t, D, {}, {x, a.in[10], H}}; p.S.init(T, D, G, bx); fg::gemm_phase(lds, p); }
    SEAM(3);
    LAS int* pref = (LAS int*)(lds + LDS_MISC + 256); LAS int* cnts = (LAS int*)(lds + LDS_MISC + 512);
    int4* LIST = (int4*)(ws + WS_LISTR); int* POS = (int*)(ws + WS_LIST); float* GATE = (float*)(ws + WS_GATE); bf16* ACTS = (bf16*)(ws + WS_ACTS); bf16* YS = (bf16*)(ws + WS_YS);
    bf16* XT = XB; bf16* ACT = U; bf16* Y = Vb; const bf16* Wgu = (const bf16*)(ws + WS_WGU); const bf16* Wd = (const bf16*)(ws + WS_WD);
#define MOE_GEMMS(l, p1, p2) do { \
        if (IN(p1)) for (int rep_ = 0; rep_ < ((l) ? REP14 : REP5); ++rep_) { fg::moe_setup((const int*)(ws + WS_CTL) + (l) * NE * 64, pref, cnts); \
            fg::MoeP<fg::EpiSwiglu, true> p{(const char*)XT, D, 1, (const char*)(Wgu + (size_t)(l) * NE * 1024 * D), (size_t)1024 * D * 2, D, LIST, pref, cnts, G, vcu, 4 * __builtin_amdgcn_readfirstlane(pref[32]), {ACTS, POS}}; \
            fg::gemm_phase(lds, p); } \
        SEAM(p1); \
        if (IN(p2)) for (int rep_ = 0; rep_ < ((l) ? REP15 : REP6); ++rep_) { fg::moe_setup((const int*)(ws + WS_CTL) + (l) * NE * 64, pref, cnts); \
            fg::MoeP<fg::EpiDown, false> p{(const char*)ACTS, DE, 0, (const char*)(Wd + (size_t)(l) * NE * D * DE), (size_t)D * DE * 2, DE, LIST, pref, cnts, G, vcu, 4 * __builtin_amdgcn_readfirstlane(pref[32]), {YS}}; \
            fg::gemm_phase(lds, p); } \
        SEAM(p2); } while (0)
    float* Wr = (float*)(ws + WS_WR); int* CNT = (int*)(ws + WS_CTL);
    if (IN(4)) th::route(lds, H, Wr, a.in[25], a.in[27], XT, LIST, CNT, GATE, G, bx);
    SEAM(4);
    MOE_GEMMS(0, 5, 6);
    if (IN(7)) th::combine(H, YS, POS, GATE, HB, RSTD2, G, bx);
    SEAM(7);
    if (IN(8)) for (int rep_ = 0; rep_ < REP8; ++rep_) { fg::DenseP<fg::EpiCL> p{(const char*)HB, D, (const char*)Wc, D, {}, {RSTD2, CL, SSP}}; p.S.init(T, NCL, G, bx); fg::gemm_phase(lds, p); }
    SEAM(8);
    if (IN(9)) for (int rep_ = 0; rep_ < REP9; ++rep_) {
        { fg::DenseP<fg::EpiQ> p{(const char*)(CL + 320), NCL, (const char*)Wuq, QLR, {}, {SSP, QRAW, SSQ}}; p.S.init(T, 1536, G, bx); fg::gemm_phase(lds, p); }
        { fg::DenseP<fg::EpiKV> p{(const char*)CL, NCL, (const char*)Wukv, KVR, {}, {SSP, KN, VV, SSK}}; p.S.init(T, 2048, G, bx); fg::gemm_phase(lds, p); }
    }
    SEAM(9);
    if (IN(10)) for (int rep_ = 0; rep_ < REP10; ++rep_) th::kfin(KN, CL, SSK, SSP, a.in[16], (const float*)(ws + WS_CS), (bf16*)(ws + WS_KK), G, bx);
    SEAM(10);
    if (IN(11)) for (int rep_ = 0; rep_ < REP11; ++rep_) { const at::AttnArgs aa{QRAW, SSQ, a.in[21], (const float*)(ws + WS_CS), (const bf16*)(ws + WS_KK), VV, O}; at::attn_phase(lds, aa, G, bx); }
    SEAM(11);
    if (IN(12)) { fg::DenseP<fg::EpiRes> p{(const char*)O, D, (const char*)Wo, D, {}, {H, nullptr, H}}; p.S.init(T, D, G, bx); fg::gemm_phase(lds, p); }
    SEAM(12);
    if (IN(13)) th::route(lds, H, Wr + (size_t)D * NRT, a.in[25] + NG, a.in[27] + NE, XT, LIST, CNT + NE * 64, GATE, G, bx);
    SEAM(13);
    MOE_GEMMS(1, 14, 15);
    if (IN(16)) th::combine(H, YS, POS, GATE, nullptr, nullptr, G, bx);
#undef MOE_GEMMS
#undef IN
#undef SEAM
}

extern "C" void kernel_launch(void* const* d_in, const int* in_sizes, int n_in, void* d_out, int out_size, void* d_ws, size_t ws_size, hipStream_t stream) {
    if (n_in != 30 || ws_size < WS_END || out_size != T * D) { fprintf(stderr, "kernel_launch: unexpected shapes (n_in %d, ws %zu, out %d)\n", n_in, ws_size, out_size); return; }
    static int grid = 0;
    if (!grid) {
        (void)hipFuncSetAttribute((const void*)fwd, hipFuncAttributeMaxDynamicSharedMemorySize, LDS_BYTES);
        int dev = 0, cus = 0; (void)hipGetDevice(&dev); if (hipDeviceGetAttribute(&cus, hipDeviceAttributeMultiprocessorCount, dev) != hipSuccess || cus <= 0) cus = 256;
        grid = cus;
    }
    char* ws = (char*)d_ws;
    Args a{}; for (int i = 0; i < 30; ++i) a.in[i] = (const float*)d_in[i]; a.out = (float*)d_out; a.ws = (unsigned char*)d_ws;
    (void)hipMemsetAsync(ws + WS_CTL, 0, 1 * MiB, stream);
    a.ph_lo = 0; a.ph_hi = NPHASE;
    hipLaunchKernelGGL(fwd, dim3(grid), dim3(NWAVES * 64), LDS_BYTES, stream, a);
}
```

```cpp
#include <hip/hip_runtime.h>
#include <stdint.h>
#include <stdio.h>

typedef unsigned short bf16;
constexpr int NB = 4, SEQ = 8192, T = NB * SEQ, D = 1024, NH = 8, DQK = 192, DNOPE = 128, DROPE = 64, DV = 128, KVR = 256, QLR = 384;
constexpr int NE = 32, NG = 4, EPG = 8, DE = 512, CONVW = 31, NCL = 768, NRT = 36;
constexpr float EPS = 1e-6f;
constexpr float SM_SCALE = 0.07216878364870322f;

constexpr size_t MiB = 1u << 20;
constexpr size_t WS_CTL = 0, WS_W1T = 1 * MiB, WS_W2T = 5 * MiB, WS_WC = 7 * MiB, WS_WUKV = 9 * MiB, WS_WUQ = 10 * MiB, WS_WO = 12 * MiB, WS_WR = 14 * MiB,
                 WS_WGU = 16 * MiB, WS_WD = 144 * MiB, WS_RSTD0 = 208 * MiB, WS_RSTD = WS_RSTD0 + 256 * 1024, WS_RSTD2 = WS_RSTD0 + 512 * 1024,
                 WS_GATE = 209 * MiB, WS_LIST = 210 * MiB, WS_CS = 214 * MiB, WS_SSP = 222 * MiB, WS_SSQ = 226 * MiB, WS_SSK = 232 * MiB,
                 WS_R1 = 236 * MiB, WS_R2 = 300 * MiB, WS_R3 = 364 * MiB, WS_CL = 492 * MiB, WS_QRAW = 540 * MiB, WS_KK = 636 * MiB, WS_LISTR = 732 * MiB  , WS_ACTS = 748 * MiB  , WS_YS = 828 * MiB  ,  WS_END = 988 * MiB;

__device__ const float INV_FREQ[32] = {
    1.0f, 0.7498942093324559f, 0.5623413251903491f, 0.4216965034285822f, 0.31622776601683794f, 0.23713737056616552f, 0.1778279410038923f, 0.1333521432163324f,
    0.1f, 0.07498942093324558f, 0.05623413251903491f, 0.04216965034285822f, 0.03162277660168379f, 0.023713737056616554f, 0.01778279410038923f, 0.01333521432163324f,
    0.01f, 0.007498942093324558f, 0.005623413251903491f, 0.004216965034285823f, 0.0031622776601683794f, 0.0023713737056616554f, 0.001778279410038923f, 0.001333521432163324f,
    0.001f, 0.0007498942093324559f, 0.0005623413251903491f, 0.00042169650342858224f, 0.00031622776601683794f, 0.00023713737056616554f, 0.0001778279410038923f, 0.0001333521432163324f};

__device__ __forceinline__ float bf2f(bf16 b) { return __uint_as_float(((unsigned)b) << 16); }
__device__ __forceinline__ bf16 f2bf(float f) { unsigned u = __float_as_uint(f); u += 0x7fffu + ((u >> 16) & 1u); return (bf16)(u >> 16); }
__device__ __forceinline__ float wave_sum(float v) {
#pragma unroll
    for (int o = 1; o < 64; o <<= 1) v += __shfl_xor(v, o);
    return v;
}
__device__ __forceinline__ float sigmoidf_(float x) { return 1.0f / (1.0f + __expf(-x)); }
__device__ __forceinline__ float siluf_(float x) { return x / (1.0f + __expf(-x)); }
__host__ __device__ __forceinline__ int pair_row(int n, int half) { const int j = n % half, hf = n / half; return 256 * (j / 128) + 128 * hf + (j % 128); }

__device__ __forceinline__ void sincos_d(double a, double& s, double& c) {
    const double TWO_PI = 6.283185307179586476925287, PI = 3.14159265358979323846;
    double k = __builtin_rint(a / TWO_PI); double r = a - k * TWO_PI;
    double q = __builtin_rint(r / (PI * 0.5)); double y = r - q * (PI * 0.5); int qi = ((int)q) & 3;
    const double y2 = y * y;
    double sp = y * (1.0 + y2 * (-1.0 / 6 + y2 * (1.0 / 120 + y2 * (-1.0 / 5040 + y2 * (1.0 / 362880 + y2 * (-1.0 / 39916800 + y2 * (1.0 / 6227020800.0)))))));
    double cp = 1.0 + y2 * (-0.5 + y2 * (1.0 / 24 + y2 * (-1.0 / 720 + y2 * (1.0 / 40320 + y2 * (-1.0 / 3628800 + y2 * (1.0 / 479001600.0 + y2 * (-1.0 / 87178291200.0)))))));
    if (qi == 0) { s = sp; c = cp; } else if (qi == 1) { s = cp; c = -sp; } else if (qi == 2) { s = -sp; c = -cp; } else { s = -cp; c = sp; }
}

constexpr int NWAVES_ = 8;
#define LAS __attribute__((address_space(3)))
#define GAS __attribute__((address_space(1)))
typedef short bf16x8 __attribute__((ext_vector_type(8)));
typedef float f32x4 __attribute__((ext_vector_type(4)));
typedef float f32x2 __attribute__((ext_vector_type(2)));
typedef unsigned u32x4 __attribute__((ext_vector_type(4)));
typedef unsigned u32x2 __attribute__((ext_vector_type(2)));

__device__ __forceinline__ unsigned cvt_pk_bf16(float lo, float hi) { unsigned r; asm volatile("v_cvt_pk_bf16_f32 %0, %1, %2" : "=v"(r) : "v"(lo), "v"(hi)); return r; }
__device__ __forceinline__ float fast_sigmoid(float x) { return __builtin_amdgcn_rcpf(1.0f + __builtin_amdgcn_exp2f(-1.4426950408889634f * x)); }
__device__ __forceinline__ float fast_rsqrt(float x) { return 1.0f / sqrtf(x); }
__device__ __forceinline__ u32x2 pack_fp8x8(const float (&y)[8]) { int w0 = 0, w1 = 0; w0 = __builtin_amdgcn_cvt_pk_fp8_f32(y[0], y[1], w0, false); w0 = __builtin_amdgcn_cvt_pk_fp8_f32(y[2], y[3], w0, true);
    w1 = __builtin_amdgcn_cvt_pk_fp8_f32(y[4], y[5], w1, false); w1 = __builtin_amdgcn_cvt_pk_fp8_f32(y[6], y[7], w1, true); u32x2 r; r.x = (unsigned)w0; r.y = (unsigned)w1; return r; }

namespace fg {
constexpr int BM = 256, BK = 64, HALF = 128, HTB = HALF * BK * 2, STAGE_BYTES = 8 * HTB, NXCD = 8, WGM = 8;
__host__ __device__ __forceinline__ int lds_byte(int r, int c) { const int st = (r >> 4) * 2 + (c >> 5), rr = r & 15, cc = c & 31, ob = rr * 64 + cc * 2; return st * 1024 + (ob ^ (((ob >> 9) & 1) << 5)); }
__host__ __device__ __forceinline__ void stage_rc(int b, int& R, int& C) { const int st = b / 1024, sb = b % 1024, swz = sb ^ (((sb >> 9) & 1) << 5); R = (st >> 1) * 16 + swz / 64; C = (st & 1) * 32 + (swz % 64) / 2; }
__host__ __device__ __forceinline__ int perm32(int rho) { const int n = rho >> 4, i = rho & 15; return 8 * (i >> 2) + 4 * n + (i & 3); }
struct Unit { int pm, pn, e, nvalid, r; };
typedef f32x4 Acc[2][2][4][2];

struct StaticOrder {
    int nM, nN, nwg, G, c;
    __device__ void init(int M, int N, int G_, int c_) { nM = M / BM; nN = N / BM; nwg = nM * nN; G = G_; c = c_; }
    __device__ bool next(int i, Unit& u) const {
        const long L = (long)i * G + c; if (L >= nwg) return false;
        int wgid = (int)L; { const int q = nwg / NXCD, r = nwg % NXCD, xcd = wgid % NXCD, off = wgid / NXCD; wgid = (xcd < r ? xcd * (q + 1) : r * (q + 1) + (xcd - r) * q) + off; }
        const int nig = WGM * nN, gid = wgid / nig, fm = gid * WGM, gsz = (nM - fm) < WGM ? (nM - fm) : WGM;
        u.pm = fm + ((wgid % nig) % gsz); u.pn = (wgid % nig) / gsz; u.e = 0; u.nvalid = 256; u.r = u.pm; return true;
    }
};

template <class P>
__device__ __forceinline__ void gemm_phase(LAS unsigned char* lds, const P& p) {
    int tid_ = threadIdx.x; asm volatile("" : "+v"(tid_));
    const int tid = tid_, wid = __builtin_amdgcn_readfirstlane(tid >> 6), lane = tid & 63, wr = wid >> 2, wc = wid & 3, fr = lane & 15, fq = lane >> 4;
    const int K = p.K, nt = K / BK;
    int sR[2], sC[2]; unsigned voffB[2];
#pragma unroll
    for (int i = 0; i < 2; ++i) { int R, C; stage_rc(tid * 16 + i * 8192, R, C); sR[i] = R; sC[i] = C; const int Rb = P::PERM ? ((R & ~31) + perm32(R & 31)) : R; voffB[i] = (unsigned)(Rb * K + C) * 2u; }
    const size_t kstep = (size_t)(BK * 2), hstepB = (size_t)HALF * K * 2;
    const unsigned ldsw = (unsigned)wid * 1024u;
    const int aoff = lds_byte(wr * 64 + fr, fq * 8), boff = lds_byte(wc * 32 + fr, fq * 8);
#define FG_SA(b, h) (((b) * 2 + (h)) * HTB)
#define FG_SB(b, h) ((4 + (b) * 2 + (h)) * HTB)
#define FG_STAGE(bufoff, gbase, voff) do { _Pragma("unroll") for (int _i = 0; _i < 2; ++_i) \
        __builtin_amdgcn_global_load_lds((const unsigned*)((const char*)(gbase) + (voff)[_i]), (LAS unsigned*)(lds + (bufoff) + ldsw + _i * 8192), 16, 0, 0); } while (0)
#define FG_LDA(dst, b, h) do { _Pragma("unroll") for (int m = 0; m < 4; ++m) _Pragma("unroll") for (int k = 0; k < 2; ++k) dst[m][k] = *(const LAS bf16x8*)(lds + FG_SA(b, h) + aoff + m * 2048 + k * 1024); } while (0)
#define FG_LDB(dst, b, h) do { _Pragma("unroll") for (int n = 0; n < 2; ++n) _Pragma("unroll") for (int k = 0; k < 2; ++k) dst[n][k] = *(const LAS bf16x8*)(lds + FG_SB(b, h) + boff + n * 2048 + k * 1024); } while (0)
#define FG_MMA(ai, bj, At, Bt) do { __builtin_amdgcn_s_setprio(1); _Pragma("unroll") for (int m = 0; m < 4; ++m) _Pragma("unroll") for (int n = 0; n < 2; ++n) _Pragma("unroll") for (int k = 0; k < 2; ++k) \
        acc[ai][bj][m][n] = __builtin_amdgcn_mfma_f32_16x16x32_bf16(Bt[n][k], At[m][k], acc[ai][bj][m][n], 0, 0, 0); __builtin_amdgcn_s_setprio(0); } while (0)
#define FG_WAIT_V(n) asm volatile("s_waitcnt vmcnt(" #n ")" ::: "memory")
#define FG_WAIT_L(n) asm volatile("s_waitcnt lgkmcnt(" #n ")" ::: "memory")
#define FG_BAR __builtin_amdgcn_s_barrier()
#define FG_SCHED __builtin_amdgcn_sched_barrier(0)
    Unit cur, nxt, nn; int ui = 0;
    if (!p.next(0, cur)) return;
    unsigned ao[4], nao[4], nnao[4];
    p.a_off(cur, sR, sC, ao);
    bool has_next = p.next(1, nxt);
    if (has_next) p.a_off(nxt, sR, sC, nao); else { nxt = cur; _Pragma("unroll") for (int j = 0; j < 4; ++j) nao[j] = ao[j]; }
    Acc acc;
#pragma unroll
    for (int a = 0; a < 2; ++a)
#pragma unroll
        for (int b = 0; b < 2; ++b)
#pragma unroll
            for (int m = 0; m < 4; ++m)
#pragma unroll
                for (int n = 0; n < 2; ++n) acc[a][b][m][n] = (f32x4){0.f, 0.f, 0.f, 0.f};
    bf16x8 At[4][2], B0[2][2], B1[2][2];
    const char* const Ab = p.A;
    const char* cB = p.b_base(cur);
    FG_STAGE(FG_SB(0, 0), cB, voffB); FG_STAGE(FG_SB(0, 1), cB + hstepB, voffB); FG_STAGE(FG_SA(0, 0), Ab, ao); FG_STAGE(FG_SA(0, 1), Ab, ao + 2);
    if (wr == 1) FG_BAR;
    FG_WAIT_V(2); FG_BAR;
    FG_STAGE(FG_SB(1, 0), cB + kstep, voffB); FG_STAGE(FG_SA(1, 0), Ab + kstep, ao); FG_STAGE(FG_SB(1, 1), cB + hstepB + kstep, voffB);
    FG_WAIT_V(6); FG_BAR;
    for (;;) {
        const char* nB = has_next ? p.b_base(nxt) : cB;
        for (int t = 0; t < nt; t += 2) {
            const bool last = (t == nt - 2);
            const char* a1 = Ab + (size_t)(t + 1) * kstep;
            const char* a2 = last ? Ab : Ab + (size_t)(t + 2) * kstep; const char* b2 = last ? nB : cB + (size_t)(t + 2) * kstep;
            const char* a3 = a2 + kstep; const char* b3 = b2 + kstep;
            unsigned so[4];
#pragma unroll
            for (int j = 0; j < 4; ++j) so[j] = last ? nao[j] : ao[j];
            FG_LDB(B0, 0, 0); FG_LDB(B1, 0, 1); FG_SCHED; FG_LDA(At, 0, 0); FG_STAGE(FG_SA(1, 1), a1, ao + 2);
            FG_WAIT_V(8); FG_WAIT_L(0); FG_BAR; FG_MMA(0, 0, At, B0); FG_MMA(0, 1, At, B1); FG_BAR; FG_SCHED;
            FG_LDA(At, 0, 1); FG_STAGE(FG_SB(0, 0), b2, voffB); FG_STAGE(FG_SB(0, 1), b2 + hstepB, voffB); FG_STAGE(FG_SA(0, 0), a2, so);
            FG_WAIT_V(8); FG_WAIT_L(0); FG_BAR; FG_MMA(1, 0, At, B0); FG_MMA(1, 1, At, B1); FG_BAR; FG_SCHED;
            FG_LDB(B0, 1, 0); FG_LDB(B1, 1, 1); FG_SCHED; FG_LDA(At, 1, 0); FG_STAGE(FG_SA(0, 1), a2, so + 2);
            FG_WAIT_V(8); FG_WAIT_L(0); FG_BAR; FG_MMA(0, 0, At, B0); FG_MMA(0, 1, At, B1); FG_BAR; FG_SCHED;
            FG_LDA(At, 1, 1); FG_STAGE(FG_SB(1, 0), b3, voffB); FG_STAGE(FG_SB(1, 1), b3 + hstepB, voffB); FG_STAGE(FG_SA(1, 0), a3, so);
            FG_WAIT_V(8); FG_WAIT_L(0); FG_BAR; FG_MMA(1, 0, At, B0); FG_MMA(1, 1, At, B1); FG_BAR; FG_SCHED;
        }
        if (wr == 0) FG_BAR;
        const bool has_nn = has_next && p.next(ui + 2, nn);
        if (has_nn) p.a_off(nn, sR, sC, nnao); else { nn = nxt; _Pragma("unroll") for (int j = 0; j < 4; ++j) nnao[j] = nao[j]; }
        p.epi(acc, cur, wr, wc, fr, fq);
        if (!has_next) break;
#pragma unroll
        for (int a = 0; a < 2; ++a)
#pragma unroll
            for (int b = 0; b < 2; ++b)
#pragma unroll
                for (int m = 0; m < 4; ++m)
#pragma unroll
                    for (int n = 0; n < 2; ++n) acc[a][b][m][n] = (f32x4){0.f, 0.f, 0.f, 0.f};
        cur = nxt; cB = nB; nxt = nn; has_next = has_nn; ++ui;
#pragma unroll
        for (int j = 0; j < 4; ++j) { ao[j] = nao[j]; nao[j] = nnao[j]; }
        if (wr == 1) FG_BAR;
    }
    FG_WAIT_V(0);
    FG_BAR;
#undef FG_SA
#undef FG_SB
#undef FG_STAGE
#undef FG_LDA
#undef FG_LDB
#undef FG_MMA
#undef FG_WAIT_V
#undef FG_WAIT_L
#undef FG_BAR
#undef FG_SCHED
}

template <class Epi> struct DenseP {
    static constexpr bool PERM = Epi::PERM;
    const char* A; int lda; const char* Bt; int K; StaticOrder S; Epi E;
    __device__ __forceinline__ bool next(int i, Unit& u) const { return S.next(i, u); }
    __device__ __forceinline__ const char* b_base(const Unit& u) const { return Bt + (size_t)u.pn * BM * K * 2; }
    __device__ __forceinline__ void a_off(const Unit& u, const int (&sR)[2], const int (&sC)[2], unsigned (&ao)[4]) const {
#pragma unroll
        for (int h = 0; h < 2; ++h)
#pragma unroll
            for (int i = 0; i < 2; ++i) ao[h * 2 + i] = (unsigned)((u.pm * BM + h * HALF + sR[i]) * lda + sC[i]) * 2u;
    }
    __device__ __forceinline__ void epi(const Acc& acc, const Unit& u, int wr, int wc, int fr, int fq) const { E(acc, u, wr, wc, fr, fq); }
};

struct EpiGlu {
    static constexpr bool PERM = true;
    const float* rstd; const float* bias; bf16* U;
    __device__ __forceinline__ void operator()(const Acc& acc, const Unit& u, int wr, int wc, int fr, int fq) const {
        const int col = u.pn * 128 + wc * 32 + fq * 8, row0 = u.pm * BM + wr * 64 + fr;
        const f32x4 ba0 = *(const f32x4*)(bias + col), ba1 = *(const f32x4*)(bias + col + 4), bg0 = *(const f32x4*)(bias + 1024 + col), bg1 = *(const f32x4*)(bias + 1024 + col + 4);
        float rsv[8];
#pragma unroll
        for (int q = 0; q < 8; ++q) rsv[q] = rstd[row0 + (q >> 2) * HALF + (q & 3) * 16];
#pragma unroll
        for (int ai = 0; ai < 2; ++ai)
#pragma unroll
            for (int m = 0; m < 4; ++m) { const int row = row0 + ai * HALF + m * 16; const float rs = rsv[ai * 4 + m];
                const f32x4 a0 = acc[ai][0][m][0] * rs + ba0, a1 = acc[ai][0][m][1] * rs + ba1, g0 = acc[ai][1][m][0] * rs + bg0, g1 = acc[ai][1][m][1] * rs + bg1;
                float o[8];
#pragma unroll
                for (int j = 0; j < 4; ++j) { o[j] = a0[j] * fast_sigmoid(g0[j]); o[4 + j] = a1[j] * fast_sigmoid(g1[j]); }
                u32x4 w; w.x = cvt_pk_bf16(o[0], o[1]); w.y = cvt_pk_bf16(o[2], o[3]); w.z = cvt_pk_bf16(o[4], o[5]); w.w = cvt_pk_bf16(o[6], o[7]);
                *(u32x4*)(U + (size_t)row * D + col) = w; }
    }
};
struct EpiRes {
    static constexpr bool PERM = false;
    const float* base; const float* bias; float* out;
    __device__ __forceinline__ void operator()(const Acc& acc, const Unit& u, int wr, int wc, int fr, int fq) const {
        const int row0 = u.pm * BM + wr * 64 + fr, col0 = u.pn * BM + wc * 32 + 4 * fq;
        f32x4 bv[2][2];
#pragma unroll
        for (int bj = 0; bj < 2; ++bj)
#pragma unroll
            for (int n = 0; n < 2; ++n) bv[bj][n] = bias ? *(const f32x4*)(bias + col0 + bj * HALF + n * 16) : (f32x4){0.f, 0.f, 0.f, 0.f};
#pragma unroll
        for (int ai = 0; ai < 2; ++ai)
#pragma unroll
        for (int mh = 0; mh < 2; ++mh) {
            f32x4 bs[2][2][2];
#pragma unroll
            for (int m2 = 0; m2 < 2; ++m2) { const size_t off = (size_t)(row0 + ai * HALF + (mh * 2 + m2) * 16) * D + col0;
#pragma unroll
                for (int bj = 0; bj < 2; ++bj)
#pragma unroll
                    for (int n = 0; n < 2; ++n) bs[m2][bj][n] = *(const f32x4*)(base + off + bj * HALF + n * 16); }
            asm volatile("" ::: "memory");
#pragma unroll
            for (int m2 = 0; m2 < 2; ++m2) { const int m = mh * 2 + m2; const size_t off = (size_t)(row0 + ai * HALF + m * 16) * D + col0;
#pragma unroll
                for (int bj = 0; bj < 2; ++bj)
#pragma unroll
                    for (int n = 0; n < 2; ++n) *(f32x4*)(out + off + bj * HALF + n * 16) = bs[m2][bj][n] + acc[ai][bj][m][n] + bv[bj][n]; }
            asm volatile("" ::: "memory");
        }
    }
};
__device__ __forceinline__ float quad_sum(float s) { s += __shfl_xor(s, 16); s += __shfl_xor(s, 32); return s; }
__device__ __forceinline__ u32x4 pack8(const f32x4 a, const f32x4 b) { u32x4 w; w.x = cvt_pk_bf16(a[0], a[1]); w.y = cvt_pk_bf16(a[2], a[3]); w.z = cvt_pk_bf16(b[0], b[1]); w.w = cvt_pk_bf16(b[2], b[3]); return w; }
__device__ __forceinline__ float sumsq8(const f32x4 a, const f32x4 b) { return (a[0] * a[0] + a[1] * a[1]) + (a[2] * a[2] + a[3] * a[3]) + (b[0] * b[0] + b[1] * b[1]) + (b[2] * b[2] + b[3] * b[3]); }
struct EpiCL {
    static constexpr bool PERM = true;
    const float* rstd2; bf16* CL; float* SSP;
    __device__ __forceinline__ void operator()(const Acc& acc, const Unit& u, int wr, int wc, int fr, int fq) const {
        const int row0 = u.pm * BM + wr * 64 + fr;
        float rsv[8];
#pragma unroll
        for (int q = 0; q < 8; ++q) rsv[q] = rstd2[row0 + (q >> 2) * HALF + (q & 3) * 16];
#pragma unroll
        for (int ai = 0; ai < 2; ++ai)
#pragma unroll
            for (int m = 0; m < 4; ++m) { const int row = row0 + ai * HALF + m * 16; const float rs = rsv[ai * 4 + m];
#pragma unroll
                for (int bj = 0; bj < 2; ++bj) { const f32x4 v0 = acc[ai][bj][m][0] * rs, v1 = acc[ai][bj][m][1] * rs; const float ss = quad_sum(sumsq8(v0, v1));
                    *(u32x4*)(CL + (size_t)row * NCL + u.pn * BM + bj * HALF + wc * 32 + fq * 8) = pack8(v0, v1);
                    const int g = u.pn * 8 + bj * 4 + wc; if (fq == 0) SSP[row * 32 + (g < 10 ? g : g + 2)] = ss; } }
    }
};
struct EpiQ {
    static constexpr bool PERM = true;
    const float* SSP; bf16* QRAW; float* SSQ;
    __device__ __forceinline__ void operator()(const Acc& acc, const Unit& u, int wr, int wc, int fr, int fq) const {
        const int row0 = u.pm * BM + wr * 64 + fr;
        float rsv[8];
#pragma unroll
        for (int q = 0; q < 8; ++q) { const int row = row0 + (q >> 2) * HALF + (q & 3) * 16;
            const f32x4 s0 = *(const f32x4*)(SSP + row * 32 + 12), s1 = *(const f32x4*)(SSP + row * 32 + 16), s2 = *(const f32x4*)(SSP + row * 32 + 20);
            rsv[q] = ((s0[0] + s0[1]) + (s0[2] + s0[3])) + ((s1[0] + s1[1]) + (s1[2] + s1[3])) + ((s2[0] + s2[1]) + (s2[2] + s2[3]));
            if (q == 3) asm volatile("" : "+v"(rsv[0]), "+v"(rsv[1]), "+v"(rsv[2]), "+v"(rsv[3]) :: "memory"); }
#pragma unroll
        for (int q = 0; q < 8; ++q) rsv[q] = fast_rsqrt(rsv[q] * (1.0f / QLR) + EPS);
#pragma unroll
        for (int ai = 0; ai < 2; ++ai)
#pragma unroll
            for (int m = 0; m < 4; ++m) { const int row = row0 + ai * HALF + m * 16; const float rs = rsv[ai * 4 + m];
#pragma unroll
                for (int bj = 0; bj < 2; ++bj) { const f32x4 v0 = acc[ai][bj][m][0] * rs, v1 = acc[ai][bj][m][1] * rs; const float ss = quad_sum(sumsq8(v0, v1));
                    *(u32x4*)(QRAW + (size_t)row * 1536 + u.pn * BM + bj * HALF + wc * 32 + fq * 8) = pack8(v0, v1);
                    if (fq == 0) SSQ[row * 48 + u.pn * 8 + bj * 4 + wc] = ss; } }
    }
};
struct EpiKV {
    static constexpr bool PERM = true;
    const float* SSP; bf16* KN; bf16* VV; float* SSK;
    __device__ __forceinline__ void operator()(const Acc& acc, const Unit& u, int wr, int wc, int fr, int fq) const {
        const int row0 = u.pm * BM + wr * 64 + fr;
        float rsv[8];
#pragma unroll
        for (int q = 0; q < 8; ++q) { const int row = row0 + (q >> 2) * HALF + (q & 3) * 16;
            const f32x4 s0 = *(const f32x4*)(SSP + row * 32), s1 = *(const f32x4*)(SSP + row * 32 + 4);
            rsv[q] = ((s0[0] + s0[1]) + (s0[2] + s0[3])) + ((s1[0] + s1[1]) + (s1[2] + s1[3])); }
#pragma unroll
        for (int q = 0; q < 8; ++q) rsv[q] = fast_rsqrt(rsv[q] * (1.0f / KVR) + EPS);
#pragma unroll
        for (int ai = 0; ai < 2; ++ai)
#pragma unroll
            for (int m = 0; m < 4; ++m) { const int row = row0 + ai * HALF + m * 16; const float rs = rsv[ai * 4 + m];
                { const f32x4 v0 = acc[ai][0][m][0] * rs, v1 = acc[ai][0][m][1] * rs; const float ss = quad_sum(sumsq8(v0, v1));
                  *(u32x4*)(KN + (size_t)row * D + u.pn * 128 + wc * 32 + fq * 8) = pack8(v0, v1);
                  if (fq == 0) SSK[row * 32 + u.pn * 4 + wc] = ss; }
                { const f32x4 v0 = acc[ai][1][m][0] * rs, v1 = acc[ai][1][m][1] * rs; const int b = row / SEQ, sq = row % SEQ;
                  *(u32x4*)(VV + (((size_t)b * NH + u.pn) * SEQ + sq) * DV + wc * 32 + fq * 8) = pack8(v0, v1); } }
    }
};

__device__ __forceinline__ void moe_setup(const int* CNT, LAS int* pref, LAS int* cnts) {
    const int tid = threadIdx.x;
    if (tid < 64) { const int c = tid < 32 ? (int)__hip_atomic_load((const unsigned*)CNT + tid * 64, __ATOMIC_RELAXED, __HIP_MEMORY_SCOPE_AGENT) : 0; int incl = (c + 255) >> 8;
#pragma unroll
        for (int o = 1; o < 32; o <<= 1) { const int v = __shfl_up(incl, o); if (tid >= o) incl += v; }
        if (tid < 32) { pref[tid + 1] = incl; cnts[tid] = c; } if (tid == 0) pref[0] = 0; }
    __syncthreads();
}
template <class Epi, bool GATHER> struct MoeP {
    static constexpr bool PERM = true;
    const char* A; int lda; int a_shift; const char* Bt; size_t b_estride; int K; const int4* LIST; const LAS int* pref; const LAS int* cnts; int G, c, nunits; Epi E;
    __device__ __forceinline__ bool next(int i, Unit& u) const {
        const int L = i * G + c; if (L >= nunits) return false;
        const int r = L >> 2, lane = threadIdx.x & 63; const int v = pref[(lane & 31) + 1];
        const int e = __builtin_popcountll(__ballot(lane < 32 && r >= v));
        u.pn = L & 3; u.e = e; u.r = r; u.pm = r - __builtin_amdgcn_readfirstlane(pref[e]); const int rem = __builtin_amdgcn_readfirstlane(cnts[e]) - BM * u.pm; u.nvalid = rem < BM ? rem : BM; return true;
    }
    __device__ __forceinline__ const char* b_base(const Unit& u) const { return Bt + (size_t)u.e * b_estride + (size_t)u.pn * BM * K * 2; }
    __device__ __forceinline__ void a_off(const Unit& u, const int (&sR)[2], const int (&sC)[2], unsigned (&ao)[4]) const {
        if constexpr (GATHER) {
            const int4* lp = LIST + (size_t)u.e * T + u.pm * BM;
#pragma unroll
            for (int h = 0; h < 2; ++h)
#pragma unroll
                for (int i = 0; i < 2; ++i) { const int row = h * HALF + sR[i]; int ent = lp[row].x; ent = row < u.nvalid ? ent : 0; ao[h * 2 + i] = (unsigned)((ent >> a_shift) * lda + sC[i]) * 2u; }
        } else {
#pragma unroll
            for (int h = 0; h < 2; ++h)
#pragma unroll
                for (int i = 0; i < 2; ++i) ao[h * 2 + i] = (unsigned)((u.r * BM + h * HALF + sR[i]) * lda + sC[i]) * 2u;
        }
    }
    __device__ __forceinline__ void epi(const Acc& acc, const Unit& u, int wr, int wc, int fr, int fq) const { E(acc, u, wr, wc, fr, fq, LIST + (size_t)u.e * T + u.pm * BM); }
};
struct EpiSwiglu {
    bf16* ACTS; int* POS;
    __device__ __forceinline__ void operator()(const Acc& acc, const Unit& u, int wr, int wc, int fr, int fq, const int4* lp) const {
        int4 rec[8];
#pragma unroll
        for (int q = 0; q < 8; ++q) { const int row = (q >> 2) * HALF + wr * 64 + (q & 3) * 16 + fr; rec[q] = lp[row]; }
#pragma unroll
        for (int ai = 0; ai < 2; ++ai)
#pragma unroll
            for (int m = 0; m < 4; ++m) { const int q = ai * 4 + m, row = ai * HALF + wr * 64 + m * 16 + fr; const float rs = __int_as_float(rec[q].y);
                const f32x4 a0 = acc[ai][0][m][0] * rs, a1 = acc[ai][0][m][1] * rs, b0 = acc[ai][1][m][0] * rs, b1 = acc[ai][1][m][1] * rs;
                float o[8];
#pragma unroll
                for (int j = 0; j < 4; ++j) { o[j] = a0[j] * fast_sigmoid(a0[j]) * b0[j]; o[4 + j] = a1[j] * fast_sigmoid(a1[j]) * b1[j]; }
                u32x4 w; w.x = cvt_pk_bf16(o[0], o[1]); w.y = cvt_pk_bf16(o[2], o[3]); w.z = cvt_pk_bf16(o[4], o[5]); w.w = cvt_pk_bf16(o[6], o[7]);
                *(u32x4*)(ACTS + (size_t)(u.r * BM + row) * DE + u.pn * 128 + wc * 32 + fq * 8) = w;
                if (u.pn == 0 && wc == 0 && fq == 0 && row < u.nvalid) POS[rec[q].x] = u.r * BM + row; }
    }
};
struct EpiDown {
    bf16* YS;
    __device__ __forceinline__ void operator()(const Acc& acc, const Unit& u, int wr, int wc, int fr, int fq, const int4*) const {
#pragma unroll
        for (int ai = 0; ai < 2; ++ai)
#pragma unroll
            for (int m = 0; m < 4; ++m) { const int row = ai * HALF + wr * 64 + m * 16 + fr;
#pragma unroll
                for (int bj = 0; bj < 2; ++bj) *(u32x4*)(YS + (size_t)(u.r * BM + row) * D + u.pn * BM + bj * HALF + wc * 32 + fq * 8) = pack8(acc[ai][bj][m][0], acc[ai][bj][m][1]); }
    }
};
}


namespace at {
typedef short s16x4 __attribute__((ext_vector_type(4)));
typedef float f32x16 __attribute__((ext_vector_type(16)));
constexpr int KTB = 64 * 192  , VTB = 64 * 256, LDS_K = 0, LDS_V = 2 * KTB, LDS_AL = LDS_V + 2 * VTB, LDS_TOTAL = LDS_AL + 8 * 256;
constexpr float SC2 = SM_SCALE * 1.4426950408889634f;
constexpr float THR2 = 11.0f / SC2;
__device__ __forceinline__ int v_rd_base(int lane) { return ((lane & 3) << 3) | (((lane >> 2) & 3) << 6) | (((lane >> 4) & 1) << 5) | (((lane >> 5) & 1) << 8); }
constexpr int v_rd_off(int d0, int ks, int half) { return d0 * 512 + ks * 4096 + half * 2048; }
__device__ __forceinline__ int crow(int r, int hi) { return (r & 3) + 8 * (r >> 2) + 4 * hi; }
#define AT_SBAR() __builtin_amdgcn_sched_barrier(0)

template <int BUF>
__device__ __forceinline__ void tile_compute(f32x16 (&o)[4], const long (&qr)[12], float& m_run, float& l_run, const LAS char* kl,
                                             int vb0, LAS float* al_l, int r32, int hi) {
    f32x16 p0 = {}, p1 = {};
#define AT_LOADB(kf, s_) do { kf[0] = *(const LAS long*)(kl + (s_) * 1024 + BUF * KTB); kf[1] = *(const LAS long*)(kl + (s_) * 1024 + 256 + BUF * KTB); } while (0)
#define AT_MMAB(kf, s_) do { __builtin_amdgcn_s_setprio(1); p0 = __builtin_amdgcn_mfma_f32_32x32x16_fp8_fp8(kf[0], qr[s_], p0, 0, 0, 0); p1 = __builtin_amdgcn_mfma_f32_32x32x16_fp8_fp8(kf[1], qr[s_], p1, 0, 0, 0); __builtin_amdgcn_s_setprio(0); } while (0)
    { long kfA[2], kfB[2], kfC[2], kfD[2];
      AT_LOADB(kfA, 0); AT_LOADB(kfB, 1); AT_LOADB(kfC, 2); AT_LOADB(kfD, 3); AT_SBAR();
      AT_MMAB(kfA, 0); AT_SBAR(); AT_LOADB(kfA, 4); AT_SBAR(); AT_MMAB(kfB, 1); AT_SBAR(); AT_LOADB(kfB, 5); AT_SBAR(); AT_MMAB(kfC, 2); AT_SBAR(); AT_LOADB(kfC, 6); AT_SBAR(); AT_MMAB(kfD, 3); AT_SBAR(); AT_LOADB(kfD, 7); AT_SBAR();
      AT_MMAB(kfA, 4); AT_SBAR(); AT_LOADB(kfA, 8); AT_SBAR(); AT_MMAB(kfB, 5); AT_SBAR(); AT_LOADB(kfB, 9); AT_SBAR(); AT_MMAB(kfC, 6); AT_SBAR(); AT_LOADB(kfC, 10); AT_SBAR(); AT_MMAB(kfD, 7); AT_SBAR(); AT_LOADB(kfD, 11); AT_SBAR();
      AT_MMAB(kfA, 8); AT_SBAR(); AT_MMAB(kfB, 9); AT_SBAR(); AT_MMAB(kfC, 10); AT_SBAR(); AT_MMAB(kfD, 11); AT_SBAR(); }
#undef AT_LOADB
#undef AT_MMAB
#define AT_TRRD(dst, off) asm volatile("ds_read_b64_tr_b16 %0, %1 offset:%2" : "=&v"(dst) : "v"(vb0), "i"(off) : "memory")
#define AT_VRD(X, d0) do { constexpr int b_ = BUF * VTB + v_rd_off(d0, 0, 0); \
        AT_TRRD(l##X##0, b_); AT_TRRD(h##X##0, b_ + 2048); AT_TRRD(l##X##1, b_ + 4096); AT_TRRD(h##X##1, b_ + 6144); AT_TRRD(l##X##2, b_ + 8192); AT_TRRD(h##X##2, b_ + 10240); AT_TRRD(l##X##3, b_ + 12288); AT_TRRD(h##X##3, b_ + 14336); } while (0)
#define AT_WAITL(n) do { asm volatile("s_waitcnt lgkmcnt(" #n ")" ::: "memory"); AT_SBAR(); } while (0)
#define AT_PVM(X, d0) do { \
        o[d0] = __builtin_amdgcn_mfma_f32_32x32x16_bf16(pa0, (bf16x8){l##X##0[0], l##X##0[1], l##X##0[2], l##X##0[3], h##X##0[0], h##X##0[1], h##X##0[2], h##X##0[3]}, o[d0], 0, 0, 0); \
        o[d0] = __builtin_amdgcn_mfma_f32_32x32x16_bf16(pa1, (bf16x8){l##X##1[0], l##X##1[1], l##X##1[2], l##X##1[3], h##X##1[0], h##X##1[1], h##X##1[2], h##X##1[3]}, o[d0], 0, 0, 0); \
        o[d0] = __builtin_amdgcn_mfma_f32_32x32x16_bf16(pa2, (bf16x8){l##X##2[0], l##X##2[1], l##X##2[2], l##X##2[3], h##X##2[0], h##X##2[1], h##X##2[2], h##X##2[3]}, o[d0], 0, 0, 0); \
        o[d0] = __builtin_amdgcn_mfma_f32_32x32x16_bf16(pa3, (bf16x8){l##X##3[0], l##X##3[1], l##X##3[2], l##X##3[3], h##X##3[0], h##X##3[1], h##X##3[2], h##X##3[3]}, o[d0], 0, 0, 0); } while (0)
    s16x4 lA0, lA1, lA2, lA3, hA0, hA1, hA2, hA3, lB0, lB1, lB2, lB3, hB0, hB1, hB2, hB3;
    AT_VRD(A, 0); AT_VRD(B, 1); AT_SBAR();
    float pmax = p0[0];
#pragma unroll
    for (int r = 1; r < 16; ++r) pmax = fmaxf(pmax, p0[r]);
#pragma unroll
    for (int r = 0; r < 16; ++r) pmax = fmaxf(pmax, p1[r]);
    { auto rr = __builtin_amdgcn_permlane32_swap(__float_as_uint(pmax), __float_as_uint(pmax), false, false); pmax = fmaxf(__uint_as_float(rr[0]), __uint_as_float(rr[1])); }
    float alpha = 1.f;
    if (!__all(pmax - m_run <= THR2)) { const float mn = fmaxf(m_run, pmax); alpha = __builtin_amdgcn_exp2f((m_run - mn) * SC2); m_run = mn; }
    const float mneg = -m_run * SC2;
#pragma unroll
    for (int r = 0; r < 16; ++r) { p0[r] = __builtin_amdgcn_exp2f(fmaf(p0[r], SC2, mneg)); p1[r] = __builtin_amdgcn_exp2f(fmaf(p1[r], SC2, mneg)); }
    float ps = 0.f;
#pragma unroll
    for (int r = 0; r < 16; ++r) ps += p0[r];
#pragma unroll
    for (int r = 0; r < 16; ++r) ps += p1[r];
    { auto rr = __builtin_amdgcn_permlane32_swap(__float_as_uint(ps), __float_as_uint(ps), false, false); ps = __uint_as_float(rr[0]) + __uint_as_float(rr[1]); }
    l_run = l_run * alpha + ps;
    bf16x8 pa0, pa1, pa2, pa3;
#define AT_PK4(P, B_, OUT) do { unsigned a0 = cvt_pk_bf16(P[B_+0], P[B_+1]), a1 = cvt_pk_bf16(P[B_+2], P[B_+3]); \
        unsigned b0 = cvt_pk_bf16(P[B_+4], P[B_+5]), b1 = cvt_pk_bf16(P[B_+6], P[B_+7]); \
        auto r0 = __builtin_amdgcn_permlane32_swap(a0, b0, false, false); auto r1 = __builtin_amdgcn_permlane32_swap(a1, b1, false, false); \
        u32x4 w = {r0[0], r1[0], r0[1], r1[1]}; OUT = *reinterpret_cast<bf16x8*>(&w); } while (0)
    AT_PK4(p0, 0, pa0); AT_PK4(p0, 8, pa1); AT_PK4(p1, 0, pa2); AT_PK4(p1, 8, pa3);
#undef AT_PK4
    if (__any(alpha < 1.f)) { if (hi == 0) al_l[r32] = alpha; asm volatile("s_waitcnt lgkmcnt(0)" ::: "memory");
#pragma unroll
        for (int d_ = 0; d_ < 4; ++d_)
#pragma unroll
            for (int r = 0; r < 16; ++r) o[d_][r] *= al_l[crow(r, hi)]; }
    AT_SBAR();
    AT_WAITL(8); AT_PVM(A, 0); AT_SBAR(); AT_VRD(A, 2);
    AT_WAITL(8); AT_PVM(B, 1); AT_SBAR(); AT_VRD(B, 3);
    AT_WAITL(8); AT_PVM(A, 2); AT_SBAR();
    AT_WAITL(0); AT_PVM(B, 3); AT_SBAR();
#undef AT_TRRD
#undef AT_VRD
#undef AT_WAITL
#undef AT_PVM
}

struct AttnArgs { const bf16* QRAW; const float* SSQ; const float* qg; const float* CS; const unsigned char* KK8; const bf16* VV; bf16* O; };

__device__ __forceinline__ void attn_phase(LAS unsigned char* lds, const AttnArgs& A, int G, int bx) {
    int tid_ = threadIdx.x; asm volatile("" : "+v"(tid_));
    const int tid = tid_, wid = __builtin_amdgcn_readfirstlane(tid >> 6), lane = tid & 63, r32 = lane & 31, hi = lane >> 5;
    const unsigned voffK = (unsigned)lane * 16u;
    unsigned voffV; { const int ob = (wid * 2 * 64 + lane) * 16, sub = ob >> 9, within = ob & 511, kk = (sub >> 2) * 8 + (within >> 6), cc = (sub & 3) * 32 + ((within & 63) >> 1);
        const int k = (kk & ~0xC) | ((kk & 4) << 1) | ((kk & 8) >> 1); voffV = (unsigned)(k * 256 + cc * 2); }
    const __amdgpu_buffer_rsrc_t rsK = __builtin_amdgcn_make_buffer_rsrc((void*)A.KK8, 0, NB * NH * (SEQ / 64) * KTB, 0x00020000), rsV = __builtin_amdgcn_make_buffer_rsrc((void*)A.VV, 0, T * NH * DV * 2, 0x00020000);
    const LAS char* kl = (const LAS char*)lds + LDS_K + hi * 512 + r32 * 8;
    const int vb0 = LDS_V + v_rd_base(lane);
    LAS float* al_l = (LAS float*)(lds + LDS_AL) + wid * 64; LAS float* li_l = al_l + 32;
    const int vcu = (G % 8 == 0) ? (bx % 8) * (G / 8) + bx / 8 : bx;
#define AT_ISSUE(t, buf) do { const int ks_ = kbase + (t) * KTB, vs_ = vbase + (t) * VTB; \
        __builtin_amdgcn_raw_ptr_buffer_load_lds(rsK, (LAS void*)(lds + LDS_K + (buf) * KTB + wid * 1024), 16, voffK, ks_ + wid * 1024, 0, 0); \
        if (wid < 4) __builtin_amdgcn_raw_ptr_buffer_load_lds(rsK, (LAS void*)(lds + LDS_K + (buf) * KTB + (wid + 8) * 1024), 16, voffK, ks_ + (wid + 8) * 1024, 0, 0); \
        _Pragma("unroll") for (int i_ = 0; i_ < 2; ++i_) __builtin_amdgcn_raw_ptr_buffer_load_lds(rsV, (LAS void*)(lds + LDS_V + (buf) * VTB + (wid * 2 + i_) * 1024), 16, voffV, vs_ + i_ * 128, 0, 0); } while (0)
    for (int item = vcu; item < NB * NH * 16; item += G) {
        const int bh = item >> 4, pr = item & 15, b = bh / NH, h = bh % NH;
        const int kbase = bh * ((SEQ / 64) * KTB), vbase = bh * (SEQ * DV * 2);
        for (int pass = 0; pass < 2; ++pass) {
            const int qb = pass == 0 ? 31 - pr : pr, NT = 4 * (qb + 1), myNT = 4 * qb + (wid >> 1) + 1;
            AT_ISSUE(0, 0);
            long qr[12];
            { const int t = b * SEQ + qb * 256 + wid * 32 + r32; const bf16* qp = A.QRAW + (size_t)t * 1536 + h * DQK + hi * 8;
              const f32x2* sq = (const f32x2*)(A.SSQ + (size_t)t * 48 + h * 6); const f32x2 s0 = sq[0], s1 = sq[1], s2 = sq[2];
              const float rq = fast_rsqrt(((s0[0] + s0[1]) + (s1[0] + s1[1]) + (s2[0] + s2[1])) * (1.0f / DQK) + EPS);
              float xt[4][8];
#pragma unroll
              for (int s = 0; s < 12; ++s) { const bf16x8 raw = *(const bf16x8*)(qp + s * 16); const f32x4 g0 = *(const f32x4*)(A.qg + s * 16 + hi * 8), g1 = *(const f32x4*)(A.qg + s * 16 + hi * 8 + 4);
                  float x[8];
#pragma unroll
                  for (int e = 0; e < 8; ++e) x[e] = __uint_as_float(((unsigned)(unsigned short)raw[e]) << 16) * (e < 4 ? g0[e] : g1[e - 4]) * rq;
                  if (s < 8) { const u32x2 w = pack_fp8x8(x); qr[s] = (long)(((unsigned long long)w.y << 32) | w.x); }
                  else {
#pragma unroll
                      for (int e = 0; e < 8; ++e) xt[s - 8][e] = x[e]; } }
#pragma unroll
              for (int s = 0; s < 2; ++s) { const float* cp = A.CS + (size_t)t * 64 + s * 16 + hi * 8;
                  const f32x4 c0 = *(const f32x4*)cp, c1 = *(const f32x4*)(cp + 4), n0 = *(const f32x4*)(cp + 32), n1 = *(const f32x4*)(cp + 36);
                  float y1[8], y2[8];
#pragma unroll
                  for (int e = 0; e < 8; ++e) { const float c = e < 4 ? c0[e] : c1[e - 4], sn = e < 4 ? n0[e] : n1[e - 4]; const float x1 = xt[s][e], x2 = xt[s + 2][e]; y1[e] = x1 * c - x2 * sn; y2[e] = x1 * sn + x2 * c; }
                  const u32x2 w = pack_fp8x8(y1), w2 = pack_fp8x8(y2);
                  qr[8 + s] = (long)(((unsigned long long)w.y << 32) | w.x); qr[10 + s] = (long)(((unsigned long long)w2.y << 32) | w2.x); } }
            float m_run = -1e30f, l_run = 0.f; f32x16 o[4] = {};
            for (int t = 0; t < NT; t += 2) {
                asm volatile("s_waitcnt vmcnt(0)" ::: "memory"); __builtin_amdgcn_s_barrier();
                AT_ISSUE(t + 1, 1);
                if (t < myNT) tile_compute<0>(o, qr, m_run, l_run, kl, vb0, al_l, r32, hi);
                asm volatile("s_waitcnt vmcnt(0)" ::: "memory"); __builtin_amdgcn_s_barrier();
                if (t + 2 < NT) AT_ISSUE(t + 2, 0);
                if (t + 1 < myNT) tile_compute<1>(o, qr, m_run, l_run, kl, vb0, al_l, r32, hi);
            }
            if (hi == 0) li_l[r32] = l_run; asm volatile("s_waitcnt lgkmcnt(0)" ::: "memory");
            bf16* Ow = A.O + (size_t)(b * SEQ + qb * 256 + wid * 32) * D + h * DV + (size_t)(4 * hi) * D + r32;
            asm volatile("" : "+v"(Ow));
#pragma unroll
            for (int r = 0; r < 16; ++r) { const int orow = crow(r, hi); const float rl = __builtin_amdgcn_rcpf(li_l[orow]);
#pragma unroll
                for (int d0 = 0; d0 < 4; ++d0) { const float v = o[d0][r] * rl; const float vn = __shfl_xor(v, 1);
                    if ((r32 & 1) == 0) *(unsigned*)(Ow + (size_t)((r & 3) + 8 * (r >> 2)) * D + d0 * 32) = cvt_pk_bf16(v, vn); } }
        }
    }
    asm volatile("s_waitcnt vmcnt(0)" ::: "memory"); __builtin_amdgcn_s_barrier();
#undef AT_ISSUE
}
#undef AT_SBAR
}


namespace th {
#define TH_LDS_WAIT() asm volatile("s_waitcnt lgkmcnt(0)" ::: "memory")
__device__ __forceinline__ void tr_item(const float* W, int K, int N, bf16* Wt, int row_off, const float* gain, int half, LAS float* scr, int item, int lane) {
    const int nblk = N / 32, kb = item / nblk, nb = item % nblk, k0 = 64 * kb, n0 = 32 * nb;
    const int kr = lane >> 3, c4 = (lane & 7) * 4;
    f32x4 v[8]; float g[8];
#pragma unroll
    for (int i = 0; i < 8; ++i) { v[i] = __builtin_nontemporal_load((const f32x4*)(W + (size_t)(k0 + 8 * i + kr) * N + n0 + c4)); g[i] = gain ? gain[k0 + 8 * i + kr] : 1.0f; }
#pragma unroll
    for (int i = 0; i < 8; ++i) { LAS float* d = scr + (8 * i + kr) * 33 + c4; d[0] = v[i][0] * g[i]; d[1] = v[i][1] * g[i]; d[2] = v[i][2] * g[i]; d[3] = v[i][3] * g[i]; }
    TH_LDS_WAIT(); asm volatile("" ::: "memory");
    const int c = lane & 7;
#pragma unroll
    for (int j = 0; j < 4; ++j) { const int n = (lane >> 3) + 8 * j; const LAS float* sp = scr + (8 * c) * 33 + n; const int nn = n0 + n, nr = half ? pair_row(nn, half) : nn;
        u32x4 o; o.x = cvt_pk_bf16(sp[0 * 33], sp[1 * 33]); o.y = cvt_pk_bf16(sp[2 * 33], sp[3 * 33]); o.z = cvt_pk_bf16(sp[4 * 33], sp[5 * 33]); o.w = cvt_pk_bf16(sp[6 * 33], sp[7 * 33]);
        *(u32x4*)(Wt + (size_t)(row_off + nr) * K + k0 + 8 * c) = o; }
    TH_LDS_WAIT(); asm volatile("" ::: "memory");
}
struct P0Args { const float* const* in; unsigned char* ws; };
__device__ __forceinline__ void prologue(LAS unsigned char* lds, const float* const (&in)[30], unsigned char* ws, int G, int bx) {
    const int tid = threadIdx.x, lane = tid & 63, wave = __builtin_amdgcn_readfirstlane(tid >> 6);
    LAS float* scr = (LAS float*)(lds + wave * 16384);
    const int gw = bx * NWAVES_ + wave, NGW = G * NWAVES_;
    bf16 *W1t = (bf16*)(ws + WS_W1T), *W2t = (bf16*)(ws + WS_W2T), *Wc = (bf16*)(ws + WS_WC), *Wukv = (bf16*)(ws + WS_WUKV), *Wuq = (bf16*)(ws + WS_WUQ), *Wo = (bf16*)(ws + WS_WO),
         *Wgu = (bf16*)(ws + WS_WGU), *Wd = (bf16*)(ws + WS_WD);
    constexpr int I_W1 = 16 * 64, I_W2 = 16 * 32, I_DKV = 16 * 8, I_KR = 16 * 2, I_DQ = 16 * 12, I_UKV = 4 * 64, I_UQ = 6 * 48, I_WO = 16 * 32, I_GU1 = 16 * 32, I_D1 = 8 * 32;
    constexpr int NIT = I_W1 + I_W2 + I_DKV + I_KR + I_DQ + I_UKV + I_UQ + I_WO + 64 * I_GU1 + 64 * I_D1;
    for (int it = gw; it < NIT; it += NGW) {
        int r = it;
        if (r < 64 * I_GU1) { const int e = r / I_GU1; tr_item(in[28] + (size_t)e * D * 1024, D, 1024, Wgu + (size_t)e * 1024 * D, 0, in[23] + (e / NE) * D, 512, scr, r % I_GU1, lane); continue; } r -= 64 * I_GU1;
        if (r < 64 * I_D1) { const int e = r / I_D1; tr_item(in[29] + (size_t)e * DE * D, DE, D, Wd + (size_t)e * D * DE, 0, nullptr, 0, scr, r % I_D1, lane); continue; } r -= 64 * I_D1;
        if (r < I_W1) { tr_item(in[3], D, 2048, W1t, 0, in[2], 1024, scr, r, lane); continue; } r -= I_W1;
        if (r < I_W2) { tr_item(in[9], D, D, W2t, 0, nullptr, 0, scr, r, lane); continue; } r -= I_W2;
        if (r < I_DKV) { tr_item(in[12], D, KVR, Wc, 0, in[11], 0, scr, r, lane); continue; } r -= I_DKV;
        if (r < I_KR) { tr_item(in[14], D, DROPE, Wc, 256, in[11], 0, scr, r, lane); continue; } r -= I_KR;
        if (r < I_DQ) { tr_item(in[18], D, QLR, Wc, 320, in[17], 0, scr, r, lane); continue; } r -= I_DQ;
        if (r < I_UKV) { tr_item(in[15], KVR, 2048, Wukv, 0, in[13], 0, scr, r, lane); continue; } r -= I_UKV;
        if (r < I_UQ) { tr_item(in[20], QLR, 1536, Wuq, 0, in[19], 0, scr, r, lane); continue; } r -= I_UQ;
        tr_item(in[22], D, D, Wo, 0, nullptr, 0, scr, r, lane);
    }
    const int gt = bx * (NWAVES_ * 64) + tid, NGT = G * NWAVES_ * 64;
    for (int i = gt; i < 64 * D / 8; i += NGT) ((u32x4*)(Wc + (size_t)704 * D))[i] = (u32x4){0u, 0u, 0u, 0u};
    { float* Wr = (float*)(ws + WS_WR);
      for (int i = gt; i < 2 * D * NRT; i += NGT) { const int c = i % NRT, k = (i / NRT) % D, l = i / (NRT * D);
          const float w = c < NG ? in[24][((size_t)l * D + k) * NG + c] : in[26][((size_t)l * D + k) * NE + (c - NG)];
          Wr[(size_t)l * D * NRT + ((((k >> 5) * 4 + ((k >> 3) & 3)) * NRT + c) * 8) + (k & 7)] = w * in[23][l * D + k]; } }
    { float* cs = (float*)(ws + WS_CS); const int* pos = (const int*)in[1];
      for (int i = gt; i < T * 32; i += NGT) { const int t = i >> 5, f = i & 31; const float ang = (float)pos[t] * INV_FREQ[f]; double sn, c; sincos_d((double)ang, sn, c); cs[(size_t)t * 64 + f] = (float)c; cs[(size_t)t * 64 + 32 + f] = (float)sn; } }
    { const float* x = in[0]; bf16* xb = (bf16*)(ws + WS_R1); float* rstd = (float*)(ws + WS_RSTD0);
      for (int row = gw; row < T; row += NGW) { const f32x4* xr = (const f32x4*)(x + (size_t)row * D); float ss = 0.f;
#pragma unroll
          for (int j = 0; j < 4; ++j) { const f32x4 v = xr[lane + 64 * j]; ss += (v[0] * v[0] + v[1] * v[1]) + (v[2] * v[2] + v[3] * v[3]);
              u32x2 o; o.x = cvt_pk_bf16(v[0], v[1]); o.y = cvt_pk_bf16(v[2], v[3]); ((u32x2*)(xb + (size_t)row * D))[lane + 64 * j] = o; }
          ss = wave_sum(ss); if (lane == 0) rstd[row] = fast_rsqrt(ss * (1.0f / D) + EPS); } }
}
__device__ __forceinline__ void conv_ln(LAS unsigned char* lds, const bf16* U, const float* dw_w, const float* dw_b, const float* ln_g, const float* ln_b, bf16* Vb, int G, int bx) {
    const int tid = threadIdx.x, lane = tid & 63, wave = __builtin_amdgcn_readfirstlane(tid >> 6);
    LAS float* tile = (LAS float*)lds;
    const int c0 = tid * 2;
    float w0[CONVW], w1[CONVW];
#pragma unroll
    for (int j = 0; j < CONVW; ++j) { const f32x2 w = *(const f32x2*)(dw_w + j * D + c0); w0[j] = w[0]; w1[j] = w[1]; }
    const f32x2 bb = *(const f32x2*)(dw_b + c0);
    for (int unit = bx; unit < T / 16; unit += G) {
        const int t0 = unit * 16, s0 = t0 & (SEQ - 1);
        float a0[16], a1[16];
#pragma unroll
        for (int r = 0; r < 16; ++r) { a0[r] = bb[0]; a1[r] = bb[1]; }
#define CV_LOAD(dst, ib) do { _Pragma("unroll") for (int k = 0; k < 12; ++k) { const int i = (ib) + k; dst[k] = (i < 46 && s0 - 30 + i >= 0) ? *(const unsigned*)(U + (size_t)(t0 - 30 + i) * D + c0) : 0u; } } while (0)
#define CV_FMA(src, ib) do { _Pragma("unroll") for (int k = 0; k < 12; ++k) { const int i = (ib) + k; if (i < 46) { const float u0 = __uint_as_float(src[k] << 16), u1 = __uint_as_float(src[k] & 0xffff0000u); \
            _Pragma("unroll") for (int r = 0; r < 16; ++r) { const int j = i - r; if (j >= 0 && j < CONVW) { a0[r] = fmaf(w0[j], u0, a0[r]); a1[r] = fmaf(w1[j], u1, a1[r]); } } } } } while (0)
        { unsigned ua[12], ub[12];
          CV_LOAD(ua, 0); asm volatile("" ::: "memory");
          CV_LOAD(ub, 12); asm volatile("" ::: "memory"); CV_FMA(ua, 0);
          CV_LOAD(ua, 24); asm volatile("" ::: "memory"); CV_FMA(ub, 12);
          CV_LOAD(ub, 36); asm volatile("" ::: "memory"); CV_FMA(ua, 24);
          CV_FMA(ub, 36); }
#undef CV_LOAD
#undef CV_FMA
#pragma unroll
        for (int r = 0; r < 16; ++r) *(LAS f32x2*)(tile + r * D + c0) = (f32x2){a0[r], a1[r]};
        __syncthreads();
#pragma unroll
        for (int rr = 0; rr < 2; ++rr) { const int r = wave * 2 + rr; const LAS f32x4* xr = (const LAS f32x4*)(tile + r * D); f32x4 v[4]; float sm = 0.f;
#pragma unroll
            for (int j = 0; j < 4; ++j) { v[j] = xr[lane + 64 * j]; sm += (v[j][0] + v[j][1]) + (v[j][2] + v[j][3]); }
            const float mean = wave_sum(sm) * (1.0f / D); float q = 0.f;
#pragma unroll
            for (int j = 0; j < 4; ++j) { v[j] = v[j] - mean; q += (v[j][0] * v[j][0] + v[j][1] * v[j][1]) + (v[j][2] * v[j][2] + v[j][3] * v[j][3]); }
            const float rs = fast_rsqrt(wave_sum(q) * (1.0f / D) + EPS);
#pragma unroll
            for (int j = 0; j < 4; ++j) { const int c = (lane + 64 * j) * 4; const f32x4 gg = *(const f32x4*)(ln_g + c), bv = *(const f32x4*)(ln_b + c); const f32x4 y = v[j] * rs * gg + bv;
                u32x2 o; o.x = cvt_pk_bf16(y[0] * fast_sigmoid(y[0]), y[1] * fast_sigmoid(y[1])); o.y = cvt_pk_bf16(y[2] * fast_sigmoid(y[2]), y[3] * fast_sigmoid(y[3]));
                ((u32x2*)(Vb + (size_t)(t0 + r) * D))[lane + 64 * j] = o; } }
        __syncthreads();
    }
}
__device__ __forceinline__ void route(LAS unsigned char* lds, const float* H, const float* WrP, const float* bg, const float* br, bf16* XT, int4* LIST, int* CNT, float* GATE, int G, int bx) {
    int tid_ = threadIdx.x; asm volatile("" : "+v"(tid_));
    const int tid = tid_, lane = tid & 63, wave = __builtin_amdgcn_readfirstlane(tid >> 6), r16 = lane & 15, kq = lane >> 4;
    LAS float* Bs = (LAS float*)lds; LAS float* LG = (LAS float*)(lds + 73728) + wave * (16 * 37);
    constexpr int NTILES = T / 16; const int NW = G * NWAVES_;
    LAS int* lcnt = (LAS int*)(lds + 73728 + 8 * 16 * 37 * 4); LAS int* gbase = lcnt + NE;
    if (tid < NE) lcnt[tid] = 0;
    int e0 = 0, e1 = 0, sl0 = 0, sl1 = 0; float rsv = 0.f, gt0 = 0.f, gt1 = 0.f;
    for (int base = 0; base < NTILES; base += NW) {
        const int tile = base + bx * NWAVES_ + wave; const bool act = tile < NTILES; const int t0 = tile * 16;
        f32x4 c0 = {0.f, 0.f, 0.f, 0.f}, c1 = c0, c2 = c0; float ss = 0.f;
#pragma unroll 1
        for (int half = 0; half < 2; ++half) {
            __syncthreads();
#pragma unroll
            for (int i = 0; i < 9; ++i) ((LAS f32x4*)Bs)[tid + 512 * i] = ((const f32x4*)(WrP + half * 18432))[tid + 512 * i];
            __syncthreads();
            if (act) {
                const float* hp = H + (size_t)(t0 + r16) * D + half * 512 + 8 * kq; bf16* xp = XT + (size_t)(t0 + r16) * D + half * 512 + 8 * kq;
#pragma unroll 4
                for (int jj = 0; jj < 16; ++jj) {
                    const f32x4 a0 = *(const f32x4*)(hp + 32 * jj), a1 = *(const f32x4*)(hp + 32 * jj + 4);
                    ss += ((a0[0] * a0[0] + a0[1] * a0[1]) + (a0[2] * a0[2] + a0[3] * a0[3])) + ((a1[0] * a1[0] + a1[1] * a1[1]) + (a1[2] * a1[2] + a1[3] * a1[3]));
                    u32x4 w; w.x = cvt_pk_bf16(a0[0], a0[1]); w.y = cvt_pk_bf16(a0[2], a0[3]); w.z = cvt_pk_bf16(a1[0], a1[1]); w.w = cvt_pk_bf16(a1[2], a1[3]); *(u32x4*)(xp + 32 * jj) = w;
                    const LAS float* bp = Bs + ((jj * 4 + kq) * NRT + r16) * 8;
                    const f32x4 b00 = *(const LAS f32x4*)bp, b01 = *(const LAS f32x4*)(bp + 4), b10 = *(const LAS f32x4*)(bp + 128), b11 = *(const LAS f32x4*)(bp + 132), b20 = *(const LAS f32x4*)(bp + 256), b21 = *(const LAS f32x4*)(bp + 260);
#pragma unroll
                    for (int i = 0; i < 4; ++i) { c0 = __builtin_amdgcn_mfma_f32_16x16x4f32(a0[i], b00[i], c0, 0, 0, 0); c1 = __builtin_amdgcn_mfma_f32_16x16x4f32(a0[i], b10[i], c1, 0, 0, 0); c2 = __builtin_amdgcn_mfma_f32_16x16x4f32(a0[i], b20[i], c2, 0, 0, 0); }
#pragma unroll
                    for (int i = 0; i < 4; ++i) { c0 = __builtin_amdgcn_mfma_f32_16x16x4f32(a1[i], b01[i], c0, 0, 0, 0); c1 = __builtin_amdgcn_mfma_f32_16x16x4f32(a1[i], b11[i], c1, 0, 0, 0); c2 = __builtin_amdgcn_mfma_f32_16x16x4f32(a1[i], b21[i], c2, 0, 0, 0); }
                }
            }
        }
        if (act) {
            ss += __shfl_xor(ss, 16); ss += __shfl_xor(ss, 32);
#pragma unroll
            for (int rg = 0; rg < 4; ++rg) { LG[(4 * kq + rg) * 37 + r16] = c0[rg]; LG[(4 * kq + rg) * 37 + 16 + r16] = c1[rg]; if (r16 < 4) LG[(4 * kq + rg) * 37 + 32 + r16] = c2[rg]; }
            asm volatile("s_waitcnt lgkmcnt(0)" ::: "memory");
            if (lane < 16) {
                const int t = t0 + lane; const LAS float* lr = LG + lane * 37;
                const float rs = fast_rsqrt(ss * (1.0f / D) + EPS);
                float lg[NG]; int gi = 0; float gm = -3.0e38f;
#pragma unroll
                for (int c = 0; c < NG; ++c) { lg[c] = lr[c] * rs + bg[c]; if (lg[c] > gm) { gm = lg[c]; gi = c; } }
                float gs = 0.f;
#pragma unroll
                for (int c = 0; c < NG; ++c) gs += __expf(lg[c] - gm);
                const float gw = 1.0f / gs;
                float le[EPG]; float em = -3.0e38f;
#pragma unroll
                for (int c = 0; c < EPG; ++c) { le[c] = lr[NG + gi * EPG + c] * rs + br[gi * EPG + c]; em = fmaxf(em, le[c]); }
                int i0 = 0; float v0 = -3.0e38f;
#pragma unroll
                for (int c = 0; c < EPG; ++c) if (le[c] > v0) { v0 = le[c]; i0 = c; }
                int i1 = 0; float v1 = -3.0e38f;
#pragma unroll
                for (int c = 0; c < EPG; ++c) if (c != i0 && le[c] > v1) { v1 = le[c]; i1 = c; }
                const float p0 = __expf(v0 - em), p1 = __expf(v1 - em); const float inv = 1.0f / (p0 + p1);
                e0 = gi * EPG + i0; e1 = gi * EPG + i1; rsv = rs; gt0 = gw * p0 * inv; gt1 = gw * p1 * inv;
                GATE[2 * t] = gt0; GATE[2 * t + 1] = gt1;
                sl0 = __hip_atomic_fetch_add(lcnt + e0, 1, __ATOMIC_RELAXED, __HIP_MEMORY_SCOPE_WORKGROUP);
                sl1 = __hip_atomic_fetch_add(lcnt + e1, 1, __ATOMIC_RELAXED, __HIP_MEMORY_SCOPE_WORKGROUP);
            }
        }
        __syncthreads();
        if (tid < NE) { const int n = lcnt[tid]; gbase[tid] = n > 0 ? atomicAdd(CNT + tid * 64, n) : 0; }
        __syncthreads();
        if (act && lane < 16) { const int t = t0 + lane;
            LIST[(size_t)e0 * T + gbase[e0] + sl0] = make_int4(2 * t, __float_as_int(rsv), __float_as_int(gt0), 0);
            LIST[(size_t)e1 * T + gbase[e1] + sl1] = make_int4(2 * t + 1, __float_as_int(rsv), __float_as_int(gt1), 0); }
        __syncthreads();
        if (tid < NE) lcnt[tid] = 0;
    }
    __syncthreads();
}
__device__ __forceinline__ void combine(float* H, const bf16* YS, const int* POS, const float* GATE, bf16* HB, float* RSTD2, int G, int bx) {
    const int tid = threadIdx.x, lane = tid & 63, wave = __builtin_amdgcn_readfirstlane(tid >> 6);
    for (int t = bx * NWAVES_ + wave; t < T; t += G * NWAVES_) {
        const int p0 = POS[2 * t], p1 = POS[2 * t + 1]; const float g0 = GATE[2 * t], g1 = GATE[2 * t + 1];
        f32x4* hr = (f32x4*)(H + (size_t)t * D); const u32x2* y0 = (const u32x2*)(YS + (size_t)p0 * D); const u32x2* y1 = (const u32x2*)(YS + (size_t)p1 * D);
        float ss = 0.f;
#pragma unroll
        for (int j = 0; j < 4; ++j) { f32x4 v = hr[lane + 64 * j]; const u32x2 p = y0[lane + 64 * j], q = y1[lane + 64 * j];
            v[0] += g0 * __uint_as_float(p.x << 16) + g1 * __uint_as_float(q.x << 16); v[1] += g0 * __uint_as_float(p.x & 0xffff0000u) + g1 * __uint_as_float(q.x & 0xffff0000u);
            v[2] += g0 * __uint_as_float(p.y << 16) + g1 * __uint_as_float(q.y << 16); v[3] += g0 * __uint_as_float(p.y & 0xffff0000u) + g1 * __uint_as_float(q.y & 0xffff0000u);
            hr[lane + 64 * j] = v; ss += (v[0] * v[0] + v[1] * v[1]) + (v[2] * v[2] + v[3] * v[3]);
            if (HB) { u32x2 o; o.x = cvt_pk_bf16(v[0], v[1]); o.y = cvt_pk_bf16(v[2], v[3]); ((u32x2*)(HB + (size_t)t * D))[lane + 64 * j] = o; } }
        if (RSTD2) { ss = wave_sum(ss); if (lane == 0) RSTD2[t] = fast_rsqrt(ss * (1.0f / D) + EPS); }
    }
}
__device__ __forceinline__ void kfin(const bf16* KN, const bf16* CL, const float* SSK, const float* SSP, const float* kg, const float* cs, unsigned char* KK8, int G, int bx) {
    const int tid = threadIdx.x, lane = tid & 63, wave = __builtin_amdgcn_readfirstlane(tid >> 6), r32 = lane & 31, hi = lane >> 5;
    for (int item = bx * NWAVES_ + wave; item < NB * NH * (SEQ / 64) * 2; item += G * NWAVES_) {
        const int blk = item & 1, tile = (item >> 1) & (SEQ / 64 - 1), bh = item >> 8, b = bh / NH, h = bh % NH;
        const int t = b * SEQ + tile * 64 + blk * 32 + r32;
        const f32x4 sk = *(const f32x4*)(SSK + t * 32 + h * 4); const f32x2 sr = *(const f32x2*)(SSP + t * 32 + 8);
        const float rk = fast_rsqrt((((sk[0] + sk[1]) + (sk[2] + sk[3])) + (sr[0] + sr[1])) * (1.0f / DQK) + EPS);
        unsigned char* out = KK8 + ((size_t)(bh * (SEQ / 64) + tile)) * (64 * 192) + blk * 256 + hi * 512 + r32 * 8;
        const bf16* kn = KN + (size_t)t * D + h * 128 + hi * 8;
#pragma unroll
        for (int s = 0; s < 8; ++s) { const bf16x8 raw = *(const bf16x8*)(kn + s * 16); const f32x4 g0 = *(const f32x4*)(kg + s * 16 + hi * 8), g1 = *(const f32x4*)(kg + s * 16 + hi * 8 + 4);
            float y[8];
#pragma unroll
            for (int e = 0; e < 8; ++e) y[e] = __uint_as_float(((unsigned)(unsigned short)raw[e]) << 16) * rk * (e < 4 ? g0[e] : g1[e - 4]);
            *(u32x2*)(out + s * 1024) = pack_fp8x8(y); }
#pragma unroll
        for (int s = 0; s < 2; ++s) { const int jt = s * 16 + hi * 8;
            const bf16x8 r1 = *(const bf16x8*)(CL + (size_t)t * NCL + 256 + jt), r2 = *(const bf16x8*)(CL + (size_t)t * NCL + 288 + jt);
            const float* cp = cs + (size_t)t * 64 + jt; const f32x4 c0 = *(const f32x4*)cp, c1 = *(const f32x4*)(cp + 4), n0 = *(const f32x4*)(cp + 32), n1 = *(const f32x4*)(cp + 36);
            const f32x4 ga0 = *(const f32x4*)(kg + 128 + jt), ga1 = *(const f32x4*)(kg + 132 + jt), gb0 = *(const f32x4*)(kg + 160 + jt), gb1 = *(const f32x4*)(kg + 164 + jt);
            float y1[8], y2[8];
#pragma unroll
            for (int e = 0; e < 8; ++e) { const float p = __uint_as_float(((unsigned)(unsigned short)r1[e]) << 16) * rk * (e < 4 ? ga0[e] : ga1[e - 4]), q = __uint_as_float(((unsigned)(unsigned short)r2[e]) << 16) * rk * (e < 4 ? gb0[e] : gb1[e - 4]);
                const float c = e < 4 ? c0[e] : c1[e - 4], sn = e < 4 ? n0[e] : n1[e - 4]; y1[e] = p * c - q * sn; y2[e] = p * sn + q * c; }
            *(u32x2*)(out + (8 + s) * 1024) = pack_fp8x8(y1); *(u32x2*)(out + (10 + s) * 1024) = pack_fp8x8(y2); }
    }
}
#undef TH_LDS_WAIT
}

#define XB_TMO      128
#define XB_XCNT(j)  (256  + 64 * (j))
#define XB_XSUB(j)  (1280 + 64 * (j))
#define XB_XGEN(j)  (2304 + 64 * (j))
#define XB_TOP      3328
#define XB_TOPGEN   3392
#define XCD_BAR_WORDS 3456
#define XB_SPIN_CAP (1u << 18)
__device__ __forceinline__ unsigned xb_ld(unsigned* p)              { return __hip_atomic_load(p, __ATOMIC_RELAXED, __HIP_MEMORY_SCOPE_AGENT); }
__device__ __forceinline__ unsigned xb_add(unsigned* p, unsigned v) { return __hip_atomic_fetch_add(p, v, __ATOMIC_RELAXED, __HIP_MEMORY_SCOPE_AGENT); }
__device__ __forceinline__ unsigned xb_xcc_id() { return (unsigned)__builtin_amdgcn_s_getreg((3 << 11) | 20) & 0xFu; }
#define XB_SPIN(cond, bar) do { unsigned _sp = 0; while (cond) { __builtin_amdgcn_s_sleep(1); \
    if ((++_sp & 255u) == 0u) { if (xb_ld(&(bar)[XB_TMO])) break; if (_sp > XB_SPIN_CAP) { atomicAdd(&(bar)[XB_TMO], 1u); break; } } } } while (0)
struct XcdBarrier { unsigned* bar; unsigned x; volatile LAS unsigned* st; };
__device__ __forceinline__ XcdBarrier xcd_barrier_post(unsigned* bar, volatile LAS unsigned* st) {
    XcdBarrier b; b.bar = bar; b.x = xb_xcc_id(); b.st = st;
    if (threadIdx.x == 0) (void)xb_add(&bar[XB_XCNT(b.x)], 1u);
    return b;
}
__device__ __forceinline__ void xcd_barrier_complete(unsigned* bar, unsigned x, unsigned& nloc, unsigned& nx) {
    const unsigned G = gridDim.x * gridDim.y * gridDim.z;
    unsigned sum, cnt, mine, sp = 0u;
    for (;;) {
        sum = 0u; cnt = 0u; mine = 0u;
#pragma unroll
        for (unsigned j = 0; j < 16; ++j) { const unsigned c = xb_ld(&bar[XB_XCNT(j)]); sum += c; cnt += (c > 0u) ? 1u : 0u; mine = (j == x) ? c : mine; }
        if (sum == G) break;
        __builtin_amdgcn_s_sleep(1);
        if ((++sp & 255u) == 0u) { if (xb_ld(&bar[XB_TMO])) break; if (sp > XB_SPIN_CAP) { atomicAdd(&bar[XB_TMO], 1u); break; } }
    }
    nloc = mine > 0u ? mine : 1u; nx = cnt > 0u ? cnt : 1u;
}
__device__ __forceinline__ void xcd_barrier(const XcdBarrier& b) {
    asm volatile("s_waitcnt vmcnt(0)" ::: "memory");
    __syncthreads();
    if (threadIdx.x == 0) {
        unsigned* bar = b.bar;
        __builtin_amdgcn_s_waitcnt(0);
        unsigned nloc = b.st[0], nx = b.st[1];
        if (nloc == 0u) { xcd_barrier_complete(bar, b.x, nloc, nx); b.st[0] = nloc; b.st[1] = nx; }
        const unsigned old = xb_add(&bar[XB_XSUB(b.x)], 1u);
        const unsigned gen = old / nloc;
        if (old + 1u == (gen + 1u) * nloc) {
            __builtin_amdgcn_fence(__ATOMIC_RELEASE, "agent");
            asm volatile("s_waitcnt vmcnt(0)" ::: "memory");
            const unsigned og = xb_add(&bar[XB_TOP], 1u);
            const unsigned tg = og / nx;
            if (og + 1u == (tg + 1u) * nx) xb_add(&bar[XB_TOPGEN], 1u);
            else XB_SPIN(xb_ld(&bar[XB_TOPGEN]) == tg, bar);
            __builtin_amdgcn_fence(__ATOMIC_ACQUIRE, "agent");
            xb_add(&bar[XB_XGEN(b.x)], 1u);
            asm volatile("s_waitcnt vmcnt(0)" ::: "memory");
        } else {
            XB_SPIN(xb_ld(&bar[XB_XGEN(b.x)]) == gen, bar);
            __builtin_amdgcn_fence(__ATOMIC_ACQUIRE, "agent");
            asm volatile("s_waitcnt vmcnt(0)" ::: "memory");
        }
    }
    __syncthreads();
}

constexpr int NWAVES = 8, LDS_BYTES = 160 * 1024, LDS_MISC = 159 * 1024;
constexpr int CW_BAR = 4096;
constexpr int NPHASE = 17;
constexpr int REP0 = 1, REP1 = 1, REP2 = 1, REP3 = 1, REP5 = 1, REP6 = 1, REP8 = 1, REP9 = 1, REP10 = 1, REP11 = 1, REP14 = 1, REP15 = 1;
struct Args { const float* in[30]; float* out; unsigned char* ws; int ph_lo, ph_hi; };

__global__ void __launch_bounds__(NWAVES * 64, 2) fwd(Args a) {
    extern __shared__ __attribute__((aligned(16))) unsigned char lds_raw[];
    LAS unsigned char* lds = (LAS unsigned char*)lds_raw;
    volatile LAS unsigned* MISC = (volatile LAS unsigned*)(lds + LDS_MISC);
    const int tid = threadIdx.x;
    if (tid < 64) MISC[tid] = 0u;
    __syncthreads();
    unsigned char* ws = a.ws; float* H = a.out;
    XcdBarrier bar = xcd_barrier_post((unsigned*)(ws + WS_CTL) + CW_BAR, MISC + 8);
    const int lo = a.ph_lo, hi = a.ph_hi, G = gridDim.x, bx = blockIdx.x;
    const int vcu = (G % 8 == 0) ? (bx % 8) * (G / 8) + bx / 8 : bx;
#define IN(k) (lo <= (k) && (k) < hi)
#define SEAM(k) do { if (IN(k) && IN((k) + 1)) xcd_barrier(bar); } while (0)
    const float* x = a.in[0];
    bf16 *W1t = (bf16*)(ws + WS_W1T), *W2t = (bf16*)(ws + WS_W2T), *Wc = (bf16*)(ws + WS_WC), *Wukv = (bf16*)(ws + WS_WUKV), *Wuq = (bf16*)(ws + WS_WUQ), *Wo = (bf16*)(ws + WS_WO);
    float *RSTD0 = (float*)(ws + WS_RSTD0), *RSTD2 = (float*)(ws + WS_RSTD2), *SSP = (float*)(ws + WS_SSP), *SSQ = (float*)(ws + WS_SSQ), *SSK = (float*)(ws + WS_SSK);
    bf16 *XB = (bf16*)(ws + WS_R1), *HB = XB, *U = (bf16*)(ws + WS_R2), *O = U, *Vb = (bf16*)(ws + WS_R3), *KN = Vb, *VV = (bf16*)(ws + WS_R3 + 64 * MiB),
         *CL = (bf16*)(ws + WS_CL), *QRAW = (bf16*)(ws + WS_QRAW);

    if (IN(0)) for (int rep_ = 0; rep_ < REP0; ++rep_) th::prologue(lds, a.in, ws, G, bx);
    SEAM(0);
    if (IN(1)) for (int rep_ = 0; rep_ < REP1; ++rep_) { fg::DenseP<fg::EpiGlu> p{(const char*)XB, D, (const char*)W1t, D, {}, {RSTD0, a.in[4], U}}; p.S.init(T, 2048, G, bx); fg::gemm_phase(lds, p); }
    SEAM(1);
    if (IN(2)) for (int rep_ = 0; rep_ < REP2; ++rep_) th::conv_ln(lds, U, a.in[5], a.in[6], a.in[7], a.in[8], Vb, G, bx);
    SEAM(2);
    if (IN(3)) for (int rep_ = 0; rep_ < REP3; ++rep_) { fg::DenseP<fg::EpiRes> p{(const char*)Vb, D, (const char*)W2t, D, {}, {x, a.in[10], H}}; p.S.init(T, D, G, bx); fg::gemm_phase(lds, p); }
    SEAM(3);
    LAS int* pref = (LAS int*)(lds + LDS_MISC + 256); LAS int* cnts = (LAS int*)(lds + LDS_MISC + 512);
    int4* LIST = (int4*)(ws + WS_LISTR); int* POS = (int*)(ws + WS_LIST); float* GATE = (float*)(ws + WS_GATE); bf16* ACTS = (bf16*)(ws + WS_ACTS); bf16* YS = (bf16*)(ws + WS_YS);
    bf16* XT = XB; bf16* ACT = U; bf16* Y = Vb; const bf16* Wgu = (const bf16*)(ws + WS_WGU); const bf16* Wd = (const bf16*)(ws + WS_WD);
#define MOE_GEMMS(l, p1, p2) do { \
        if (IN(p1)) for (int rep_ = 0; rep_ < ((l) ? REP14 : REP5); ++rep_) { fg::moe_setup((const int*)(ws + WS_CTL) + (l) * NE * 64, pref, cnts); \
            fg::MoeP<fg::EpiSwiglu, true> p{(const char*)XT, D, 1, (const char*)(Wgu + (size_t)(l) * NE * 1024 * D), (size_t)1024 * D * 2, D, LIST, pref, cnts, G, vcu, 4 * __builtin_amdgcn_readfirstlane(pref[32]), {ACTS, POS}}; \
            fg::gemm_phase(lds, p); } \
        SEAM(p1); \
        if (IN(p2)) for (int rep_ = 0; rep_ < ((l) ? REP15 : REP6); ++rep_) { fg::moe_setup((const int*)(ws + WS_CTL) + (l) * NE * 64, pref, cnts); \
            fg::MoeP<fg::EpiDown, false> p{(const char*)ACTS, DE, 0, (const char*)(Wd + (size_t)(l) * NE * D * DE), (size_t)D * DE * 2, DE, LIST, pref, cnts, G, vcu, 4 * __builtin_amdgcn_readfirstlane(pref[32]), {YS}}; \
            fg::gemm_phase(lds, p); } \
        SEAM(p2); } while (0)
    float* Wr = (float*)(ws + WS_WR); int* CNT = (int*)(ws + WS_CTL);
    if (IN(4)) th::route(lds, H, Wr, a.in[25], a.in[27], XT, LIST, CNT, GATE, G, bx);
    SEAM(4);
    MOE_GEMMS(0, 5, 6);
    if (IN(7)) th::combine(H, YS, POS, GATE, HB, RSTD2, G, bx);
    SEAM(7);
    if (IN(8)) for (int rep_ = 0; rep_ < REP8; ++rep_) { fg::DenseP<fg::EpiCL> p{(const char*)HB, D, (const char*)Wc, D, {}, {RSTD2, CL, SSP}}; p.S.init(T, NCL, G, bx); fg::gemm_phase(lds, p); }
    SEAM(8);
    if (IN(9)) for (int rep_ = 0; rep_ < REP9; ++rep_) {
        { fg::DenseP<fg::EpiQ> p{(const char*)(CL + 320), NCL, (const char*)Wuq, QLR, {}, {SSP, QRAW, SSQ}}; p.S.init(T, 1536, G, bx); fg::gemm_phase(lds, p); }
        { fg::DenseP<fg::EpiKV> p{(const char*)CL, NCL, (const char*)Wukv, KVR, {}, {SSP, KN, VV, SSK}}; p.S.init(T, 2048, G, bx); fg::gemm_phase(lds, p); }
    }
    SEAM(9);
    if (IN(10)) for (int rep_ = 0; rep_ < REP10; ++rep_) th::kfin(KN, CL, SSK, SSP, a.in[16], (const float*)(ws + WS_CS), (unsigned char*)(ws + WS_KK), G, bx);
    SEAM(10);
    if (IN(11)) for (int rep_ = 0; rep_ < REP11; ++rep_) { const at::AttnArgs aa{QRAW, SSQ, a.in[21], (const float*)(ws + WS_CS), (const unsigned char*)(ws + WS_KK), VV, O}; at::attn_phase(lds, aa, G, bx); }
    SEAM(11);
    if (IN(12)) { fg::DenseP<fg::EpiRes> p{(const char*)O, D, (const char*)Wo, D, {}, {H, nullptr, H}}; p.S.init(T, D, G, bx); fg::gemm_phase(lds, p); }
    SEAM(12);
    if (IN(13)) th::route(lds, H, Wr + (size_t)D * NRT, a.in[25] + NG, a.in[27] + NE, XT, LIST, CNT + NE * 64, GATE, G, bx);
    SEAM(13);
    MOE_GEMMS(1, 14, 15);
    if (IN(16)) th::combine(H, YS, POS, GATE, nullptr, nullptr, G, bx);
#undef MOE_GEMMS
#undef IN
#undef SEAM
}

extern "C" void kernel_launch(void* const* d_in, const int* in_sizes, int n_in, void* d_out, int out_size, void* d_ws, size_t ws_size, hipStream_t stream) {
    if (n_in != 30 || ws_size < WS_END || out_size != T * D) { fprintf(stderr, "kernel_launch: unexpected shapes (n_in %d, ws %zu, out %d)\n", n_in, ws_size, out_size); return; }
    static int grid = 0;
    if (!grid) {
        (void)hipFuncSetAttribute((const void*)fwd, hipFuncAttributeMaxDynamicSharedMemorySize, LDS_BYTES);
        int dev = 0, cus = 0; (void)hipGetDevice(&dev); if (hipDeviceGetAttribute(&cus, hipDeviceAttributeMultiprocessorCount, dev) != hipSuccess || cus <= 0) cus = 256;
        grid = cus;
    }
    char* ws = (char*)d_ws;
    Args a{}; for (int i = 0; i < 30; ++i) a.in[i] = (const float*)d_in[i]; a.out = (float*)d_out; a.ws = (unsigned char*)d_ws;
    (void)hipMemsetAsync(ws + WS_CTL, 0, 1 * MiB, stream);
    a.ph_lo = 0; a.ph_hi = NPHASE;
    hipLaunchKernelGGL(fwd, dim3(grid), dim3(NWAVES * 64), LDS_BYTES, stream, a);
}
```

```cpp
#include <hip/hip_runtime.h>
#include <stdint.h>
#include <stdio.h>

typedef unsigned short bf16;
constexpr int NB = 4, SEQ = 8192, T = NB * SEQ, D = 1024, NH = 8, DQK = 192, DNOPE = 128, DROPE = 64, DV = 128, KVR = 256, QLR = 384;
constexpr int NE = 32, NG = 4, EPG = 8, DE = 512, CONVW = 31, NCL = 768, NRT = 36;
constexpr float EPS = 1e-6f;
constexpr float SM_SCALE = 0.07216878364870322f;

constexpr size_t MiB = 1u << 20;
constexpr size_t WS_CTL = 0, WS_W1T = 1 * MiB, WS_W2T = 5 * MiB, WS_WC = 7 * MiB, WS_WUKV = 9 * MiB, WS_WUQ = 10 * MiB, WS_WO = 12 * MiB, WS_WR = 14 * MiB,
                 WS_WGU = 16 * MiB, WS_WD = 144 * MiB, WS_RSTD0 = 208 * MiB, WS_RSTD = WS_RSTD0 + 256 * 1024, WS_RSTD2 = WS_RSTD0 + 512 * 1024,
                 WS_GATE = 209 * MiB, WS_LIST = 210 * MiB, WS_CS = 214 * MiB, WS_SSP = 222 * MiB, WS_SSQ = 226 * MiB, WS_SSK = 232 * MiB,
                 WS_R1 = 236 * MiB, WS_R2 = 300 * MiB, WS_R3 = 364 * MiB, WS_CL = 492 * MiB, WS_QRAW = 540 * MiB, WS_KK = 636 * MiB, WS_LISTR = 732 * MiB  , WS_ACTS = 748 * MiB  , WS_YS = 828 * MiB  ,  WS_END = 988 * MiB;

__device__ const float INV_FREQ[32] = {
    1.0f, 0.7498942093324559f, 0.5623413251903491f, 0.4216965034285822f, 0.31622776601683794f, 0.23713737056616552f, 0.1778279410038923f, 0.1333521432163324f,
    0.1f, 0.07498942093324558f, 0.05623413251903491f, 0.04216965034285822f, 0.03162277660168379f, 0.023713737056616554f, 0.01778279410038923f, 0.01333521432163324f,
    0.01f, 0.007498942093324558f, 0.005623413251903491f, 0.004216965034285823f, 0.0031622776601683794f, 0.0023713737056616554f, 0.001778279410038923f, 0.001333521432163324f,
    0.001f, 0.0007498942093324559f, 0.0005623413251903491f, 0.00042169650342858224f, 0.00031622776601683794f, 0.00023713737056616554f, 0.0001778279410038923f, 0.0001333521432163324f};

__device__ __forceinline__ float bf2f(bf16 b) { return __uint_as_float(((unsigned)b) << 16); }
__device__ __forceinline__ bf16 f2bf(float f) { unsigned u = __float_as_uint(f); u += 0x7fffu + ((u >> 16) & 1u); return (bf16)(u >> 16); }
__device__ __forceinline__ float wave_sum(float v) {
#pragma unroll
    for (int o = 1; o < 64; o <<= 1) v += __shfl_xor(v, o);
    return v;
}
__device__ __forceinline__ float sigmoidf_(float x) { return 1.0f / (1.0f + __expf(-x)); }
__device__ __forceinline__ float siluf_(float x) { return x / (1.0f + __expf(-x)); }
__host__ __device__ __forceinline__ int pair_row(int n, int half) { const int j = n % half, hf = n / half; return 256 * (j / 128) + 128 * hf + (j % 128); }

__device__ __forceinline__ void sincos_d(double a, double& s, double& c) {
    const double TWO_PI = 6.283185307179586476925287, PI = 3.14159265358979323846;
    double k = __builtin_rint(a / TWO_PI); double r = a - k * TWO_PI;
    double q = __builtin_rint(r / (PI * 0.5)); double y = r - q * (PI * 0.5); int qi = ((int)q) & 3;
    const double y2 = y * y;
    double sp = y * (1.0 + y2 * (-1.0 / 6 + y2 * (1.0 / 120 + y2 * (-1.0 / 5040 + y2 * (1.0 / 362880 + y2 * (-1.0 / 39916800 + y2 * (1.0 / 6227020800.0)))))));
    double cp = 1.0 + y2 * (-0.5 + y2 * (1.0 / 24 + y2 * (-1.0 / 720 + y2 * (1.0 / 40320 + y2 * (-1.0 / 3628800 + y2 * (1.0 / 479001600.0 + y2 * (-1.0 / 87178291200.0)))))));
    if (qi == 0) { s = sp; c = cp; } else if (qi == 1) { s = cp; c = -sp; } else if (qi == 2) { s = -sp; c = -cp; } else { s = -cp; c = sp; }
}

constexpr int NWAVES_ = 8;
#define LAS __attribute__((address_space(3)))
#define GAS __attribute__((address_space(1)))
typedef short bf16x8 __attribute__((ext_vector_type(8)));
typedef float f32x4 __attribute__((ext_vector_type(4)));
typedef float f32x2 __attribute__((ext_vector_type(2)));
typedef unsigned u32x4 __attribute__((ext_vector_type(4)));
typedef unsigned u32x2 __attribute__((ext_vector_type(2)));

__device__ __forceinline__ unsigned cvt_pk_bf16(float lo, float hi) { unsigned r; asm volatile("v_cvt_pk_bf16_f32 %0, %1, %2" : "=v"(r) : "v"(lo), "v"(hi)); return r; }
__device__ __forceinline__ float fast_sigmoid(float x) { return __builtin_amdgcn_rcpf(1.0f + __builtin_amdgcn_exp2f(-1.4426950408889634f * x)); }
__device__ __forceinline__ float fast_rsqrt(float x) { return 1.0f / sqrtf(x); }
__device__ __forceinline__ u32x2 pack_fp8x8(const float (&y)[8]) { int w0 = 0, w1 = 0; w0 = __builtin_amdgcn_cvt_pk_fp8_f32(y[0], y[1], w0, false); w0 = __builtin_amdgcn_cvt_pk_fp8_f32(y[2], y[3], w0, true);
    w1 = __builtin_amdgcn_cvt_pk_fp8_f32(y[4], y[5], w1, false); w1 = __builtin_amdgcn_cvt_pk_fp8_f32(y[6], y[7], w1, true); u32x2 r; r.x = (unsigned)w0; r.y = (unsigned)w1; return r; }

namespace fg {
constexpr int BM = 256, BK = 64, HALF = 128, HTB = HALF * BK * 2, STAGE_BYTES = 8 * HTB, NXCD = 8, WGM = 8;
__host__ __device__ __forceinline__ int lds_byte(int r, int c) { const int st = (r >> 4) * 2 + (c >> 5), rr = r & 15, cc = c & 31, ob = rr * 64 + cc * 2; return st * 1024 + (ob ^ (((ob >> 9) & 1) << 5)); }
__host__ __device__ __forceinline__ void stage_rc(int b, int& R, int& C) { const int st = b / 1024, sb = b % 1024, swz = sb ^ (((sb >> 9) & 1) << 5); R = (st >> 1) * 16 + swz / 64; C = (st & 1) * 32 + (swz % 64) / 2; }
__host__ __device__ __forceinline__ int perm32(int rho) { const int n = rho >> 4, i = rho & 15; return 8 * (i >> 2) + 4 * n + (i & 3); }
struct Unit { int pm, pn, e, nvalid, r; };
typedef f32x4 Acc[2][2][4][2];

struct StaticOrder {
    int nM, nN, nwg, G, c;
    __device__ void init(int M, int N, int G_, int c_) { nM = M / BM; nN = N / BM; nwg = nM * nN; G = G_; c = c_; }
    __device__ bool next(int i, Unit& u) const {
        const long L = (long)i * G + c; if (L >= nwg) return false;
        int wgid = (int)L; { const int q = nwg / NXCD, r = nwg % NXCD, xcd = wgid % NXCD, off = wgid / NXCD; wgid = (xcd < r ? xcd * (q + 1) : r * (q + 1) + (xcd - r) * q) + off; }
        const int nig = WGM * nN, gid = wgid / nig, fm = gid * WGM, gsz = (nM - fm) < WGM ? (nM - fm) : WGM;
        u.pm = fm + ((wgid % nig) % gsz); u.pn = (wgid % nig) / gsz; u.e = 0; u.nvalid = 256; u.r = u.pm; return true;
    }
};

template <class P>
__device__ __forceinline__ void gemm_phase(LAS unsigned char* lds, const P& p) {
    int tid_ = threadIdx.x; asm volatile("" : "+v"(tid_));
    const int tid = tid_, wid = __builtin_amdgcn_readfirstlane(tid >> 6), lane = tid & 63, wr = wid >> 2, wc = wid & 3, fr = lane & 15, fq = lane >> 4;
    const int K = p.K, nt = K / BK;
    int sR[2], sC[2]; unsigned voffB[2];
#pragma unroll
    for (int i = 0; i < 2; ++i) { int R, C; stage_rc(tid * 16 + i * 8192, R, C); sR[i] = R; sC[i] = C; const int Rb = P::PERM ? ((R & ~31) + perm32(R & 31)) : R; voffB[i] = (unsigned)(Rb * K + C) * 2u; }
    const size_t kstep = (size_t)(BK * 2), hstepB = (size_t)HALF * K * 2;
    const unsigned ldsw = (unsigned)wid * 1024u;
    const int aoff = lds_byte(wr * 64 + fr, fq * 8), boff = lds_byte(wc * 32 + fr, fq * 8);
#define FG_SA(b, h) (((b) * 2 + (h)) * HTB)
#define FG_SB(b, h) ((4 + (b) * 2 + (h)) * HTB)
#define FG_STAGE(bufoff, gbase, voff) do { _Pragma("unroll") for (int _i = 0; _i < 2; ++_i) \
        __builtin_amdgcn_global_load_lds((const unsigned*)((const char*)(gbase) + (voff)[_i]), (LAS unsigned*)(lds + (bufoff) + ldsw + _i * 8192), 16, 0, 0); } while (0)
#define FG_LDA(dst, b, h) do { _Pragma("unroll") for (int m = 0; m < 4; ++m) _Pragma("unroll") for (int k = 0; k < 2; ++k) dst[m][k] = *(const LAS bf16x8*)(lds + FG_SA(b, h) + aoff + m * 2048 + k * 1024); } while (0)
#define FG_LDB(dst, b, h) do { _Pragma("unroll") for (int n = 0; n < 2; ++n) _Pragma("unroll") for (int k = 0; k < 2; ++k) dst[n][k] = *(const LAS bf16x8*)(lds + FG_SB(b, h) + boff + n * 2048 + k * 1024); } while (0)
#define FG_MMA(ai, bj, At, Bt) do { __builtin_amdgcn_s_setprio(1); _Pragma("unroll") for (int m = 0; m < 4; ++m) _Pragma("unroll") for (int n = 0; n < 2; ++n) _Pragma("unroll") for (int k = 0; k < 2; ++k) \
        acc[ai][bj][m][n] = __builtin_amdgcn_mfma_f32_16x16x32_bf16(Bt[n][k], At[m][k], acc[ai][bj][m][n], 0, 0, 0); __builtin_amdgcn_s_setprio(0); } while (0)
#define FG_WAIT_V(n) asm volatile("s_waitcnt vmcnt(" #n ")" ::: "memory")
#define FG_WAIT_L(n) asm volatile("s_waitcnt lgkmcnt(" #n ")" ::: "memory")
#define FG_BAR __builtin_amdgcn_s_barrier()
#define FG_SCHED __builtin_amdgcn_sched_barrier(0)
    Unit cur, nxt, nn; int ui = 0;
    if (!p.next(0, cur)) return;
    unsigned ao[4], nao[4], nnao[4];
    p.a_off(cur, sR, sC, ao);
    bool has_next = p.next(1, nxt);
    if (has_next) p.a_off(nxt, sR, sC, nao); else { nxt = cur; _Pragma("unroll") for (int j = 0; j < 4; ++j) nao[j] = ao[j]; }
    Acc acc;
#pragma unroll
    for (int a = 0; a < 2; ++a)
#pragma unroll
        for (int b = 0; b < 2; ++b)
#pragma unroll
            for (int m = 0; m < 4; ++m)
#pragma unroll
                for (int n = 0; n < 2; ++n) acc[a][b][m][n] = (f32x4){0.f, 0.f, 0.f, 0.f};
    bf16x8 At[4][2], B0[2][2], B1[2][2];
    const char* const Ab = p.A;
    const char* cB = p.b_base(cur);
    FG_STAGE(FG_SB(0, 0), cB, voffB); FG_STAGE(FG_SB(0, 1), cB + hstepB, voffB); FG_STAGE(FG_SA(0, 0), Ab, ao); FG_STAGE(FG_SA(0, 1), Ab, ao + 2);
    if (wr == 1) FG_BAR;
    FG_WAIT_V(2); FG_BAR;
    FG_STAGE(FG_SB(1, 0), cB + kstep, voffB); FG_STAGE(FG_SA(1, 0), Ab + kstep, ao); FG_STAGE(FG_SB(1, 1), cB + hstepB + kstep, voffB);
    FG_WAIT_V(6); FG_BAR;
    for (;;) {
        const char* nB = has_next ? p.b_base(nxt) : cB;
        for (int t = 0; t < nt; t += 2) {
            const bool last = (t == nt - 2);
            const char* a1 = Ab + (size_t)(t + 1) * kstep;
            const char* a2 = last ? Ab : Ab + (size_t)(t + 2) * kstep; const char* b2 = last ? nB : cB + (size_t)(t + 2) * kstep;
            const char* a3 = a2 + kstep; const char* b3 = b2 + kstep;
            unsigned so[4];
#pragma unroll
            for (int j = 0; j < 4; ++j) so[j] = last ? nao[j] : ao[j];
            FG_LDB(B0, 0, 0); FG_LDB(B1, 0, 1); FG_SCHED; FG_LDA(At, 0, 0); FG_STAGE(FG_SA(1, 1), a1, ao + 2);
            FG_WAIT_V(8); FG_WAIT_L(0); FG_BAR; FG_MMA(0, 0, At, B0); FG_MMA(0, 1, At, B1); FG_BAR; FG_SCHED;
            FG_LDA(At, 0, 1); FG_STAGE(FG_SB(0, 0), b2, voffB); FG_STAGE(FG_SB(0, 1), b2 + hstepB, voffB); FG_STAGE(FG_SA(0, 0), a2, so);
            FG_WAIT_V(8); FG_WAIT_L(0); FG_BAR; if (cur.nvalid > HALF) { FG_MMA(1, 0, At, B0); FG_MMA(1, 1, At, B1); } FG_BAR; FG_SCHED;
            FG_LDB(B0, 1, 0); FG_LDB(B1, 1, 1); FG_SCHED; FG_LDA(At, 1, 0); FG_STAGE(FG_SA(0, 1), a2, so + 2);
            FG_WAIT_V(8); FG_WAIT_L(0); FG_BAR; FG_MMA(0, 0, At, B0); FG_MMA(0, 1, At, B1); FG_BAR; FG_SCHED;
            FG_LDA(At, 1, 1); FG_STAGE(FG_SB(1, 0), b3, voffB); FG_STAGE(FG_SB(1, 1), b3 + hstepB, voffB); FG_STAGE(FG_SA(1, 0), a3, so);
            FG_WAIT_V(8); FG_WAIT_L(0); FG_BAR; if (cur.nvalid > HALF) { FG_MMA(1, 0, At, B0); FG_MMA(1, 1, At, B1); } FG_BAR; FG_SCHED;
        }
        if (wr == 0) FG_BAR;
        const bool has_nn = has_next && p.next(ui + 2, nn);
        if (has_nn) p.a_off(nn, sR, sC, nnao); else { nn = nxt; _Pragma("unroll") for (int j = 0; j < 4; ++j) nnao[j] = nao[j]; }
        p.epi(acc, cur, wr, wc, fr, fq);
        if (!has_next) break;
#pragma unroll
        for (int a = 0; a < 2; ++a)
#pragma unroll
            for (int b = 0; b < 2; ++b)
#pragma unroll
                for (int m = 0; m < 4; ++m)
#pragma unroll
                    for (int n = 0; n < 2; ++n) acc[a][b][m][n] = (f32x4){0.f, 0.f, 0.f, 0.f};
        cur = nxt; cB = nB; nxt = nn; has_next = has_nn; ++ui;
#pragma unroll
        for (int j = 0; j < 4; ++j) { ao[j] = nao[j]; nao[j] = nnao[j]; }
        if (wr == 1) FG_BAR;
    }
    FG_WAIT_V(0);
    FG_BAR;
#undef FG_SA
#undef FG_SB
#undef FG_STAGE
#undef FG_LDA
#undef FG_LDB
#undef FG_MMA
#undef FG_WAIT_V
#undef FG_WAIT_L
#undef FG_BAR
#undef FG_SCHED
}

template <class Epi> struct DenseP {
    static constexpr bool PERM = Epi::PERM;
    const char* A; int lda; const char* Bt; int K; StaticOrder S; Epi E;
    __device__ __forceinline__ bool next(int i, Unit& u) const { return S.next(i, u); }
    __device__ __forceinline__ const char* b_base(const Unit& u) const { return Bt + (size_t)u.pn * BM * K * 2; }
    __device__ __forceinline__ void a_off(const Unit& u, const int (&sR)[2], const int (&sC)[2], unsigned (&ao)[4]) const {
#pragma unroll
        for (int h = 0; h < 2; ++h)
#pragma unroll
            for (int i = 0; i < 2; ++i) ao[h * 2 + i] = (unsigned)((u.pm * BM + h * HALF + sR[i]) * lda + sC[i]) * 2u;
    }
    __device__ __forceinline__ void epi(const Acc& acc, const Unit& u, int wr, int wc, int fr, int fq) const { E(acc, u, wr, wc, fr, fq); }
};

struct EpiGlu {
    static constexpr bool PERM = true;
    const float* rstd; const float* bias; bf16* U;
    __device__ __forceinline__ void operator()(const Acc& acc, const Unit& u, int wr, int wc, int fr, int fq) const {
        const int col = u.pn * 128 + wc * 32 + fq * 8, row0 = u.pm * BM + wr * 64 + fr;
        const f32x4 ba0 = *(const f32x4*)(bias + col), ba1 = *(const f32x4*)(bias + col + 4), bg0 = *(const f32x4*)(bias + 1024 + col), bg1 = *(const f32x4*)(bias + 1024 + col + 4);
        float rsv[8];
#pragma unroll
        for (int q = 0; q < 8; ++q) rsv[q] = rstd[row0 + (q >> 2) * HALF + (q & 3) * 16];
#pragma unroll
        for (int ai = 0; ai < 2; ++ai)
#pragma unroll
            for (int m = 0; m < 4; ++m) { const int row = row0 + ai * HALF + m * 16; const float rs = rsv[ai * 4 + m];
                const f32x4 a0 = acc[ai][0][m][0] * rs + ba0, a1 = acc[ai][0][m][1] * rs + ba1, g0 = acc[ai][1][m][0] * rs + bg0, g1 = acc[ai][1][m][1] * rs + bg1;
                float o[8];
#pragma unroll
                for (int j = 0; j < 4; ++j) { o[j] = a0[j] * fast_sigmoid(g0[j]); o[4 + j] = a1[j] * fast_sigmoid(g1[j]); }
                u32x4 w; w.x = cvt_pk_bf16(o[0], o[1]); w.y = cvt_pk_bf16(o[2], o[3]); w.z = cvt_pk_bf16(o[4], o[5]); w.w = cvt_pk_bf16(o[6], o[7]);
                *(u32x4*)(U + (size_t)row * D + col) = w; }
    }
};
__device__ __forceinline__ u32x4 pack8(const f32x4 a, const f32x4 b);
template <bool BF16BASE> struct EpiRes {
    static constexpr bool PERM = true;
    const void* base; const float* bias; bf16* out;
    __device__ __forceinline__ void operator()(const Acc& acc, const Unit& u, int wr, int wc, int fr, int fq) const {
        const int row0 = u.pm * BM + wr * 64 + fr, col0 = u.pn * BM + wc * 32 + 8 * fq;
        f32x4 bv[2][2];
#pragma unroll
        for (int bj = 0; bj < 2; ++bj)
#pragma unroll
            for (int n = 0; n < 2; ++n) bv[bj][n] = bias ? *(const f32x4*)(bias + col0 + bj * HALF + 4 * n) : (f32x4){0.f, 0.f, 0.f, 0.f};
#pragma unroll
        for (int ai = 0; ai < 2; ++ai) {
            f32x4 bs[4][2][2];
#pragma unroll
            for (int m = 0; m < 4; ++m) { const size_t off = (size_t)(row0 + ai * HALF + m * 16) * D + col0;
#pragma unroll
                for (int bj = 0; bj < 2; ++bj) {
                    if constexpr (BF16BASE) { const u32x4 w = *(const u32x4*)((const bf16*)base + off + bj * HALF);
                        bs[m][bj][0] = (f32x4){__uint_as_float(w.x << 16), __uint_as_float(w.x & 0xffff0000u), __uint_as_float(w.y << 16), __uint_as_float(w.y & 0xffff0000u)};
                        bs[m][bj][1] = (f32x4){__uint_as_float(w.z << 16), __uint_as_float(w.z & 0xffff0000u), __uint_as_float(w.w << 16), __uint_as_float(w.w & 0xffff0000u)}; }
                    else { bs[m][bj][0] = *(const f32x4*)((const float*)base + off + bj * HALF); bs[m][bj][1] = *(const f32x4*)((const float*)base + off + bj * HALF + 4); } } }
            asm volatile("" ::: "memory");
#pragma unroll
            for (int m = 0; m < 4; ++m) { const size_t off = (size_t)(row0 + ai * HALF + m * 16) * D + col0;
#pragma unroll
                for (int bj = 0; bj < 2; ++bj) *(u32x4*)(out + off + bj * HALF) = pack8(bs[m][bj][0] + acc[ai][bj][m][0] + bv[bj][0], bs[m][bj][1] + acc[ai][bj][m][1] + bv[bj][1]); }
            asm volatile("" ::: "memory");
        }
    }
};
__device__ __forceinline__ float quad_sum(float s) { s += __shfl_xor(s, 16); s += __shfl_xor(s, 32); return s; }
__device__ __forceinline__ u32x4 pack8(const f32x4 a, const f32x4 b) { u32x4 w; w.x = cvt_pk_bf16(a[0], a[1]); w.y = cvt_pk_bf16(a[2], a[3]); w.z = cvt_pk_bf16(b[0], b[1]); w.w = cvt_pk_bf16(b[2], b[3]); return w; }
__device__ __forceinline__ float sumsq8(const f32x4 a, const f32x4 b) { return (a[0] * a[0] + a[1] * a[1]) + (a[2] * a[2] + a[3] * a[3]) + (b[0] * b[0] + b[1] * b[1]) + (b[2] * b[2] + b[3] * b[3]); }
struct EpiCL {
    static constexpr bool PERM = true;
    const float* rstd2; bf16* CL; float* SSP;
    __device__ __forceinline__ void operator()(const Acc& acc, const Unit& u, int wr, int wc, int fr, int fq) const {
        const int row0 = u.pm * BM + wr * 64 + fr;
        float rsv[8];
#pragma unroll
        for (int q = 0; q < 8; ++q) rsv[q] = rstd2[row0 + (q >> 2) * HALF + (q & 3) * 16];
#pragma unroll
        for (int ai = 0; ai < 2; ++ai)
#pragma unroll
            for (int m = 0; m < 4; ++m) { const int row = row0 + ai * HALF + m * 16; const float rs = rsv[ai * 4 + m];
#pragma unroll
                for (int bj = 0; bj < 2; ++bj) { const f32x4 v0 = acc[ai][bj][m][0] * rs, v1 = acc[ai][bj][m][1] * rs; const float ss = quad_sum(sumsq8(v0, v1));
                    *(u32x4*)(CL + (size_t)row * NCL + u.pn * BM + bj * HALF + wc * 32 + fq * 8) = pack8(v0, v1);
                    const int g = u.pn * 8 + bj * 4 + wc; if (fq == 0) SSP[row * 32 + (g < 10 ? g : g + 2)] = ss; } }
    }
};
struct EpiQ {
    static constexpr bool PERM = true;
    const float* SSP; bf16* QRAW; float* SSQ;
    __device__ __forceinline__ void operator()(const Acc& acc, const Unit& u, int wr, int wc, int fr, int fq) const {
        const int row0 = u.pm * BM + wr * 64 + fr;
        float rsv[8];
#pragma unroll
        for (int q = 0; q < 8; ++q) { const int row = row0 + (q >> 2) * HALF + (q & 3) * 16;
            const f32x4 s0 = *(const f32x4*)(SSP + row * 32 + 12), s1 = *(const f32x4*)(SSP + row * 32 + 16), s2 = *(const f32x4*)(SSP + row * 32 + 20);
            rsv[q] = ((s0[0] + s0[1]) + (s0[2] + s0[3])) + ((s1[0] + s1[1]) + (s1[2] + s1[3])) + ((s2[0] + s2[1]) + (s2[2] + s2[3]));
            if (q == 3) asm volatile("" : "+v"(rsv[0]), "+v"(rsv[1]), "+v"(rsv[2]), "+v"(rsv[3]) :: "memory"); }
#pragma unroll
        for (int q = 0; q < 8; ++q) rsv[q] = fast_rsqrt(rsv[q] * (1.0f / QLR) + EPS);
#pragma unroll
        for (int ai = 0; ai < 2; ++ai)
#pragma unroll
            for (int m = 0; m < 4; ++m) { const int row = row0 + ai * HALF + m * 16; const float rs = rsv[ai * 4 + m];
#pragma unroll
                for (int bj = 0; bj < 2; ++bj) { const f32x4 v0 = acc[ai][bj][m][0] * rs, v1 = acc[ai][bj][m][1] * rs; const float ss = quad_sum(sumsq8(v0, v1));
                    *(u32x4*)(QRAW + (size_t)row * 1536 + u.pn * BM + bj * HALF + wc * 32 + fq * 8) = pack8(v0, v1);
                    if (fq == 0) SSQ[row * 48 + u.pn * 8 + bj * 4 + wc] = ss; } }
    }
};
struct EpiKV {
    static constexpr bool PERM = true;
    const float* SSP; bf16* KN; bf16* VV; float* SSK;
    __device__ __forceinline__ void operator()(const Acc& acc, const Unit& u, int wr, int wc, int fr, int fq) const {
        const int row0 = u.pm * BM + wr * 64 + fr;
        float rsv[8];
#pragma unroll
        for (int q = 0; q < 8; ++q) { const int row = row0 + (q >> 2) * HALF + (q & 3) * 16;
            const f32x4 s0 = *(const f32x4*)(SSP + row * 32), s1 = *(const f32x4*)(SSP + row * 32 + 4);
            rsv[q] = ((s0[0] + s0[1]) + (s0[2] + s0[3])) + ((s1[0] + s1[1]) + (s1[2] + s1[3])); }
#pragma unroll
        for (int q = 0; q < 8; ++q) rsv[q] = fast_rsqrt(rsv[q] * (1.0f / KVR) + EPS);
#pragma unroll
        for (int ai = 0; ai < 2; ++ai)
#pragma unroll
            for (int m = 0; m < 4; ++m) { const int row = row0 + ai * HALF + m * 16; const float rs = rsv[ai * 4 + m];
                { const f32x4 v0 = acc[ai][0][m][0] * rs, v1 = acc[ai][0][m][1] * rs; const float ss = quad_sum(sumsq8(v0, v1));
                  *(u32x4*)(KN + (size_t)row * D + u.pn * 128 + wc * 32 + fq * 8) = pack8(v0, v1);
                  if (fq == 0) SSK[row * 32 + u.pn * 4 + wc] = ss; }
                { const f32x4 v0 = acc[ai][1][m][0] * rs, v1 = acc[ai][1][m][1] * rs; const int b = row / SEQ, sq = row % SEQ;
                  *(u32x4*)(VV + (((size_t)b * NH + u.pn) * SEQ + sq) * DV + wc * 32 + fq * 8) = pack8(v0, v1); } }
    }
};

__device__ __forceinline__ void moe_setup(const int* CNT, LAS int* pref, LAS int* cnts) {
    const int tid = threadIdx.x; LAS int* spre = pref + 40;
    if (tid < 64) { const int c = tid < 32 ? (int)__hip_atomic_load((const unsigned*)CNT + tid * 64, __ATOMIC_RELAXED, __HIP_MEMORY_SCOPE_AGENT) : 0;
        const int nt = (c + 255) >> 8, rem = c - ((nt - 1) << 8), sm = (nt > 0 && rem <= 128) ? 1 : 0; int ib = nt - sm, is = sm;
#pragma unroll
        for (int o = 1; o < 32; o <<= 1) { const int v = __shfl_up(ib, o), w = __shfl_up(is, o); if (tid >= o) { ib += v; is += w; } }
        if (tid < 32) { pref[tid + 1] = ib; spre[tid + 1] = is; cnts[tid] = c; } if (tid == 0) { pref[0] = 0; spre[0] = 0; } }
    __syncthreads();
}
template <class Epi, bool GATHER> struct MoeP {
    static constexpr bool PERM = true;
    const char* A; int lda; int a_shift; const char* Bt; size_t b_estride; int K; const int4* LIST; const LAS int* pref; const LAS int* cnts; int G, c, nunits; Epi E;
    __device__ __forceinline__ bool next(int i, Unit& u) const {
        const int L = i * G + c; if (L >= nunits) return false;
        const int r = L >> 2, lane = threadIdx.x & 63; const LAS int* spre = pref + 40; const int nbig = __builtin_amdgcn_readfirstlane(pref[32]);
        int e, pm;
        if (r < nbig) { const int v = pref[(lane & 31) + 1]; e = __builtin_popcountll(__ballot(lane < 32 && r >= v)); pm = r - __builtin_amdgcn_readfirstlane(pref[e]); }
        else { const int q = r - nbig; const int v = spre[(lane & 31) + 1]; e = __builtin_popcountll(__ballot(lane < 32 && q >= v)); pm = ((__builtin_amdgcn_readfirstlane(cnts[e]) + 255) >> 8) - 1; }
        u.pn = L & 3; u.e = e; u.r = r; u.pm = pm; const int rem = __builtin_amdgcn_readfirstlane(cnts[e]) - BM * pm; u.nvalid = rem < BM ? rem : BM; return true;
    }
    __device__ __forceinline__ const char* b_base(const Unit& u) const { return Bt + (size_t)u.e * b_estride + (size_t)u.pn * BM * K * 2; }
    __device__ __forceinline__ void a_off(const Unit& u, const int (&sR)[2], const int (&sC)[2], unsigned (&ao)[4]) const {
        if constexpr (GATHER) {
            const int4* lp = LIST + (size_t)u.e * T + u.pm * BM;
#pragma unroll
            for (int h = 0; h < 2; ++h)
#pragma unroll
                for (int i = 0; i < 2; ++i) { const int row = h * HALF + sR[i]; int ent = lp[row].x; ent = row < u.nvalid ? ent : 0; ao[h * 2 + i] = (unsigned)((ent >> a_shift) * lda + sC[i]) * 2u; }
        } else {
#pragma unroll
            for (int h = 0; h < 2; ++h)
#pragma unroll
                for (int i = 0; i < 2; ++i) ao[h * 2 + i] = (unsigned)((u.r * BM + h * HALF + sR[i]) * lda + sC[i]) * 2u;
        }
    }
    __device__ __forceinline__ void epi(const Acc& acc, const Unit& u, int wr, int wc, int fr, int fq) const { E(acc, u, wr, wc, fr, fq, LIST + (size_t)u.e * T + u.pm * BM); }
};
struct EpiSwiglu {
    bf16* ACTS; int* POS;
    __device__ __forceinline__ void operator()(const Acc& acc, const Unit& u, int wr, int wc, int fr, int fq, const int4* lp) const {
        int4 rec[8];
#pragma unroll
        for (int q = 0; q < 8; ++q) { const int row = (q >> 2) * HALF + wr * 64 + (q & 3) * 16 + fr; rec[q] = lp[row]; }
#pragma unroll
        for (int ai = 0; ai < 2; ++ai)
#pragma unroll
            for (int m = 0; m < 4; ++m) { const int q = ai * 4 + m, row = ai * HALF + wr * 64 + m * 16 + fr; const float rs = __int_as_float(rec[q].y);
                const f32x4 a0 = acc[ai][0][m][0] * rs, a1 = acc[ai][0][m][1] * rs, b0 = acc[ai][1][m][0] * rs, b1 = acc[ai][1][m][1] * rs;
                float o[8];
#pragma unroll
                for (int j = 0; j < 4; ++j) { o[j] = a0[j] * fast_sigmoid(a0[j]) * b0[j]; o[4 + j] = a1[j] * fast_sigmoid(a1[j]) * b1[j]; }
                u32x4 w; w.x = cvt_pk_bf16(o[0], o[1]); w.y = cvt_pk_bf16(o[2], o[3]); w.z = cvt_pk_bf16(o[4], o[5]); w.w = cvt_pk_bf16(o[6], o[7]);
                *(u32x4*)(ACTS + (size_t)(u.r * BM + row) * DE + u.pn * 128 + wc * 32 + fq * 8) = w;
                if (u.pn == 0 && wc == 0 && fq == 0 && row < u.nvalid) POS[rec[q].x] = u.r * BM + row; }
    }
};
struct EpiDown {
    bf16* YS;
    __device__ __forceinline__ void operator()(const Acc& acc, const Unit& u, int wr, int wc, int fr, int fq, const int4*) const {
#pragma unroll
        for (int ai = 0; ai < 2; ++ai)
#pragma unroll
            for (int m = 0; m < 4; ++m) { const int row = ai * HALF + wr * 64 + m * 16 + fr;
#pragma unroll
                for (int bj = 0; bj < 2; ++bj) *(u32x4*)(YS + (size_t)(u.r * BM + row) * D + u.pn * BM + bj * HALF + wc * 32 + fq * 8) = pack8(acc[ai][bj][m][0], acc[ai][bj][m][1]); }
    }
};
}


namespace at {
typedef short s16x4 __attribute__((ext_vector_type(4)));
typedef float f32x16 __attribute__((ext_vector_type(16)));
constexpr int KTB = 64 * 192  , VTB = 64 * 256, LDS_K = 0, LDS_V = 2 * KTB, LDS_AL = LDS_V + 2 * VTB, LDS_TOTAL = LDS_AL + 8 * 256;
constexpr float SC2 = SM_SCALE * 1.4426950408889634f;
constexpr float THR2 = 11.0f / SC2;
__device__ __forceinline__ int v_rd_base(int lane) { return ((lane & 3) << 3) | (((lane >> 2) & 3) << 6) | (((lane >> 4) & 1) << 5) | (((lane >> 5) & 1) << 8); }
constexpr int v_rd_off(int d0, int ks, int half) { return d0 * 512 + ks * 4096 + half * 2048; }
__device__ __forceinline__ int crow(int r, int hi) { return (r & 3) + 8 * (r >> 2) + 4 * hi; }
#define AT_SBAR() __builtin_amdgcn_sched_barrier(0)

template <int BUF>
__device__ __forceinline__ void tile_compute(f32x16 (&o)[4], const long (&qr)[12], float& m_run, float& l_run, const LAS char* kl,
                                             int vb0, LAS float* al_l, int r32, int hi) {
    f32x16 p0 = {}, p1 = {};
#define AT_LOADB(kf, s_) do { kf[0] = *(const LAS long*)(kl + (s_) * 1024 + BUF * KTB); kf[1] = *(const LAS long*)(kl + (s_) * 1024 + 256 + BUF * KTB); } while (0)
#define AT_MMAB(kf, s_) do { __builtin_amdgcn_s_setprio(1); p0 = __builtin_amdgcn_mfma_f32_32x32x16_fp8_fp8(kf[0], qr[s_], p0, 0, 0, 0); p1 = __builtin_amdgcn_mfma_f32_32x32x16_fp8_fp8(kf[1], qr[s_], p1, 0, 0, 0); __builtin_amdgcn_s_setprio(0); } while (0)
    { long kfA[2], kfB[2], kfC[2], kfD[2];
      AT_LOADB(kfA, 0); AT_LOADB(kfB, 1); AT_LOADB(kfC, 2); AT_LOADB(kfD, 3); AT_SBAR();
      AT_MMAB(kfA, 0); AT_SBAR(); AT_LOADB(kfA, 4); AT_SBAR(); AT_MMAB(kfB, 1); AT_SBAR(); AT_LOADB(kfB, 5); AT_SBAR(); AT_MMAB(kfC, 2); AT_SBAR(); AT_LOADB(kfC, 6); AT_SBAR(); AT_MMAB(kfD, 3); AT_SBAR(); AT_LOADB(kfD, 7); AT_SBAR();
      AT_MMAB(kfA, 4); AT_SBAR(); AT_LOADB(kfA, 8); AT_SBAR(); AT_MMAB(kfB, 5); AT_SBAR(); AT_LOADB(kfB, 9); AT_SBAR(); AT_MMAB(kfC, 6); AT_SBAR(); AT_LOADB(kfC, 10); AT_SBAR(); AT_MMAB(kfD, 7); AT_SBAR(); AT_LOADB(kfD, 11); AT_SBAR();
      AT_MMAB(kfA, 8); AT_SBAR(); AT_MMAB(kfB, 9); AT_SBAR(); AT_MMAB(kfC, 10); AT_SBAR(); AT_MMAB(kfD, 11); AT_SBAR(); }
#undef AT_LOADB
#undef AT_MMAB
#define AT_TRRD(dst, off) asm volatile("ds_read_b64_tr_b16 %0, %1 offset:%2" : "=&v"(dst) : "v"(vb0), "i"(off) : "memory")
#define AT_VRD(X, d0) do { constexpr int b_ = BUF * VTB + v_rd_off(d0, 0, 0); \
        AT_TRRD(l##X##0, b_); AT_TRRD(h##X##0, b_ + 2048); AT_TRRD(l##X##1, b_ + 4096); AT_TRRD(h##X##1, b_ + 6144); AT_TRRD(l##X##2, b_ + 8192); AT_TRRD(h##X##2, b_ + 10240); AT_TRRD(l##X##3, b_ + 12288); AT_TRRD(h##X##3, b_ + 14336); } while (0)
#define AT_WAITL(n) do { asm volatile("s_waitcnt lgkmcnt(" #n ")" ::: "memory"); AT_SBAR(); } while (0)
#define AT_PVM(X, d0) do { \
        o[d0] = __builtin_amdgcn_mfma_f32_32x32x16_bf16(pa0, (bf16x8){l##X##0[0], l##X##0[1], l##X##0[2], l##X##0[3], h##X##0[0], h##X##0[1], h##X##0[2], h##X##0[3]}, o[d0], 0, 0, 0); \
        o[d0] = __builtin_amdgcn_mfma_f32_32x32x16_bf16(pa1, (bf16x8){l##X##1[0], l##X##1[1], l##X##1[2], l##X##1[3], h##X##1[0], h##X##1[1], h##X##1[2], h##X##1[3]}, o[d0], 0, 0, 0); \
        o[d0] = __builtin_amdgcn_mfma_f32_32x32x16_bf16(pa2, (bf16x8){l##X##2[0], l##X##2[1], l##X##2[2], l##X##2[3], h##X##2[0], h##X##2[1], h##X##2[2], h##X##2[3]}, o[d0], 0, 0, 0); \
        o[d0] = __builtin_amdgcn_mfma_f32_32x32x16_bf16(pa3, (bf16x8){l##X##3[0], l##X##3[1], l##X##3[2], l##X##3[3], h##X##3[0], h##X##3[1], h##X##3[2], h##X##3[3]}, o[d0], 0, 0, 0); } while (0)
    s16x4 lA0, lA1, lA2, lA3, hA0, hA1, hA2, hA3, lB0, lB1, lB2, lB3, hB0, hB1, hB2, hB3;
    AT_VRD(A, 0); AT_VRD(B, 1); AT_SBAR();
    float pmax = p0[0];
#pragma unroll
    for (int r = 1; r < 16; ++r) pmax = fmaxf(pmax, p0[r]);
#pragma unroll
    for (int r = 0; r < 16; ++r) pmax = fmaxf(pmax, p1[r]);
    { auto rr = __builtin_amdgcn_permlane32_swap(__float_as_uint(pmax), __float_as_uint(pmax), false, false); pmax = fmaxf(__uint_as_float(rr[0]), __uint_as_float(rr[1])); }
    float alpha = 1.f;
    if (!__all(pmax - m_run <= THR2)) { const float mn = fmaxf(m_run, pmax); alpha = __builtin_amdgcn_exp2f((m_run - mn) * SC2); m_run = mn; }
    const float mneg = -m_run * SC2;
#pragma unroll
    for (int r = 0; r < 16; ++r) { p0[r] = __builtin_amdgcn_exp2f(fmaf(p0[r], SC2, mneg)); p1[r] = __builtin_amdgcn_exp2f(fmaf(p1[r], SC2, mneg)); }
    float ps = 0.f;
#pragma unroll
    for (int r = 0; r < 16; ++r) ps += p0[r];
#pragma unroll
    for (int r = 0; r < 16; ++r) ps += p1[r];
    { auto rr = __builtin_amdgcn_permlane32_swap(__float_as_uint(ps), __float_as_uint(ps), false, false); ps = __uint_as_float(rr[0]) + __uint_as_float(rr[1]); }
    l_run = l_run * alpha + ps;
    bf16x8 pa0, pa1, pa2, pa3;
#define AT_PK4(P, B_, OUT) do { unsigned a0 = cvt_pk_bf16(P[B_+0], P[B_+1]), a1 = cvt_pk_bf16(P[B_+2], P[B_+3]); \
        unsigned b0 = cvt_pk_bf16(P[B_+4], P[B_+5]), b1 = cvt_pk_bf16(P[B_+6], P[B_+7]); \
        auto r0 = __builtin_amdgcn_permlane32_swap(a0, b0, false, false); auto r1 = __builtin_amdgcn_permlane32_swap(a1, b1, false, false); \
        u32x4 w = {r0[0], r1[0], r0[1], r1[1]}; OUT = *reinterpret_cast<bf16x8*>(&w); } while (0)
    AT_PK4(p0, 0, pa0); AT_PK4(p0, 8, pa1); AT_PK4(p1, 0, pa2); AT_PK4(p1, 8, pa3);
#undef AT_PK4
    if (__any(alpha < 1.f)) { if (hi == 0) al_l[r32] = alpha; asm volatile("s_waitcnt lgkmcnt(0)" ::: "memory");
#pragma unroll
        for (int d_ = 0; d_ < 4; ++d_)
#pragma unroll
            for (int r = 0; r < 16; ++r) o[d_][r] *= al_l[crow(r, hi)]; }
    AT_SBAR();
    AT_WAITL(8); AT_PVM(A, 0); AT_SBAR(); AT_VRD(A, 2);
    AT_WAITL(8); AT_PVM(B, 1); AT_SBAR(); AT_VRD(B, 3);
    AT_WAITL(8); AT_PVM(A, 2); AT_SBAR();
    AT_WAITL(0); AT_PVM(B, 3); AT_SBAR();
#undef AT_TRRD
#undef AT_VRD
#undef AT_WAITL
#undef AT_PVM
}

struct AttnArgs { const bf16* QRAW; const float* SSQ; const float* qg; const float* CS; const unsigned char* KK8; const bf16* VV; bf16* O; };

__device__ __forceinline__ void attn_phase(LAS unsigned char* lds, const AttnArgs& A, int G, int bx) {
    int tid_ = threadIdx.x; asm volatile("" : "+v"(tid_));
    const int tid = tid_, wid = __builtin_amdgcn_readfirstlane(tid >> 6), lane = tid & 63, r32 = lane & 31, hi = lane >> 5;
    const unsigned voffK = (unsigned)lane * 16u;
    unsigned voffV; { const int ob = (wid * 2 * 64 + lane) * 16, sub = ob >> 9, within = ob & 511, kk = (sub >> 2) * 8 + (within >> 6), cc = (sub & 3) * 32 + ((within & 63) >> 1);
        const int k = (kk & ~0xC) | ((kk & 4) << 1) | ((kk & 8) >> 1); voffV = (unsigned)(k * 256 + cc * 2); }
    const __amdgpu_buffer_rsrc_t rsK = __builtin_amdgcn_make_buffer_rsrc((void*)A.KK8, 0, NB * NH * (SEQ / 64) * KTB, 0x00020000), rsV = __builtin_amdgcn_make_buffer_rsrc((void*)A.VV, 0, T * NH * DV * 2, 0x00020000);
    const LAS char* kl = (const LAS char*)lds + LDS_K + hi * 512 + r32 * 8;
    const int vb0 = LDS_V + v_rd_base(lane);
    LAS float* al_l = (LAS float*)(lds + LDS_AL) + wid * 64; LAS float* li_l = al_l + 32;
    const int vcu = (G % 8 == 0) ? (bx % 8) * (G / 8) + bx / 8 : bx;
#define AT_ISSUE(t, buf) do { const int ks_ = kbase + (t) * KTB, vs_ = vbase + (t) * VTB; \
        __builtin_amdgcn_raw_ptr_buffer_load_lds(rsK, (LAS void*)(lds + LDS_K + (buf) * KTB + wid * 1024), 16, voffK, ks_ + wid * 1024, 0, 0); \
        if (wid < 4) __builtin_amdgcn_raw_ptr_buffer_load_lds(rsK, (LAS void*)(lds + LDS_K + (buf) * KTB + (wid + 8) * 1024), 16, voffK, ks_ + (wid + 8) * 1024, 0, 0); \
        _Pragma("unroll") for (int i_ = 0; i_ < 2; ++i_) __builtin_amdgcn_raw_ptr_buffer_load_lds(rsV, (LAS void*)(lds + LDS_V + (buf) * VTB + (wid * 2 + i_) * 1024), 16, voffV, vs_ + i_ * 128, 0, 0); } while (0)
    for (int item = vcu; item < NB * NH * 16; item += G) {
        const int bh = item >> 4, pr = item & 15, b = bh / NH, h = bh % NH;
        const int kbase = bh * ((SEQ / 64) * KTB), vbase = bh * (SEQ * DV * 2);
        for (int pass = 0; pass < 2; ++pass) {
            const int qb = pass == 0 ? 31 - pr : pr, NT = 4 * (qb + 1), myNT = 4 * qb + (wid >> 1) + 1;
            AT_ISSUE(0, 0);
            long qr[12];
            { const int t = b * SEQ + qb * 256 + wid * 32 + r32; const bf16* qp = A.QRAW + (size_t)t * 1536 + h * DQK + hi * 8;
              const f32x2* sq = (const f32x2*)(A.SSQ + (size_t)t * 48 + h * 6); const f32x2 s0 = sq[0], s1 = sq[1], s2 = sq[2];
              const float rq = fast_rsqrt(((s0[0] + s0[1]) + (s1[0] + s1[1]) + (s2[0] + s2[1])) * (1.0f / DQK) + EPS);
              float xt[4][8];
#pragma unroll
              for (int s = 0; s < 12; ++s) { const bf16x8 raw = *(const bf16x8*)(qp + s * 16); const f32x4 g0 = *(const f32x4*)(A.qg + s * 16 + hi * 8), g1 = *(const f32x4*)(A.qg + s * 16 + hi * 8 + 4);
                  float x[8];
#pragma unroll
                  for (int e = 0; e < 8; ++e) x[e] = __uint_as_float(((unsigned)(unsigned short)raw[e]) << 16) * (e < 4 ? g0[e] : g1[e - 4]) * rq;
                  if (s < 8) { const u32x2 w = pack_fp8x8(x); qr[s] = (long)(((unsigned long long)w.y << 32) | w.x); }
                  else {
#pragma unroll
                      for (int e = 0; e < 8; ++e) xt[s - 8][e] = x[e]; } }
#pragma unroll
              for (int s = 0; s < 2; ++s) { const float* cp = A.CS + (size_t)t * 64 + s * 16 + hi * 8;
                  const f32x4 c0 = *(const f32x4*)cp, c1 = *(const f32x4*)(cp + 4), n0 = *(const f32x4*)(cp + 32), n1 = *(const f32x4*)(cp + 36);
                  float y1[8], y2[8];
#pragma unroll
                  for (int e = 0; e < 8; ++e) { const float c = e < 4 ? c0[e] : c1[e - 4], sn = e < 4 ? n0[e] : n1[e - 4]; const float x1 = xt[s][e], x2 = xt[s + 2][e]; y1[e] = x1 * c - x2 * sn; y2[e] = x1 * sn + x2 * c; }
                  const u32x2 w = pack_fp8x8(y1), w2 = pack_fp8x8(y2);
                  qr[8 + s] = (long)(((unsigned long long)w.y << 32) | w.x); qr[10 + s] = (long)(((unsigned long long)w2.y << 32) | w2.x); } }
            float m_run = -1e30f, l_run = 0.f; f32x16 o[4] = {};
            for (int t = 0; t < NT; t += 2) {
                asm volatile("s_waitcnt vmcnt(0)" ::: "memory"); __builtin_amdgcn_s_barrier();
                AT_ISSUE(t + 1, 1);
                if (t < myNT) tile_compute<0>(o, qr, m_run, l_run, kl, vb0, al_l, r32, hi);
                asm volatile("s_waitcnt vmcnt(0)" ::: "memory"); __builtin_amdgcn_s_barrier();
                if (t + 2 < NT) AT_ISSUE(t + 2, 0);
                if (t + 1 < myNT) tile_compute<1>(o, qr, m_run, l_run, kl, vb0, al_l, r32, hi);
            }
            if (hi == 0) li_l[r32] = l_run; asm volatile("s_waitcnt lgkmcnt(0)" ::: "memory");
            bf16* Ow = A.O + (size_t)(b * SEQ + qb * 256 + wid * 32) * D + h * DV + (size_t)(4 * hi) * D + r32;
            asm volatile("" : "+v"(Ow));
#pragma unroll
            for (int r = 0; r < 16; ++r) { const int orow = crow(r, hi); const float rl = __builtin_amdgcn_rcpf(li_l[orow]);
#pragma unroll
                for (int d0 = 0; d0 < 4; ++d0) { const float v = o[d0][r] * rl; const float vn = __shfl_xor(v, 1);
                    if ((r32 & 1) == 0) *(unsigned*)(Ow + (size_t)((r & 3) + 8 * (r >> 2)) * D + d0 * 32) = cvt_pk_bf16(v, vn); } }
        }
    }
    asm volatile("s_waitcnt vmcnt(0)" ::: "memory"); __builtin_amdgcn_s_barrier();
#undef AT_ISSUE
}
#undef AT_SBAR
}


namespace th {
#define TH_LDS_WAIT() asm volatile("s_waitcnt lgkmcnt(0)" ::: "memory")
__device__ __forceinline__ void tr_item(const float* W, int K, int N, bf16* Wt, int row_off, const float* gain, int half, LAS float* scr, int item, int lane) {
    const int nblk = N / 32, kb = item / nblk, nb = item % nblk, k0 = 64 * kb, n0 = 32 * nb;
    const int kr = lane >> 3, c4 = (lane & 7) * 4;
    f32x4 v[8]; float g[8];
#pragma unroll
    for (int i = 0; i < 8; ++i) { v[i] = __builtin_nontemporal_load((const f32x4*)(W + (size_t)(k0 + 8 * i + kr) * N + n0 + c4)); g[i] = gain ? gain[k0 + 8 * i + kr] : 1.0f; }
#pragma unroll
    for (int i = 0; i < 8; ++i) { LAS float* d = scr + (8 * i + kr) * 33 + c4; d[0] = v[i][0] * g[i]; d[1] = v[i][1] * g[i]; d[2] = v[i][2] * g[i]; d[3] = v[i][3] * g[i]; }
    TH_LDS_WAIT(); asm volatile("" ::: "memory");
    const int c = lane & 7;
#pragma unroll
    for (int j = 0; j < 4; ++j) { const int n = (lane >> 3) + 8 * j; const LAS float* sp = scr + (8 * c) * 33 + n; const int nn = n0 + n, nr = half ? pair_row(nn, half) : nn;
        u32x4 o; o.x = cvt_pk_bf16(sp[0 * 33], sp[1 * 33]); o.y = cvt_pk_bf16(sp[2 * 33], sp[3 * 33]); o.z = cvt_pk_bf16(sp[4 * 33], sp[5 * 33]); o.w = cvt_pk_bf16(sp[6 * 33], sp[7 * 33]);
        *(u32x4*)(Wt + (size_t)(row_off + nr) * K + k0 + 8 * c) = o; }
    TH_LDS_WAIT(); asm volatile("" ::: "memory");
}
struct P0Args { const float* const* in; unsigned char* ws; };
__device__ __forceinline__ void prologue(LAS unsigned char* lds, const float* const (&in)[30], unsigned char* ws, int G, int bx) {
    const int tid = threadIdx.x, lane = tid & 63, wave = __builtin_amdgcn_readfirstlane(tid >> 6);
    LAS float* scr = (LAS float*)(lds + wave * 16384);
    const int gw = bx * NWAVES_ + wave, NGW = G * NWAVES_;
    bf16 *W1t = (bf16*)(ws + WS_W1T), *W2t = (bf16*)(ws + WS_W2T), *Wc = (bf16*)(ws + WS_WC), *Wukv = (bf16*)(ws + WS_WUKV), *Wuq = (bf16*)(ws + WS_WUQ), *Wo = (bf16*)(ws + WS_WO),
         *Wgu = (bf16*)(ws + WS_WGU), *Wd = (bf16*)(ws + WS_WD);
    constexpr int I_W1 = 16 * 64, I_W2 = 16 * 32, I_DKV = 16 * 8, I_KR = 16 * 2, I_DQ = 16 * 12, I_UKV = 4 * 64, I_UQ = 6 * 48, I_WO = 16 * 32, I_GU1 = 16 * 32, I_D1 = 8 * 32;
    constexpr int NIT = I_W1 + I_W2 + I_DKV + I_KR + I_DQ + I_UKV + I_UQ + I_WO + 64 * I_GU1 + 64 * I_D1;
    for (int it = gw; it < NIT; it += NGW) {
        int r = it;
        if (r < 64 * I_GU1) { const int e = r / I_GU1; tr_item(in[28] + (size_t)e * D * 1024, D, 1024, Wgu + (size_t)e * 1024 * D, 0, in[23] + (e / NE) * D, 512, scr, r % I_GU1, lane); continue; } r -= 64 * I_GU1;
        if (r < 64 * I_D1) { const int e = r / I_D1; tr_item(in[29] + (size_t)e * DE * D, DE, D, Wd + (size_t)e * D * DE, 0, nullptr, 0, scr, r % I_D1, lane); continue; } r -= 64 * I_D1;
        if (r < I_W1) { tr_item(in[3], D, 2048, W1t, 0, in[2], 1024, scr, r, lane); continue; } r -= I_W1;
        if (r < I_W2) { tr_item(in[9], D, D, W2t, 0, nullptr, 0, scr, r, lane); continue; } r -= I_W2;
        if (r < I_DKV) { tr_item(in[12], D, KVR, Wc, 0, in[11], 0, scr, r, lane); continue; } r -= I_DKV;
        if (r < I_KR) { tr_item(in[14], D, DROPE, Wc, 256, in[11], 0, scr, r, lane); continue; } r -= I_KR;
        if (r < I_DQ) { tr_item(in[18], D, QLR, Wc, 320, in[17], 0, scr, r, lane); continue; } r -= I_DQ;
        if (r < I_UKV) { tr_item(in[15], KVR, 2048, Wukv, 0, in[13], 0, scr, r, lane); continue; } r -= I_UKV;
        if (r < I_UQ) { tr_item(in[20], QLR, 1536, Wuq, 0, in[19], 0, scr, r, lane); continue; } r -= I_UQ;
        tr_item(in[22], D, D, Wo, 0, nullptr, 0, scr, r, lane);
    }
    const int gt = bx * (NWAVES_ * 64) + tid, NGT = G * NWAVES_ * 64;
    for (int i = gt; i < 64 * D / 8; i += NGT) ((u32x4*)(Wc + (size_t)704 * D))[i] = (u32x4){0u, 0u, 0u, 0u};
    { float* Wr = (float*)(ws + WS_WR);
      for (int i = gt; i < 2 * D * NRT; i += NGT) { const int c = i % NRT, k = (i / NRT) % D, l = i / (NRT * D);
          const float w = c < NG ? in[24][((size_t)l * D + k) * NG + c] : in[26][((size_t)l * D + k) * NE + (c - NG)];
          Wr[(size_t)l * D * NRT + ((((k >> 5) * 4 + ((k >> 3) & 3)) * NRT + c) * 8) + (k & 7)] = w * in[23][l * D + k]; } }
    { float* cs = (float*)(ws + WS_CS); const int* pos = (const int*)in[1];
      for (int i = gt; i < T * 32; i += NGT) { const int t = i >> 5, f = i & 31; const float ang = (float)pos[t] * INV_FREQ[f]; double sn, c; sincos_d((double)ang, sn, c); cs[(size_t)t * 64 + f] = (float)c; cs[(size_t)t * 64 + 32 + f] = (float)sn; } }
    { const float* x = in[0]; bf16* xb = (bf16*)(ws + WS_R1); float* rstd = (float*)(ws + WS_RSTD0);
      for (int row = gw; row < T; row += NGW) { const f32x4* xr = (const f32x4*)(x + (size_t)row * D); float ss = 0.f;
#pragma unroll
          for (int j = 0; j < 4; ++j) { const f32x4 v = xr[lane + 64 * j]; ss += (v[0] * v[0] + v[1] * v[1]) + (v[2] * v[2] + v[3] * v[3]);
              u32x2 o; o.x = cvt_pk_bf16(v[0], v[1]); o.y = cvt_pk_bf16(v[2], v[3]); ((u32x2*)(xb + (size_t)row * D))[lane + 64 * j] = o; }
          ss = wave_sum(ss); if (lane == 0) rstd[row] = fast_rsqrt(ss * (1.0f / D) + EPS); } }
}
__device__ __forceinline__ void conv_ln(LAS unsigned char* lds, const bf16* U, const float* dw_w, const float* dw_b, const float* ln_g, const float* ln_b, bf16* Vb, int G, int bx) {
    const int tid = threadIdx.x, lane = tid & 63, wave = __builtin_amdgcn_readfirstlane(tid >> 6);
    LAS float* tile = (LAS float*)lds;
    const int c0 = tid * 2;
    float w0[CONVW], w1[CONVW];
#pragma unroll
    for (int j = 0; j < CONVW; ++j) { const f32x2 w = *(const f32x2*)(dw_w + j * D + c0); w0[j] = w[0]; w1[j] = w[1]; }
    const f32x2 bb = *(const f32x2*)(dw_b + c0);
    for (int unit = bx; unit < T / 16; unit += G) {
        const int t0 = unit * 16, s0 = t0 & (SEQ - 1);
        float a0[16], a1[16];
#pragma unroll
        for (int r = 0; r < 16; ++r) { a0[r] = bb[0]; a1[r] = bb[1]; }
#define CV_LOAD(dst, ib) do { _Pragma("unroll") for (int k = 0; k < 12; ++k) { const int i = (ib) + k; dst[k] = (i < 46 && s0 - 30 + i >= 0) ? *(const unsigned*)(U + (size_t)(t0 - 30 + i) * D + c0) : 0u; } } while (0)
#define CV_FMA(src, ib) do { _Pragma("unroll") for (int k = 0; k < 12; ++k) { const int i = (ib) + k; if (i < 46) { const float u0 = __uint_as_float(src[k] << 16), u1 = __uint_as_float(src[k] & 0xffff0000u); \
            _Pragma("unroll") for (int r = 0; r < 16; ++r) { const int j = i - r; if (j >= 0 && j < CONVW) { a0[r] = fmaf(w0[j], u0, a0[r]); a1[r] = fmaf(w1[j], u1, a1[r]); } } } } } while (0)
        { unsigned ua[12], ub[12];
          CV_LOAD(ua, 0); asm volatile("" ::: "memory");
          CV_LOAD(ub, 12); asm volatile("" ::: "memory"); CV_FMA(ua, 0);
          CV_LOAD(ua, 24); asm volatile("" ::: "memory"); CV_FMA(ub, 12);
          CV_LOAD(ub, 36); asm volatile("" ::: "memory"); CV_FMA(ua, 24);
          CV_FMA(ub, 36); }
#undef CV_LOAD
#undef CV_FMA
#pragma unroll
        for (int r = 0; r < 16; ++r) *(LAS f32x2*)(tile + r * D + c0) = (f32x2){a0[r], a1[r]};
        __syncthreads();
#pragma unroll
        for (int rr = 0; rr < 2; ++rr) { const int r = wave * 2 + rr; const LAS f32x4* xr = (const LAS f32x4*)(tile + r * D); f32x4 v[4]; float sm = 0.f;
#pragma unroll
            for (int j = 0; j < 4; ++j) { v[j] = xr[lane + 64 * j]; sm += (v[j][0] + v[j][1]) + (v[j][2] + v[j][3]); }
            const float mean = wave_sum(sm) * (1.0f / D); float q = 0.f;
#pragma unroll
            for (int j = 0; j < 4; ++j) { v[j] = v[j] - mean; q += (v[j][0] * v[j][0] + v[j][1] * v[j][1]) + (v[j][2] * v[j][2] + v[j][3] * v[j][3]); }
            const float rs = fast_rsqrt(wave_sum(q) * (1.0f / D) + EPS);
#pragma unroll
            for (int j = 0; j < 4; ++j) { const int c = (lane + 64 * j) * 4; const f32x4 gg = *(const f32x4*)(ln_g + c), bv = *(const f32x4*)(ln_b + c); const f32x4 y = v[j] * rs * gg + bv;
                u32x2 o; o.x = cvt_pk_bf16(y[0] * fast_sigmoid(y[0]), y[1] * fast_sigmoid(y[1])); o.y = cvt_pk_bf16(y[2] * fast_sigmoid(y[2]), y[3] * fast_sigmoid(y[3]));
                ((u32x2*)(Vb + (size_t)(t0 + r) * D))[lane + 64 * j] = o; } }
        __syncthreads();
    }
}
__device__ __forceinline__ void route(LAS unsigned char* lds, const bf16* H, const float* WrP, const float* bg, const float* br, int4* LIST, int* CNT, float* GATE, int G, int bx) {
    int tid_ = threadIdx.x; asm volatile("" : "+v"(tid_));
    const int tid = tid_, lane = tid & 63, wave = __builtin_amdgcn_readfirstlane(tid >> 6), r16 = lane & 15, kq = lane >> 4;
    LAS float* Bs = (LAS float*)lds; LAS float* LG = (LAS float*)(lds + 73728) + wave * (16 * 37);
    constexpr int NTILES = T / 16; const int NW = G * NWAVES_;
    LAS int* lcnt = (LAS int*)(lds + 73728 + 8 * 16 * 37 * 4); LAS int* gbase = lcnt + NE;
    if (tid < NE) lcnt[tid] = 0;
    int e0 = 0, e1 = 0, sl0 = 0, sl1 = 0; float rsv = 0.f, gt0 = 0.f, gt1 = 0.f;
    for (int base = 0; base < NTILES; base += NW) {
        const int tile = base + bx * NWAVES_ + wave; const bool act = tile < NTILES; const int t0 = tile * 16;
        f32x4 c0 = {0.f, 0.f, 0.f, 0.f}, c1 = c0, c2 = c0; float ss = 0.f;
#pragma unroll 1
        for (int half = 0; half < 2; ++half) {
            __syncthreads();
#pragma unroll
            for (int i = 0; i < 9; ++i) ((LAS f32x4*)Bs)[tid + 512 * i] = ((const f32x4*)(WrP + half * 18432))[tid + 512 * i];
            __syncthreads();
            if (act) {
                const bf16* hp = H + (size_t)(t0 + r16) * D + half * 512 + 8 * kq;
#pragma unroll 4
                for (int jj = 0; jj < 16; ++jj) {
                    const u32x4 hw = *(const u32x4*)(hp + 32 * jj);
                    const f32x4 a0 = (f32x4){__uint_as_float(hw.x << 16), __uint_as_float(hw.x & 0xffff0000u), __uint_as_float(hw.y << 16), __uint_as_float(hw.y & 0xffff0000u)};
                    const f32x4 a1 = (f32x4){__uint_as_float(hw.z << 16), __uint_as_float(hw.z & 0xffff0000u), __uint_as_float(hw.w << 16), __uint_as_float(hw.w & 0xffff0000u)};
                    ss += ((a0[0] * a0[0] + a0[1] * a0[1]) + (a0[2] * a0[2] + a0[3] * a0[3])) + ((a1[0] * a1[0] + a1[1] * a1[1]) + (a1[2] * a1[2] + a1[3] * a1[3]));
                    const LAS float* bp = Bs + ((jj * 4 + kq) * NRT + r16) * 8;
                    const f32x4 b00 = *(const LAS f32x4*)bp, b01 = *(const LAS f32x4*)(bp + 4), b10 = *(const LAS f32x4*)(bp + 128), b11 = *(const LAS f32x4*)(bp + 132), b20 = *(const LAS f32x4*)(bp + 256), b21 = *(const LAS f32x4*)(bp + 260);
#pragma unroll
                    for (int i = 0; i < 4; ++i) { c0 = __builtin_amdgcn_mfma_f32_16x16x4f32(a0[i], b00[i], c0, 0, 0, 0); c1 = __builtin_amdgcn_mfma_f32_16x16x4f32(a0[i], b10[i], c1, 0, 0, 0); c2 = __builtin_amdgcn_mfma_f32_16x16x4f32(a0[i], b20[i], c2, 0, 0, 0); }
#pragma unroll
                    for (int i = 0; i < 4; ++i) { c0 = __builtin_amdgcn_mfma_f32_16x16x4f32(a1[i], b01[i], c0, 0, 0, 0); c1 = __builtin_amdgcn_mfma_f32_16x16x4f32(a1[i], b11[i], c1, 0, 0, 0); c2 = __builtin_amdgcn_mfma_f32_16x16x4f32(a1[i], b21[i], c2, 0, 0, 0); }
                }
            }
        }
        if (act) {
            ss += __shfl_xor(ss, 16); ss += __shfl_xor(ss, 32);
#pragma unroll
            for (int rg = 0; rg < 4; ++rg) { LG[(4 * kq + rg) * 37 + r16] = c0[rg]; LG[(4 * kq + rg) * 37 + 16 + r16] = c1[rg]; if (r16 < 4) LG[(4 * kq + rg) * 37 + 32 + r16] = c2[rg]; }
            asm volatile("s_waitcnt lgkmcnt(0)" ::: "memory");
            if (lane < 16) {
                const int t = t0 + lane; const LAS float* lr = LG + lane * 37;
                const float rs = fast_rsqrt(ss * (1.0f / D) + EPS);
                float lg[NG]; int gi = 0; float gm = -3.0e38f;
#pragma unroll
                for (int c = 0; c < NG; ++c) { lg[c] = lr[c] * rs + bg[c]; if (lg[c] > gm) { gm = lg[c]; gi = c; } }
                float gs = 0.f;
#pragma unroll
                for (int c = 0; c < NG; ++c) gs += __expf(lg[c] - gm);
                const float gw = 1.0f / gs;
                float le[EPG]; float em = -3.0e38f;
#pragma unroll
                for (int c = 0; c < EPG; ++c) { le[c] = lr[NG + gi * EPG + c] * rs + br[gi * EPG + c]; em = fmaxf(em, le[c]); }
                int i0 = 0; float v0 = -3.0e38f;
#pragma unroll
                for (int c = 0; c < EPG; ++c) if (le[c] > v0) { v0 = le[c]; i0 = c; }
                int i1 = 0; float v1 = -3.0e38f;
#pragma unroll
                for (int c = 0; c < EPG; ++c) if (c != i0 && le[c] > v1) { v1 = le[c]; i1 = c; }
                const float p0 = __expf(v0 - em), p1 = __expf(v1 - em); const float inv = 1.0f / (p0 + p1);
                e0 = gi * EPG + i0; e1 = gi * EPG + i1; rsv = rs; gt0 = gw * p0 * inv; gt1 = gw * p1 * inv;
                GATE[2 * t] = gt0; GATE[2 * t + 1] = gt1;
                sl0 = __hip_atomic_fetch_add(lcnt + e0, 1, __ATOMIC_RELAXED, __HIP_MEMORY_SCOPE_WORKGROUP);
                sl1 = __hip_atomic_fetch_add(lcnt + e1, 1, __ATOMIC_RELAXED, __HIP_MEMORY_SCOPE_WORKGROUP);
            }
        }
        __syncthreads();
        if (tid < NE) { const int n = lcnt[tid]; gbase[tid] = n > 0 ? atomicAdd(CNT + tid * 64, n) : 0; }
        __syncthreads();
        if (act && lane < 16) { const int t = t0 + lane;
            LIST[(size_t)e0 * T + gbase[e0] + sl0] = make_int4(2 * t, __float_as_int(rsv), __float_as_int(gt0), 0);
            LIST[(size_t)e1 * T + gbase[e1] + sl1] = make_int4(2 * t + 1, __float_as_int(rsv), __float_as_int(gt1), 0); }
        __syncthreads();
        if (tid < NE) lcnt[tid] = 0;
    }
    __syncthreads();
}
template <bool FINAL>
__device__ __forceinline__ void combine(bf16* HB, float* out, const bf16* YS, const int* POS, const float* GATE, float* RSTD2, int G, int bx) {
    const int tid = threadIdx.x, lane = tid & 63, wave = __builtin_amdgcn_readfirstlane(tid >> 6);
    for (int t = bx * NWAVES_ + wave; t < T; t += G * NWAVES_) {
        const int p0 = POS[2 * t], p1 = POS[2 * t + 1]; const float g0 = GATE[2 * t], g1 = GATE[2 * t + 1];
        const u32x4* hr = (const u32x4*)(HB + (size_t)t * D); const u32x4* y0 = (const u32x4*)(YS + (size_t)p0 * D); const u32x4* y1 = (const u32x4*)(YS + (size_t)p1 * D);
        float ss = 0.f;
#pragma unroll
        for (int j = 0; j < 2; ++j) { const u32x4 hw = hr[lane + 64 * j], p = y0[lane + 64 * j], q = y1[lane + 64 * j]; float v[8];
            const unsigned hv[4] = {hw.x, hw.y, hw.z, hw.w}, pv[4] = {p.x, p.y, p.z, p.w}, qv[4] = {q.x, q.y, q.z, q.w};
#pragma unroll
            for (int e = 0; e < 4; ++e) { v[2 * e] = __uint_as_float(hv[e] << 16) + g0 * __uint_as_float(pv[e] << 16) + g1 * __uint_as_float(qv[e] << 16);
                v[2 * e + 1] = __uint_as_float(hv[e] & 0xffff0000u) + g0 * __uint_as_float(pv[e] & 0xffff0000u) + g1 * __uint_as_float(qv[e] & 0xffff0000u); }
            if constexpr (FINAL) { f32x4* o = (f32x4*)(out + (size_t)t * D) + 2 * (lane + 64 * j); o[0] = (f32x4){v[0], v[1], v[2], v[3]}; o[1] = (f32x4){v[4], v[5], v[6], v[7]}; }
            else { unsigned wv[4];
#pragma unroll
                for (int e = 0; e < 4; ++e) { wv[e] = cvt_pk_bf16(v[2 * e], v[2 * e + 1]); const float r0 = __uint_as_float(wv[e] << 16), r1 = __uint_as_float(wv[e] & 0xffff0000u); ss += r0 * r0 + r1 * r1; }
                u32x4 w; w.x = wv[0]; w.y = wv[1]; w.z = wv[2]; w.w = wv[3]; ((u32x4*)(HB + (size_t)t * D))[lane + 64 * j] = w; } }
        if constexpr (!FINAL) { ss = wave_sum(ss); if (lane == 0) RSTD2[t] = fast_rsqrt(ss * (1.0f / D) + EPS); }
    }
}
__device__ __forceinline__ void kfin(const bf16* KN, const bf16* CL, const float* SSK, const float* SSP, const float* kg, const float* cs, unsigned char* KK8, int G, int bx) {
    const int tid = threadIdx.x, lane = tid & 63, wave = __builtin_amdgcn_readfirstlane(tid >> 6), r32 = lane & 31, hi = lane >> 5;
    for (int item = bx * NWAVES_ + wave; item < NB * NH * (SEQ / 64) * 2; item += G * NWAVES_) {
        const int blk = item & 1, tile = (item >> 1) & (SEQ / 64 - 1), bh = item >> 8, b = bh / NH, h = bh % NH;
        const int t = b * SEQ + tile * 64 + blk * 32 + r32;
        const f32x4 sk = *(const f32x4*)(SSK + t * 32 + h * 4); const f32x2 sr = *(const f32x2*)(SSP + t * 32 + 8);
        const float rk = fast_rsqrt((((sk[0] + sk[1]) + (sk[2] + sk[3])) + (sr[0] + sr[1])) * (1.0f / DQK) + EPS);
        unsigned char* out = KK8 + ((size_t)(bh * (SEQ / 64) + tile)) * (64 * 192) + blk * 256 + hi * 512 + r32 * 8;
        const bf16* kn = KN + (size_t)t * D + h * 128 + hi * 8;
#pragma unroll
        for (int s = 0; s < 8; ++s) { const bf16x8 raw = *(const bf16x8*)(kn + s * 16); const f32x4 g0 = *(const f32x4*)(kg + s * 16 + hi * 8), g1 = *(const f32x4*)(kg + s * 16 + hi * 8 + 4);
            float y[8];
#pragma unroll
            for (int e = 0; e < 8; ++e) y[e] = __uint_as_float(((unsigned)(unsigned short)raw[e]) << 16) * rk * (e < 4 ? g0[e] : g1[e - 4]);
            *(u32x2*)(out + s * 1024) = pack_fp8x8(y); }
#pragma unroll
        for (int s = 0; s < 2; ++s) { const int jt = s * 16 + hi * 8;
            const bf16x8 r1 = *(const bf16x8*)(CL + (size_t)t * NCL + 256 + jt), r2 = *(const bf16x8*)(CL + (size_t)t * NCL + 288 + jt);
            const float* cp = cs + (size_t)t * 64 + jt; const f32x4 c0 = *(const f32x4*)cp, c1 = *(const f32x4*)(cp + 4), n0 = *(const f32x4*)(cp + 32), n1 = *(const f32x4*)(cp + 36);
            const f32x4 ga0 = *(const f32x4*)(kg + 128 + jt), ga1 = *(const f32x4*)(kg + 132 + jt), gb0 = *(const f32x4*)(kg + 160 + jt), gb1 = *(const f32x4*)(kg + 164 + jt);
            float y1[8], y2[8];
#pragma unroll
            for (int e = 0; e < 8; ++e) { const float p = __uint_as_float(((unsigned)(unsigned short)r1[e]) << 16) * rk * (e < 4 ? ga0[e] : ga1[e - 4]), q = __uint_as_float(((unsigned)(unsigned short)r2[e]) << 16) * rk * (e < 4 ? gb0[e] : gb1[e - 4]);
                const float c = e < 4 ? c0[e] : c1[e - 4], sn = e < 4 ? n0[e] : n1[e - 4]; y1[e] = p * c - q * sn; y2[e] = p * sn + q * c; }
            *(u32x2*)(out + (8 + s) * 1024) = pack_fp8x8(y1); *(u32x2*)(out + (10 + s) * 1024) = pack_fp8x8(y2); }
    }
}
#undef TH_LDS_WAIT
}

#define XB_TMO      128
#define XB_XCNT(j)  (256  + 64 * (j))
#define XB_XSUB(j)  (1280 + 64 * (j))
#define XB_XGEN(j)  (2304 + 64 * (j))
#define XB_TOP      3328
#define XB_TOPGEN   3392
#define XCD_BAR_WORDS 3456
#define XB_SPIN_CAP (1u << 18)
__device__ __forceinline__ unsigned xb_ld(unsigned* p)              { return __hip_atomic_load(p, __ATOMIC_RELAXED, __HIP_MEMORY_SCOPE_AGENT); }
__device__ __forceinline__ unsigned xb_add(unsigned* p, unsigned v) { return __hip_atomic_fetch_add(p, v, __ATOMIC_RELAXED, __HIP_MEMORY_SCOPE_AGENT); }
__device__ __forceinline__ unsigned xb_xcc_id() { return (unsigned)__builtin_amdgcn_s_getreg((3 << 11) | 20) & 0xFu; }
#define XB_SPIN(cond, bar) do { unsigned _sp = 0; while (cond) { __builtin_amdgcn_s_sleep(1); \
    if ((++_sp & 255u) == 0u) { if (xb_ld(&(bar)[XB_TMO])) break; if (_sp > XB_SPIN_CAP) { atomicAdd(&(bar)[XB_TMO], 1u); break; } } } } while (0)
struct XcdBarrier { unsigned* bar; unsigned x; volatile LAS unsigned* st; };
__device__ __forceinline__ XcdBarrier xcd_barrier_post(unsigned* bar, volatile LAS unsigned* st) {
    XcdBarrier b; b.bar = bar; b.x = xb_xcc_id(); b.st = st;
    if (threadIdx.x == 0) (void)xb_add(&bar[XB_XCNT(b.x)], 1u);
    return b;
}
__device__ __forceinline__ void xcd_barrier_complete(unsigned* bar, unsigned x, unsigned& nloc, unsigned& nx) {
    const unsigned G = gridDim.x * gridDim.y * gridDim.z;
    unsigned sum, cnt, mine, sp = 0u;
    for (;;) {
        sum = 0u; cnt = 0u; mine = 0u;
#pragma unroll
        for (unsigned j = 0; j < 16; ++j) { const unsigned c = xb_ld(&bar[XB_XCNT(j)]); sum += c; cnt += (c > 0u) ? 1u : 0u; mine = (j == x) ? c : mine; }
        if (sum == G) break;
        __builtin_amdgcn_s_sleep(1);
        if ((++sp & 255u) == 0u) { if (xb_ld(&bar[XB_TMO])) break; if (sp > XB_SPIN_CAP) { atomicAdd(&bar[XB_TMO], 1u); break; } }
    }
    nloc = mine > 0u ? mine : 1u; nx = cnt > 0u ? cnt : 1u;
}
__device__ __forceinline__ void xcd_barrier(const XcdBarrier& b) {
    asm volatile("s_waitcnt vmcnt(0)" ::: "memory");
    __syncthreads();
    if (threadIdx.x == 0) {
        unsigned* bar = b.bar;
        __builtin_amdgcn_s_waitcnt(0);
        unsigned nloc = b.st[0], nx = b.st[1];
        if (nloc == 0u) { xcd_barrier_complete(bar, b.x, nloc, nx); b.st[0] = nloc; b.st[1] = nx; }
        const unsigned old = xb_add(&bar[XB_XSUB(b.x)], 1u);
        const unsigned gen = old / nloc;
        if (old + 1u == (gen + 1u) * nloc) {
            __builtin_amdgcn_fence(__ATOMIC_RELEASE, "agent");
            asm volatile("s_waitcnt vmcnt(0)" ::: "memory");
            const unsigned og = xb_add(&bar[XB_TOP], 1u);
            const unsigned tg = og / nx;
            if (og + 1u == (tg + 1u) * nx) xb_add(&bar[XB_TOPGEN], 1u);
            else XB_SPIN(xb_ld(&bar[XB_TOPGEN]) == tg, bar);
            __builtin_amdgcn_fence(__ATOMIC_ACQUIRE, "agent");
            xb_add(&bar[XB_XGEN(b.x)], 1u);
            asm volatile("s_waitcnt vmcnt(0)" ::: "memory");
        } else {
            XB_SPIN(xb_ld(&bar[XB_XGEN(b.x)]) == gen, bar);
            __builtin_amdgcn_fence(__ATOMIC_ACQUIRE, "agent");
            asm volatile("s_waitcnt vmcnt(0)" ::: "memory");
        }
    }
    __syncthreads();
}

constexpr int NWAVES = 8, LDS_BYTES = 160 * 1024, LDS_MISC = 159 * 1024;
constexpr int CW_BAR = 4096;
constexpr int NPHASE = 17;
constexpr int PROBE_PH = -1, PROBE_MULT = 4;
constexpr int REP0 = 1, REP1 = 1, REP2 = 1, REP3 = 1, REP5 = 1, REP6 = 1, REP8 = 1, REP9 = 1, REP10 = 1, REP11 = 1, REP14 = 1, REP15 = 1;
struct Args { const float* in[30]; float* out; unsigned char* ws; int ph_lo, ph_hi; };

__global__ void __launch_bounds__(NWAVES * 64, 2) fwd(Args a) {
    extern __shared__ __attribute__((aligned(16))) unsigned char lds_raw[];
    LAS unsigned char* lds = (LAS unsigned char*)lds_raw;
    volatile LAS unsigned* MISC = (volatile LAS unsigned*)(lds + LDS_MISC);
    const int tid = threadIdx.x;
    if (tid < 64) MISC[tid] = 0u;
    __syncthreads();
    unsigned char* ws = a.ws; float* H = a.out;
    XcdBarrier bar = xcd_barrier_post((unsigned*)(ws + WS_CTL) + CW_BAR, MISC + 8);
    const int lo = a.ph_lo, hi = a.ph_hi, G = gridDim.x, bx = blockIdx.x;
    const int vcu = (G % 8 == 0) ? (bx % 8) * (G / 8) + bx / 8 : bx;
    unsigned long long pt0_ = 0, pt1_ = 0;
#define STAMP(k) do { if (PROBE_PH >= 0 && (k) == PROBE_PH) pt0_ = __builtin_amdgcn_s_memrealtime(); if (PROBE_PH >= 0 && (k) == PROBE_PH + 1) pt1_ = __builtin_amdgcn_s_memrealtime(); } while (0)
#define IN(k) (lo <= (k) && (k) < hi)
#define SEAM(k) do { if (IN(k) && IN((k) + 1)) xcd_barrier(bar); } while (0)
    const float* x = a.in[0];
    bf16 *W1t = (bf16*)(ws + WS_W1T), *W2t = (bf16*)(ws + WS_W2T), *Wc = (bf16*)(ws + WS_WC), *Wukv = (bf16*)(ws + WS_WUKV), *Wuq = (bf16*)(ws + WS_WUQ), *Wo = (bf16*)(ws + WS_WO);
    float *RSTD0 = (float*)(ws + WS_RSTD0), *RSTD2 = (float*)(ws + WS_RSTD2), *SSP = (float*)(ws + WS_SSP), *SSQ = (float*)(ws + WS_SSQ), *SSK = (float*)(ws + WS_SSK);
    bf16 *XB = (bf16*)(ws + WS_R1), *HB = XB, *U = (bf16*)(ws + WS_R2), *O = U, *Vb = (bf16*)(ws + WS_R3), *KN = Vb, *VV = (bf16*)(ws + WS_R3 + 64 * MiB),
         *CL = (bf16*)(ws + WS_CL), *QRAW = (bf16*)(ws + WS_QRAW);

    STAMP(0);
    if (IN(0)) for (int rep_ = 0; rep_ < REP0; ++rep_) th::prologue(lds, a.in, ws, G, bx);
    SEAM(0);
    STAMP(1);
    if (IN(1)) for (int rep_ = 0; rep_ < REP1; ++rep_) { fg::DenseP<fg::EpiGlu> p{(const char*)XB, D, (const char*)W1t, D, {}, {RSTD0, a.in[4], U}}; p.S.init(T, 2048, G, bx); fg::gemm_phase(lds, p); }
    SEAM(1);
    STAMP(2);
    if (IN(2)) for (int rep_ = 0; rep_ < REP2; ++rep_) th::conv_ln(lds, U, a.in[5], a.in[6], a.in[7], a.in[8], Vb, G, bx);
    SEAM(2);
    STAMP(3);
    if (IN(3)) for (int rep_ = 0; rep_ < REP3; ++rep_) { fg::DenseP<fg::EpiRes<false>> p{(const char*)Vb, D, (const char*)W2t, D, {}, {x, a.in[10], HB}}; p.S.init(T, D, G, bx); fg::gemm_phase(lds, p); }
    SEAM(3);
    LAS int* pref = (LAS int*)(lds + LDS_MISC + 256); LAS int* cnts = (LAS int*)(lds + LDS_MISC + 640);
    int4* LIST = (int4*)(ws + WS_LISTR); int* POS = (int*)(ws + WS_LIST); float* GATE = (float*)(ws + WS_GATE); bf16* ACTS = (bf16*)(ws + WS_ACTS); bf16* YS = (bf16*)(ws + WS_YS);
    bf16* XT = XB; bf16* ACT = U; bf16* Y = Vb; const bf16* Wgu = (const bf16*)(ws + WS_WGU); const bf16* Wd = (const bf16*)(ws + WS_WD);
#define MOE_GEMMS(l, p1, p2) do { \
        STAMP(p1); \
        if (IN(p1)) for (int rep_ = 0; rep_ < ((l) ? REP14 : REP5); ++rep_) { fg::moe_setup((const int*)(ws + WS_CTL) + (l) * NE * 64, pref, cnts); \
            fg::MoeP<fg::EpiSwiglu, true> p{(const char*)HB, D, 1, (const char*)(Wgu + (size_t)(l) * NE * 1024 * D), (size_t)1024 * D * 2, D, LIST, pref, cnts, G, vcu, 4 * (__builtin_amdgcn_readfirstlane(pref[32]) + __builtin_amdgcn_readfirstlane(pref[72])), {ACTS, POS}}; \
            fg::gemm_phase(lds, p); } \
        SEAM(p1); \
        STAMP(p2); \
        if (IN(p2)) for (int rep_ = 0; rep_ < ((l) ? REP15 : REP6); ++rep_) { fg::moe_setup((const int*)(ws + WS_CTL) + (l) * NE * 64, pref, cnts); \
            fg::MoeP<fg::EpiDown, false> p{(const char*)ACTS, DE, 0, (const char*)(Wd + (size_t)(l) * NE * D * DE), (size_t)D * DE * 2, DE, LIST, pref, cnts, G, vcu, 4 * (__builtin_amdgcn_readfirstlane(pref[32]) + __builtin_amdgcn_readfirstlane(pref[72])), {YS}}; \
            fg::gemm_phase(lds, p); } \
        SEAM(p2); } while (0)
    float* Wr = (float*)(ws + WS_WR); int* CNT = (int*)(ws + WS_CTL);
    STAMP(4);
    if (IN(4)) th::route(lds, HB, Wr, a.in[25], a.in[27], LIST, CNT, GATE, G, bx);
    SEAM(4);
    MOE_GEMMS(0, 5, 6);
    STAMP(7);
    if (IN(7)) th::combine<false>(HB, nullptr, YS, POS, GATE, RSTD2, G, bx);
    SEAM(7);
    STAMP(8);
    if (IN(8)) for (int rep_ = 0; rep_ < REP8; ++rep_) { fg::DenseP<fg::EpiCL> p{(const char*)HB, D, (const char*)Wc, D, {}, {RSTD2, CL, SSP}}; p.S.init(T, NCL, G, bx); fg::gemm_phase(lds, p); }
    SEAM(8);
    STAMP(9);
    if (IN(9)) for (int rep_ = 0; rep_ < REP9; ++rep_) {
        { fg::DenseP<fg::EpiQ> p{(const char*)(CL + 320), NCL, (const char*)Wuq, QLR, {}, {SSP, QRAW, SSQ}}; p.S.init(T, 1536, G, bx); fg::gemm_phase(lds, p); }
        { fg::DenseP<fg::EpiKV> p{(const char*)CL, NCL, (const char*)Wukv, KVR, {}, {SSP, KN, VV, SSK}}; p.S.init(T, 2048, G, bx); fg::gemm_phase(lds, p); }
    }
    SEAM(9);
    STAMP(10);
    if (IN(10)) for (int rep_ = 0; rep_ < REP10; ++rep_) th::kfin(KN, CL, SSK, SSP, a.in[16], (const float*)(ws + WS_CS), (unsigned char*)(ws + WS_KK), G, bx);
    SEAM(10);
    STAMP(11);
    if (IN(11)) for (int rep_ = 0; rep_ < REP11; ++rep_) { const at::AttnArgs aa{QRAW, SSQ, a.in[21], (const float*)(ws + WS_CS), (const unsigned char*)(ws + WS_KK), VV, O}; at::attn_phase(lds, aa, G, bx); }
    SEAM(11);
    STAMP(12);
    if (IN(12)) { fg::DenseP<fg::EpiRes<true>> p{(const char*)O, D, (const char*)Wo, D, {}, {HB, nullptr, HB}}; p.S.init(T, D, G, bx); fg::gemm_phase(lds, p); }
    SEAM(12);
    STAMP(13);
    if (IN(13)) th::route(lds, HB, Wr + (size_t)D * NRT, a.in[25] + NG, a.in[27] + NE, LIST, CNT + NE * 64, GATE, G, bx);
    SEAM(13);
    MOE_GEMMS(1, 14, 15);
    STAMP(16);
    if (IN(16)) th::combine<true>(HB, H, YS, POS, GATE, nullptr, G, bx);
#undef MOE_GEMMS
    STAMP(17);
    if (PROBE_PH >= 0 && bx == 0) { const unsigned long long te_ = __builtin_amdgcn_s_memrealtime(), dt_ = (pt1_ - pt0_) * (unsigned long long)PROBE_MULT; while (__builtin_amdgcn_s_memrealtime() - te_ < dt_) __builtin_amdgcn_s_sleep(8); }
#undef IN
#undef SEAM
#undef STAMP
}

extern "C" void kernel_launch(void* const* d_in, const int* in_sizes, int n_in, void* d_out, int out_size, void* d_ws, size_t ws_size, hipStream_t stream) {
    if (n_in != 30 || ws_size < WS_END || out_size != T * D) { fprintf(stderr, "kernel_launch: unexpected shapes (n_in %d, ws %zu, out %d)\n", n_in, ws_size, out_size); return; }
    static int grid = 0;
    if (!grid) {
        (void)hipFuncSetAttribute((const void*)fwd, hipFuncAttributeMaxDynamicSharedMemorySize, LDS_BYTES);
        int dev = 0, cus = 0; (void)hipGetDevice(&dev); if (hipDeviceGetAttribute(&cus, hipDeviceAttributeMultiprocessorCount, dev) != hipSuccess || cus <= 0) cus = 256;
        grid = cus;
    }
    char* ws = (char*)d_ws;
    Args a{}; for (int i = 0; i < 30; ++i) a.in[i] = (const float*)d_in[i]; a.out = (float*)d_out; a.ws = (unsigned char*)d_ws;
    (void)hipMemsetAsync(ws + WS_CTL, 0, 1 * MiB, stream);
    a.ph_lo = 0; a.ph_hi = NPHASE;
    hipLaunchKernelGGL(fwd, dim3(grid), dim3(NWAVES * 64), LDS_BYTES, stream, a);
}
```

```cpp
#include <hip/hip_runtime.h>
#include <stdint.h>
#include <stdio.h>

typedef unsigned short bf16;
constexpr int NB = 4, SEQ = 8192, T = NB * SEQ, D = 1024, NH = 8, DQK = 192, DNOPE = 128, DROPE = 64, DV = 128, KVR = 256, QLR = 384;
constexpr int NE = 32, NG = 4, EPG = 8, DE = 512, CONVW = 31, NCL = 768, NRT = 36;
constexpr float EPS = 1e-6f;
constexpr float SM_SCALE = 0.07216878364870322f;

constexpr size_t MiB = 1u << 20;
constexpr size_t WS_CTL = 0, WS_W1T = 1 * MiB, WS_W2T = 5 * MiB, WS_WC = 7 * MiB, WS_WUKV = 9 * MiB, WS_WUQ = 10 * MiB, WS_WO = 12 * MiB, WS_WR = 14 * MiB,
                 WS_WGU = 16 * MiB, WS_WD = 144 * MiB, WS_RSTD0 = 208 * MiB, WS_RSTD = WS_RSTD0 + 256 * 1024, WS_RSTD2 = WS_RSTD0 + 512 * 1024,
                 WS_GATE = 209 * MiB, WS_LIST = 210 * MiB, WS_CS = 214 * MiB, WS_SSP = 222 * MiB, WS_SSQ = 226 * MiB, WS_SSK = 232 * MiB,
                 WS_R1 = 236 * MiB, WS_R2 = 300 * MiB, WS_R3 = 364 * MiB, WS_CL = 492 * MiB, WS_QRAW = 540 * MiB, WS_KK = 636 * MiB, WS_LISTR = 732 * MiB  , WS_ACTS = 748 * MiB  , WS_YS = 828 * MiB  ,  WS_END = 988 * MiB;

__device__ const float INV_FREQ[32] = {
    1.0f, 0.7498942093324559f, 0.5623413251903491f, 0.4216965034285822f, 0.31622776601683794f, 0.23713737056616552f, 0.1778279410038923f, 0.1333521432163324f,
    0.1f, 0.07498942093324558f, 0.05623413251903491f, 0.04216965034285822f, 0.03162277660168379f, 0.023713737056616554f, 0.01778279410038923f, 0.01333521432163324f,
    0.01f, 0.007498942093324558f, 0.005623413251903491f, 0.004216965034285823f, 0.0031622776601683794f, 0.0023713737056616554f, 0.001778279410038923f, 0.001333521432163324f,
    0.001f, 0.0007498942093324559f, 0.0005623413251903491f, 0.00042169650342858224f, 0.00031622776601683794f, 0.00023713737056616554f, 0.0001778279410038923f, 0.0001333521432163324f};

__device__ __forceinline__ float bf2f(bf16 b) { return __uint_as_float(((unsigned)b) << 16); }
__device__ __forceinline__ bf16 f2bf(float f) { unsigned u = __float_as_uint(f); u += 0x7fffu + ((u >> 16) & 1u); return (bf16)(u >> 16); }
__device__ __forceinline__ float wave_sum(float v) {
#pragma unroll
    for (int o = 1; o < 64; o <<= 1) v += __shfl_xor(v, o);
    return v;
}
__device__ __forceinline__ float sigmoidf_(float x) { return 1.0f / (1.0f + __expf(-x)); }
__device__ __forceinline__ float siluf_(float x) { return x / (1.0f + __expf(-x)); }
__host__ __device__ __forceinline__ int pair_row(int n, int half) { const int j = n % half, hf = n / half; return 256 * (j / 128) + 128 * hf + (j % 128); }

__device__ __forceinline__ void sincos_d(double a, double& s, double& c) {
    const double TWO_PI = 6.283185307179586476925287, PI = 3.14159265358979323846;
    double k = __builtin_rint(a / TWO_PI); double r = a - k * TWO_PI;
    double q = __builtin_rint(r / (PI * 0.5)); double y = r - q * (PI * 0.5); int qi = ((int)q) & 3;
    const double y2 = y * y;
    double sp = y * (1.0 + y2 * (-1.0 / 6 + y2 * (1.0 / 120 + y2 * (-1.0 / 5040 + y2 * (1.0 / 362880 + y2 * (-1.0 / 39916800 + y2 * (1.0 / 6227020800.0)))))));
    double cp = 1.0 + y2 * (-0.5 + y2 * (1.0 / 24 + y2 * (-1.0 / 720 + y2 * (1.0 / 40320 + y2 * (-1.0 / 3628800 + y2 * (1.0 / 479001600.0 + y2 * (-1.0 / 87178291200.0)))))));
    if (qi == 0) { s = sp; c = cp; } else if (qi == 1) { s = cp; c = -sp; } else if (qi == 2) { s = -sp; c = -cp; } else { s = -cp; c = sp; }
}

constexpr int NWAVES_ = 8;
#define LAS __attribute__((address_space(3)))
#define GAS __attribute__((address_space(1)))
typedef short bf16x8 __attribute__((ext_vector_type(8)));
typedef float f32x4 __attribute__((ext_vector_type(4)));
typedef float f32x2 __attribute__((ext_vector_type(2)));
typedef unsigned u32x4 __attribute__((ext_vector_type(4)));
typedef unsigned u32x2 __attribute__((ext_vector_type(2)));

__device__ __forceinline__ unsigned cvt_pk_bf16(float lo, float hi) { unsigned r; asm volatile("v_cvt_pk_bf16_f32 %0, %1, %2" : "=v"(r) : "v"(lo), "v"(hi)); return r; }
__device__ __forceinline__ float fast_sigmoid(float x) { return __builtin_amdgcn_rcpf(1.0f + __builtin_amdgcn_exp2f(-1.4426950408889634f * x)); }
__device__ __forceinline__ float fast_rsqrt(float x) { return 1.0f / sqrtf(x); }
__device__ __forceinline__ u32x2 pack_fp8x8(const float (&y)[8]) { int w0 = 0, w1 = 0; w0 = __builtin_amdgcn_cvt_pk_fp8_f32(y[0], y[1], w0, false); w0 = __builtin_amdgcn_cvt_pk_fp8_f32(y[2], y[3], w0, true);
    w1 = __builtin_amdgcn_cvt_pk_fp8_f32(y[4], y[5], w1, false); w1 = __builtin_amdgcn_cvt_pk_fp8_f32(y[6], y[7], w1, true); u32x2 r; r.x = (unsigned)w0; r.y = (unsigned)w1; return r; }

namespace fg {
constexpr int BM = 256, BK = 64, HALF = 128, HTB = HALF * BK * 2, STAGE_BYTES = 8 * HTB, NXCD = 8, WGM = 8;
__host__ __device__ __forceinline__ int lds_byte(int r, int c) { const int st = (r >> 4) * 2 + (c >> 5), rr = r & 15, cc = c & 31, ob = rr * 64 + cc * 2; return st * 1024 + (ob ^ (((ob >> 9) & 1) << 5)); }
__host__ __device__ __forceinline__ void stage_rc(int b, int& R, int& C) { const int st = b / 1024, sb = b % 1024, swz = sb ^ (((sb >> 9) & 1) << 5); R = (st >> 1) * 16 + swz / 64; C = (st & 1) * 32 + (swz % 64) / 2; }
__host__ __device__ __forceinline__ int perm32(int rho) { const int n = rho >> 4, i = rho & 15; return 8 * (i >> 2) + 4 * n + (i & 3); }
struct Unit { int pm, pn, e, nvalid, r, am; };
typedef f32x4 Acc[2][2][4][2];

struct StaticOrder {
    int nM, nN, nwg, G, c;
    __device__ void init(int M, int N, int G_, int c_) { nM = M / BM; nN = N / BM; nwg = nM * nN; G = G_; c = c_; }
    __device__ bool next(int i, Unit& u) const {
        long L = (long)i * G + c; const int nfull = (nwg / G) * G;
        int am = 3; if (L >= nfull) { const long hu = L - nfull; L = nfull + (hu >> 1); am = 1 << (int)(hu & 1); }
        if (L >= nwg) return false;
        int wgid = (int)L; { const int q = nwg / NXCD, r = nwg % NXCD, xcd = wgid % NXCD, off = wgid / NXCD; wgid = (xcd < r ? xcd * (q + 1) : r * (q + 1) + (xcd - r) * q) + off; }
        const int nig = WGM * nN, gid = wgid / nig, fm = gid * WGM, gsz = (nM - fm) < WGM ? (nM - fm) : WGM;
        u.pm = fm + ((wgid % nig) % gsz); u.pn = (wgid % nig) / gsz; u.e = 0; u.nvalid = 256; u.r = u.pm; u.am = am; return true;
    }
};

template <class P>
__device__ __forceinline__ void gemm_phase(LAS unsigned char* lds, const P& p) {
    int tid_ = threadIdx.x; asm volatile("" : "+v"(tid_));
    const int tid = tid_, wid = __builtin_amdgcn_readfirstlane(tid >> 6), lane = tid & 63, wr = wid >> 2, wc = wid & 3, fr = lane & 15, fq = lane >> 4;
    const int K = p.K, nt = K / BK;
    int sR[2], sC[2]; unsigned voffB[2];
#pragma unroll
    for (int i = 0; i < 2; ++i) { int R, C; stage_rc(tid * 16 + i * 8192, R, C); sR[i] = R; sC[i] = C; const int Rb = P::PERM ? ((R & ~31) + perm32(R & 31)) : R; voffB[i] = (unsigned)(Rb * K + C) * 2u; }
    const size_t kstep = (size_t)(BK * 2), hstepB = (size_t)HALF * K * 2;
    const unsigned ldsw = (unsigned)wid * 1024u;
    const int aoff = lds_byte(wr * 64 + fr, fq * 8), boff = lds_byte(wc * 32 + fr, fq * 8);
#define FG_SA(b, h) (((b) * 2 + (h)) * HTB)
#define FG_SB(b, h) ((4 + (b) * 2 + (h)) * HTB)
#define FG_STAGE(bufoff, gbase, voff) do { _Pragma("unroll") for (int _i = 0; _i < 2; ++_i) \
        __builtin_amdgcn_global_load_lds((const unsigned*)((const char*)(gbase) + (voff)[_i]), (LAS unsigned*)(lds + (bufoff) + ldsw + _i * 8192), 16, 0, 0); } while (0)
#define FG_LDA(dst, b, h) do { _Pragma("unroll") for (int m = 0; m < 4; ++m) _Pragma("unroll") for (int k = 0; k < 2; ++k) dst[m][k] = *(const LAS bf16x8*)(lds + FG_SA(b, h) + aoff + m * 2048 + k * 1024); } while (0)
#define FG_LDB(dst, b, h) do { _Pragma("unroll") for (int n = 0; n < 2; ++n) _Pragma("unroll") for (int k = 0; k < 2; ++k) dst[n][k] = *(const LAS bf16x8*)(lds + FG_SB(b, h) + boff + n * 2048 + k * 1024); } while (0)
#define FG_MMA(ai, bj, At, Bt) do { __builtin_amdgcn_s_setprio(1); _Pragma("unroll") for (int m = 0; m < 4; ++m) _Pragma("unroll") for (int n = 0; n < 2; ++n) _Pragma("unroll") for (int k = 0; k < 2; ++k) \
        acc[ai][bj][m][n] = __builtin_amdgcn_mfma_f32_16x16x32_bf16(Bt[n][k], At[m][k], acc[ai][bj][m][n], 0, 0, 0); __builtin_amdgcn_s_setprio(0); } while (0)
#define FG_WAIT_V(n) asm volatile("s_waitcnt vmcnt(" #n ")" ::: "memory")
#define FG_WAIT_L(n) asm volatile("s_waitcnt lgkmcnt(" #n ")" ::: "memory")
#define FG_BAR __builtin_amdgcn_s_barrier()
#define FG_SCHED __builtin_amdgcn_sched_barrier(0)
    Unit cur, nxt, nn; int ui = 0;
    if (!p.next(0, cur)) return;
    unsigned ao[4], nao[4], nnao[4];
    p.a_off(cur, sR, sC, ao);
    bool has_next = p.next(1, nxt);
    if (has_next) p.a_off(nxt, sR, sC, nao); else { nxt = cur; _Pragma("unroll") for (int j = 0; j < 4; ++j) nao[j] = ao[j]; }
    Acc acc;
#pragma unroll
    for (int a = 0; a < 2; ++a)
#pragma unroll
        for (int b = 0; b < 2; ++b)
#pragma unroll
            for (int m = 0; m < 4; ++m)
#pragma unroll
                for (int n = 0; n < 2; ++n) acc[a][b][m][n] = (f32x4){0.f, 0.f, 0.f, 0.f};
    bf16x8 At[4][2], B0[2][2], B1[2][2];
    const char* const Ab = p.A;
    const char* cB = p.b_base(cur);
    FG_STAGE(FG_SB(0, 0), cB, voffB); FG_STAGE(FG_SB(0, 1), cB + hstepB, voffB); FG_STAGE(FG_SA(0, 0), Ab, ao); FG_STAGE(FG_SA(0, 1), Ab, ao + 2);
    if (wr == 1) FG_BAR;
    FG_WAIT_V(2); FG_BAR;
    FG_STAGE(FG_SB(1, 0), cB + kstep, voffB); FG_STAGE(FG_SA(1, 0), Ab + kstep, ao); FG_STAGE(FG_SB(1, 1), cB + hstepB + kstep, voffB);
    FG_WAIT_V(6); FG_BAR;
    for (;;) {
        const char* nB = has_next ? p.b_base(nxt) : cB;
        for (int t = 0; t < nt; t += 2) {
            const bool last = (t == nt - 2);
            const char* a1 = Ab + (size_t)(t + 1) * kstep;
            const char* a2 = last ? Ab : Ab + (size_t)(t + 2) * kstep; const char* b2 = last ? nB : cB + (size_t)(t + 2) * kstep;
            const char* a3 = a2 + kstep; const char* b3 = b2 + kstep;
            unsigned so[4];
#pragma unroll
            for (int j = 0; j < 4; ++j) so[j] = last ? nao[j] : ao[j];
            FG_LDB(B0, 0, 0); FG_LDB(B1, 0, 1); FG_SCHED; FG_LDA(At, 0, 0); FG_STAGE(FG_SA(1, 1), a1, ao + 2);
            FG_WAIT_V(8); FG_WAIT_L(0); FG_BAR; if (cur.am & 1) { FG_MMA(0, 0, At, B0); FG_MMA(0, 1, At, B1); } FG_BAR; FG_SCHED;
            FG_LDA(At, 0, 1); FG_STAGE(FG_SB(0, 0), b2, voffB); FG_STAGE(FG_SB(0, 1), b2 + hstepB, voffB); FG_STAGE(FG_SA(0, 0), a2, so);
            FG_WAIT_V(8); FG_WAIT_L(0); FG_BAR; if (cur.am & 2) { FG_MMA(1, 0, At, B0); FG_MMA(1, 1, At, B1); } FG_BAR; FG_SCHED;
            FG_LDB(B0, 1, 0); FG_LDB(B1, 1, 1); FG_SCHED; FG_LDA(At, 1, 0); FG_STAGE(FG_SA(0, 1), a2, so + 2);
            FG_WAIT_V(8); FG_WAIT_L(0); FG_BAR; if (cur.am & 1) { FG_MMA(0, 0, At, B0); FG_MMA(0, 1, At, B1); } FG_BAR; FG_SCHED;
            FG_LDA(At, 1, 1); FG_STAGE(FG_SB(1, 0), b3, voffB); FG_STAGE(FG_SB(1, 1), b3 + hstepB, voffB); FG_STAGE(FG_SA(1, 0), a3, so);
            FG_WAIT_V(8); FG_WAIT_L(0); FG_BAR; if (cur.am & 2) { FG_MMA(1, 0, At, B0); FG_MMA(1, 1, At, B1); } FG_BAR; FG_SCHED;
        }
        if (wr == 0) FG_BAR;
        const bool has_nn = has_next && p.next(ui + 2, nn);
        if (has_nn) p.a_off(nn, sR, sC, nnao); else { nn = nxt; _Pragma("unroll") for (int j = 0; j < 4; ++j) nnao[j] = nao[j]; }
        p.epi(acc, cur, wr, wc, fr, fq);
        if (!has_next) break;
#pragma unroll
        for (int a = 0; a < 2; ++a)
#pragma unroll
            for (int b = 0; b < 2; ++b)
#pragma unroll
                for (int m = 0; m < 4; ++m)
#pragma unroll
                    for (int n = 0; n < 2; ++n) acc[a][b][m][n] = (f32x4){0.f, 0.f, 0.f, 0.f};
        cur = nxt; cB = nB; nxt = nn; has_next = has_nn; ++ui;
#pragma unroll
        for (int j = 0; j < 4; ++j) { ao[j] = nao[j]; nao[j] = nnao[j]; }
        if (wr == 1) FG_BAR;
    }
    FG_WAIT_V(0);
    FG_BAR;
#undef FG_SA
#undef FG_SB
#undef FG_STAGE
#undef FG_LDA
#undef FG_LDB
#undef FG_MMA
#undef FG_WAIT_V
#undef FG_WAIT_L
#undef FG_BAR
#undef FG_SCHED
}

template <class Epi> struct DenseP {
    static constexpr bool PERM = Epi::PERM;
    const char* A; int lda; const char* Bt; int K; StaticOrder S; Epi E;
    __device__ __forceinline__ bool next(int i, Unit& u) const { return S.next(i, u); }
    __device__ __forceinline__ const char* b_base(const Unit& u) const { return Bt + (size_t)u.pn * BM * K * 2; }
    __device__ __forceinline__ void a_off(const Unit& u, const int (&sR)[2], const int (&sC)[2], unsigned (&ao)[4]) const {
#pragma unroll
        for (int h = 0; h < 2; ++h)
#pragma unroll
            for (int i = 0; i < 2; ++i) ao[h * 2 + i] = (unsigned)((u.pm * BM + h * HALF + sR[i]) * lda + sC[i]) * 2u;
    }
    __device__ __forceinline__ void epi(const Acc& acc, const Unit& u, int wr, int wc, int fr, int fq) const { E(acc, u, wr, wc, fr, fq); }
};

struct EpiGlu {
    static constexpr bool PERM = true;
    const float* rstd; const float* bias; bf16* U;
    __device__ __forceinline__ void operator()(const Acc& acc, const Unit& u, int wr, int wc, int fr, int fq) const {
        const int col = u.pn * 128 + wc * 32 + fq * 8, row0 = u.pm * BM + wr * 64 + fr;
        const f32x4 ba0 = *(const f32x4*)(bias + col), ba1 = *(const f32x4*)(bias + col + 4), bg0 = *(const f32x4*)(bias + 1024 + col), bg1 = *(const f32x4*)(bias + 1024 + col + 4);
        float rsv[8];
#pragma unroll
        for (int q = 0; q < 8; ++q) rsv[q] = rstd[row0 + (q >> 2) * HALF + (q & 3) * 16];
#pragma unroll
        for (int ai = 0; ai < 2; ++ai) if ((u.am >> ai) & 1)
#pragma unroll
            for (int m = 0; m < 4; ++m) { const int row = row0 + ai * HALF + m * 16; const float rs = rsv[ai * 4 + m];
                const f32x4 a0 = acc[ai][0][m][0] * rs + ba0, a1 = acc[ai][0][m][1] * rs + ba1, g0 = acc[ai][1][m][0] * rs + bg0, g1 = acc[ai][1][m][1] * rs + bg1;
                float o[8];
#pragma unroll
                for (int j = 0; j < 4; ++j) { o[j] = a0[j] * fast_sigmoid(g0[j]); o[4 + j] = a1[j] * fast_sigmoid(g1[j]); }
                u32x4 w; w.x = cvt_pk_bf16(o[0], o[1]); w.y = cvt_pk_bf16(o[2], o[3]); w.z = cvt_pk_bf16(o[4], o[5]); w.w = cvt_pk_bf16(o[6], o[7]);
                *(u32x4*)(U + (size_t)row * D + col) = w; }
    }
};
__device__ __forceinline__ u32x4 pack8(const f32x4 a, const f32x4 b);
template <bool BF16BASE> struct EpiRes {
    static constexpr bool PERM = true;
    const void* base; const float* bias; bf16* out;
    __device__ __forceinline__ void operator()(const Acc& acc, const Unit& u, int wr, int wc, int fr, int fq) const {
        const int row0 = u.pm * BM + wr * 64 + fr, col0 = u.pn * BM + wc * 32 + 8 * fq;
        f32x4 bv[2][2];
#pragma unroll
        for (int bj = 0; bj < 2; ++bj)
#pragma unroll
            for (int n = 0; n < 2; ++n) bv[bj][n] = bias ? *(const f32x4*)(bias + col0 + bj * HALF + 4 * n) : (f32x4){0.f, 0.f, 0.f, 0.f};
#pragma unroll
        for (int ai = 0; ai < 2; ++ai) { if (!((u.am >> ai) & 1)) continue;
            if constexpr (BF16BASE) {
                u32x4 raw[4][2];
#pragma unroll
                for (int m = 0; m < 4; ++m) { const size_t off = (size_t)(row0 + ai * HALF + m * 16) * D + col0;
#pragma unroll
                    for (int bj = 0; bj < 2; ++bj) raw[m][bj] = *(const u32x4*)((const bf16*)base + off + bj * HALF); }
                asm volatile("" ::: "memory");
#pragma unroll
                for (int m = 0; m < 4; ++m) { const size_t off = (size_t)(row0 + ai * HALF + m * 16) * D + col0;
#pragma unroll
                    for (int bj = 0; bj < 2; ++bj) { const u32x4 w = raw[m][bj];
                        const f32x4 b0 = (f32x4){__uint_as_float(w.x << 16), __uint_as_float(w.x & 0xffff0000u), __uint_as_float(w.y << 16), __uint_as_float(w.y & 0xffff0000u)};
                        const f32x4 b1 = (f32x4){__uint_as_float(w.z << 16), __uint_as_float(w.z & 0xffff0000u), __uint_as_float(w.w << 16), __uint_as_float(w.w & 0xffff0000u)};
                        *(u32x4*)(out + off + bj * HALF) = pack8(b0 + acc[ai][bj][m][0] + bv[bj][0], b1 + acc[ai][bj][m][1] + bv[bj][1]); } }
                asm volatile("" ::: "memory");
            } else {
#pragma unroll
                for (int mh = 0; mh < 2; ++mh) {
                    f32x4 bs[2][2][2];
#pragma unroll
                    for (int m2 = 0; m2 < 2; ++m2) { const size_t off = (size_t)(row0 + ai * HALF + (mh * 2 + m2) * 16) * D + col0;
#pragma unroll
                        for (int bj = 0; bj < 2; ++bj) { bs[m2][bj][0] = *(const f32x4*)((const float*)base + off + bj * HALF); bs[m2][bj][1] = *(const f32x4*)((const float*)base + off + bj * HALF + 4); } }
                    asm volatile("" ::: "memory");
#pragma unroll
                    for (int m2 = 0; m2 < 2; ++m2) { const int m = mh * 2 + m2; const size_t off = (size_t)(row0 + ai * HALF + m * 16) * D + col0;
#pragma unroll
                        for (int bj = 0; bj < 2; ++bj) *(u32x4*)(out + off + bj * HALF) = pack8(bs[m2][bj][0] + acc[ai][bj][m][0] + bv[bj][0], bs[m2][bj][1] + acc[ai][bj][m][1] + bv[bj][1]); }
                    asm volatile("" ::: "memory");
                }
            }
        }
    }
};
__device__ __forceinline__ float quad_sum(float s) { s += __shfl_xor(s, 16); s += __shfl_xor(s, 32); return s; }
__device__ __forceinline__ u32x4 pack8(const f32x4 a, const f32x4 b) { u32x4 w; w.x = cvt_pk_bf16(a[0], a[1]); w.y = cvt_pk_bf16(a[2], a[3]); w.z = cvt_pk_bf16(b[0], b[1]); w.w = cvt_pk_bf16(b[2], b[3]); return w; }
__device__ __forceinline__ float sumsq8(const f32x4 a, const f32x4 b) { return (a[0] * a[0] + a[1] * a[1]) + (a[2] * a[2] + a[3] * a[3]) + (b[0] * b[0] + b[1] * b[1]) + (b[2] * b[2] + b[3] * b[3]); }
struct EpiCL {
    static constexpr bool PERM = true;
    const float* rstd2; bf16* CL; float* SSP;
    __device__ __forceinline__ void operator()(const Acc& acc, const Unit& u, int wr, int wc, int fr, int fq) const {
        const int row0 = u.pm * BM + wr * 64 + fr;
        float rsv[8];
#pragma unroll
        for (int q = 0; q < 8; ++q) rsv[q] = rstd2[row0 + (q >> 2) * HALF + (q & 3) * 16];
#pragma unroll
        for (int ai = 0; ai < 2; ++ai) if ((u.am >> ai) & 1)
#pragma unroll
            for (int m = 0; m < 4; ++m) { const int row = row0 + ai * HALF + m * 16; const float rs = rsv[ai * 4 + m];
#pragma unroll
                for (int bj = 0; bj < 2; ++bj) { const f32x4 v0 = acc[ai][bj][m][0] * rs, v1 = acc[ai][bj][m][1] * rs; const float ss = quad_sum(sumsq8(v0, v1));
                    *(u32x4*)(CL + (size_t)row * NCL + u.pn * BM + bj * HALF + wc * 32 + fq * 8) = pack8(v0, v1);
                    const int g = u.pn * 8 + bj * 4 + wc; if (fq == 0) SSP[row * 32 + (g < 10 ? g : g + 2)] = ss; } }
    }
};
struct EpiQ {
    static constexpr bool PERM = true;
    const float* SSP; bf16* QRAW; float* SSQ;
    __device__ __forceinline__ void operator()(const Acc& acc, const Unit& u, int wr, int wc, int fr, int fq) const {
        const int row0 = u.pm * BM + wr * 64 + fr;
        float rsv[8];
#pragma unroll
        for (int q = 0; q < 8; ++q) { const int row = row0 + (q >> 2) * HALF + (q & 3) * 16;
            const f32x4 s0 = *(const f32x4*)(SSP + row * 32 + 12), s1 = *(const f32x4*)(SSP + row * 32 + 16), s2 = *(const f32x4*)(SSP + row * 32 + 20);
            rsv[q] = ((s0[0] + s0[1]) + (s0[2] + s0[3])) + ((s1[0] + s1[1]) + (s1[2] + s1[3])) + ((s2[0] + s2[1]) + (s2[2] + s2[3]));
            if (q == 3) asm volatile("" : "+v"(rsv[0]), "+v"(rsv[1]), "+v"(rsv[2]), "+v"(rsv[3]) :: "memory"); }
#pragma unroll
        for (int q = 0; q < 8; ++q) rsv[q] = fast_rsqrt(rsv[q] * (1.0f / QLR) + EPS);
#pragma unroll
        for (int ai = 0; ai < 2; ++ai) if ((u.am >> ai) & 1)
#pragma unroll
            for (int m = 0; m < 4; ++m) { const int row = row0 + ai * HALF + m * 16; const float rs = rsv[ai * 4 + m];
#pragma unroll
                for (int bj = 0; bj < 2; ++bj) { const f32x4 v0 = acc[ai][bj][m][0] * rs, v1 = acc[ai][bj][m][1] * rs; const float ss = quad_sum(sumsq8(v0, v1));
                    *(u32x4*)(QRAW + (size_t)row * 1536 + u.pn * BM + bj * HALF + wc * 32 + fq * 8) = pack8(v0, v1);
                    if (fq == 0) SSQ[row * 48 + u.pn * 8 + bj * 4 + wc] = ss; } }
    }
};
struct EpiKV {
    static constexpr bool PERM = true;
    const float* SSP; bf16* KN; bf16* VV; float* SSK;
    __device__ __forceinline__ void operator()(const Acc& acc, const Unit& u, int wr, int wc, int fr, int fq) const {
        const int row0 = u.pm * BM + wr * 64 + fr;
        float rsv[8];
#pragma unroll
        for (int q = 0; q < 8; ++q) { const int row = row0 + (q >> 2) * HALF + (q & 3) * 16;
            const f32x4 s0 = *(const f32x4*)(SSP + row * 32), s1 = *(const f32x4*)(SSP + row * 32 + 4);
            rsv[q] = ((s0[0] + s0[1]) + (s0[2] + s0[3])) + ((s1[0] + s1[1]) + (s1[2] + s1[3])); }
#pragma unroll
        for (int q = 0; q < 8; ++q) rsv[q] = fast_rsqrt(rsv[q] * (1.0f / KVR) + EPS);
#pragma unroll
        for (int ai = 0; ai < 2; ++ai) if ((u.am >> ai) & 1)
#pragma unroll
            for (int m = 0; m < 4; ++m) { const int row = row0 + ai * HALF + m * 16; const float rs = rsv[ai * 4 + m];
                { const f32x4 v0 = acc[ai][0][m][0] * rs, v1 = acc[ai][0][m][1] * rs; const float ss = quad_sum(sumsq8(v0, v1));
                  *(u32x4*)(KN + (size_t)row * D + u.pn * 128 + wc * 32 + fq * 8) = pack8(v0, v1);
                  if (fq == 0) SSK[row * 32 + u.pn * 4 + wc] = ss; }
                { const f32x4 v0 = acc[ai][1][m][0] * rs, v1 = acc[ai][1][m][1] * rs; const int b = row / SEQ, sq = row % SEQ;
                  *(u32x4*)(VV + (((size_t)b * NH + u.pn) * SEQ + sq) * DV + wc * 32 + fq * 8) = pack8(v0, v1); } }
    }
};

__device__ __forceinline__ void moe_setup(const int* CNT, LAS int* pref, LAS int* cnts) {
    const int tid = threadIdx.x; LAS int* spre = pref + 40;
    if (tid < 64) { const int c = tid < 32 ? (int)__hip_atomic_load((const unsigned*)CNT + tid * 64, __ATOMIC_RELAXED, __HIP_MEMORY_SCOPE_AGENT) : 0;
        const int nt = (c + 255) >> 8, rem = c - ((nt - 1) << 8), sm = (nt > 0 && rem <= 128) ? 1 : 0; int ib = nt - sm, is = sm;
#pragma unroll
        for (int o = 1; o < 32; o <<= 1) { const int v = __shfl_up(ib, o), w = __shfl_up(is, o); if (tid >= o) { ib += v; is += w; } }
        if (tid < 32) { pref[tid + 1] = ib; spre[tid + 1] = is; cnts[tid] = c; } if (tid == 0) { pref[0] = 0; spre[0] = 0; } }
    __syncthreads();
}
template <class Epi, bool GATHER> struct MoeP {
    static constexpr bool PERM = true;
    const char* A; int lda; int a_shift; const char* Bt; size_t b_estride; int K; const int4* LIST; const LAS int* pref; const LAS int* cnts; int G, c, nunits; Epi E;
    __device__ __forceinline__ bool next(int i, Unit& u) const {
        int L = i * G + c; const int nfull = (nunits / G) * G; int am = 3;
        if (L >= nfull) { const int hu = L - nfull; L = nfull + (hu >> 1); am = 1 << (hu & 1); }
        if (L >= nunits) return false;
        const int r = L >> 2, lane = threadIdx.x & 63; const LAS int* spre = pref + 40; const int nbig = __builtin_amdgcn_readfirstlane(pref[32]);
        int e, pm;
        if (r < nbig) { const int v = pref[(lane & 31) + 1]; e = __builtin_popcountll(__ballot(lane < 32 && r >= v)); pm = r - __builtin_amdgcn_readfirstlane(pref[e]); }
        else { const int q = r - nbig; const int v = spre[(lane & 31) + 1]; e = __builtin_popcountll(__ballot(lane < 32 && q >= v)); pm = ((__builtin_amdgcn_readfirstlane(cnts[e]) + 255) >> 8) - 1; }
        u.pn = L & 3; u.e = e; u.r = r; u.pm = pm; const int rem = __builtin_amdgcn_readfirstlane(cnts[e]) - BM * pm; u.nvalid = rem < BM ? rem : BM; u.am = (u.nvalid > HALF) ? am : (am & 1); return true;
    }
    __device__ __forceinline__ const char* b_base(const Unit& u) const { return Bt + (size_t)u.e * b_estride + (size_t)u.pn * BM * K * 2; }
    __device__ __forceinline__ void a_off(const Unit& u, const int (&sR)[2], const int (&sC)[2], unsigned (&ao)[4]) const {
        if constexpr (GATHER) {
            const int4* lp = LIST + (size_t)u.e * T + u.pm * BM;
#pragma unroll
            for (int h = 0; h < 2; ++h)
#pragma unroll
                for (int i = 0; i < 2; ++i) { const int row = h * HALF + sR[i]; int ent = lp[row].x; ent = row < u.nvalid ? ent : 0; ao[h * 2 + i] = (unsigned)((ent >> a_shift) * lda + sC[i]) * 2u; }
        } else {
#pragma unroll
            for (int h = 0; h < 2; ++h)
#pragma unroll
                for (int i = 0; i < 2; ++i) ao[h * 2 + i] = (unsigned)((u.r * BM + h * HALF + sR[i]) * lda + sC[i]) * 2u;
        }
    }
    __device__ __forceinline__ void epi(const Acc& acc, const Unit& u, int wr, int wc, int fr, int fq) const { E(acc, u, wr, wc, fr, fq, LIST + (size_t)u.e * T + u.pm * BM); }
};
struct EpiSwiglu {
    bf16* ACTS; int* POS;
    __device__ __forceinline__ void operator()(const Acc& acc, const Unit& u, int wr, int wc, int fr, int fq, const int4* lp) const {
        int4 rec[8];
#pragma unroll
        for (int q = 0; q < 8; ++q) { const int row = (q >> 2) * HALF + wr * 64 + (q & 3) * 16 + fr; rec[q] = lp[row]; }
#pragma unroll
        for (int ai = 0; ai < 2; ++ai) if ((u.am >> ai) & 1)
#pragma unroll
            for (int m = 0; m < 4; ++m) { const int q = ai * 4 + m, row = ai * HALF + wr * 64 + m * 16 + fr; const float rs = __int_as_float(rec[q].y);
                const f32x4 a0 = acc[ai][0][m][0] * rs, a1 = acc[ai][0][m][1] * rs, b0 = acc[ai][1][m][0] * rs, b1 = acc[ai][1][m][1] * rs;
                float o[8];
#pragma unroll
                for (int j = 0; j < 4; ++j) { o[j] = a0[j] * fast_sigmoid(a0[j]) * b0[j]; o[4 + j] = a1[j] * fast_sigmoid(a1[j]) * b1[j]; }
                u32x4 w; w.x = cvt_pk_bf16(o[0], o[1]); w.y = cvt_pk_bf16(o[2], o[3]); w.z = cvt_pk_bf16(o[4], o[5]); w.w = cvt_pk_bf16(o[6], o[7]);
                *(u32x4*)(ACTS + (size_t)(u.r * BM + row) * DE + u.pn * 128 + wc * 32 + fq * 8) = w;
                if (u.pn == 0 && wc == 0 && fq == 0 && row < u.nvalid) POS[rec[q].x] = u.r * BM + row; }
    }
};
struct EpiDown {
    bf16* YS;
    __device__ __forceinline__ void operator()(const Acc& acc, const Unit& u, int wr, int wc, int fr, int fq, const int4*) const {
#pragma unroll
        for (int ai = 0; ai < 2; ++ai) if ((u.am >> ai) & 1)
#pragma unroll
            for (int m = 0; m < 4; ++m) { const int row = ai * HALF + wr * 64 + m * 16 + fr;
#pragma unroll
                for (int bj = 0; bj < 2; ++bj) *(u32x4*)(YS + (size_t)(u.r * BM + row) * D + u.pn * BM + bj * HALF + wc * 32 + fq * 8) = pack8(acc[ai][bj][m][0], acc[ai][bj][m][1]); }
    }
};
}


namespace at {
typedef short s16x4 __attribute__((ext_vector_type(4)));
typedef float f32x16 __attribute__((ext_vector_type(16)));
constexpr int KTB = 64 * 192  , VTB = 64 * 256, LDS_K = 0, LDS_V = 2 * KTB, LDS_AL = LDS_V + 2 * VTB, LDS_TOTAL = LDS_AL + 8 * 256;
constexpr float SC2 = SM_SCALE * 1.4426950408889634f;
constexpr float SQ2 = 0.32263132f;
constexpr float THR2 = 11.0f;
__device__ __forceinline__ int v_rd_base(int lane) { return ((lane & 3) << 3) | (((lane >> 2) & 3) << 6) | (((lane >> 4) & 1) << 5) | (((lane >> 5) & 1) << 8); }
constexpr int v_rd_off(int d0, int ks, int half) { return d0 * 512 + ks * 4096 + half * 2048; }
__device__ __forceinline__ int crow(int r, int hi) { return (r & 3) + 8 * (r >> 2) + 4 * hi; }
#define AT_SBAR() __builtin_amdgcn_sched_barrier(0)

typedef int i32x8 __attribute__((ext_vector_type(8)));
typedef int i32x4v __attribute__((ext_vector_type(4)));
template <int BUF>
__device__ __forceinline__ void tile_compute(f32x16 (&o)[4], const i32x8 (&qr)[3], float& m_run, float& l_run, f32x16& negm, const LAS char* kl,
                                             int vb0, LAS float* al_l, int r32, int hi) {
    f32x16 p0, p1;
#define AT_LOADK(kf, S_, blk_) do { const i32x4v a_ = *(const LAS i32x4v*)(kl + (S_) * 4096 + (blk_) * 1024 + BUF * KTB), b_ = *(const LAS i32x4v*)(kl + (S_) * 4096 + (blk_) * 1024 + 512 + BUF * KTB); \
        kf = (i32x8){a_[0], a_[1], a_[2], a_[3], b_[0], b_[1], b_[2], b_[3]}; } while (0)
#define AT_MMAK(P, kf, S_) do { __builtin_amdgcn_s_setprio(1); P = __builtin_amdgcn_mfma_scale_f32_32x32x64_f8f6f4(kf, qr[S_], (S_) == 0 ? negm : P, 0, 0, 0, 0x7f7f7f7f, 0, 0x7f7f7f7f); __builtin_amdgcn_s_setprio(0); } while (0)
    { i32x8 kfA, kfB;
      AT_LOADK(kfA, 0, 0); AT_LOADK(kfB, 0, 1); AT_SBAR();
      AT_MMAK(p0, kfA, 0); AT_SBAR(); AT_LOADK(kfA, 1, 0); AT_SBAR(); AT_MMAK(p1, kfB, 0); AT_SBAR(); AT_LOADK(kfB, 1, 1); AT_SBAR();
      AT_MMAK(p0, kfA, 1); AT_SBAR(); AT_LOADK(kfA, 2, 0); AT_SBAR(); AT_MMAK(p1, kfB, 1); AT_SBAR(); AT_LOADK(kfB, 2, 1); AT_SBAR();
      AT_MMAK(p0, kfA, 2); AT_SBAR(); AT_MMAK(p1, kfB, 2); AT_SBAR(); }
#undef AT_LOADK
#undef AT_MMAK
#define AT_TRRD(dst, off) asm volatile("ds_read_b64_tr_b16 %0, %1 offset:%2" : "=&v"(dst) : "v"(vb0), "i"(off) : "memory")
#define AT_VRD(X, d0) do { constexpr int b_ = BUF * VTB + v_rd_off(d0, 0, 0); \
        AT_TRRD(l##X##0, b_); AT_TRRD(h##X##0, b_ + 2048); AT_TRRD(l##X##1, b_ + 4096); AT_TRRD(h##X##1, b_ + 6144); AT_TRRD(l##X##2, b_ + 8192); AT_TRRD(h##X##2, b_ + 10240); AT_TRRD(l##X##3, b_ + 12288); AT_TRRD(h##X##3, b_ + 14336); } while (0)
#define AT_WAITL(n) do { asm volatile("s_waitcnt lgkmcnt(" #n ")" ::: "memory"); AT_SBAR(); } while (0)
#define AT_PVM(X, d0) do { \
        o[d0] = __builtin_amdgcn_mfma_f32_32x32x16_bf16(pa0, (bf16x8){l##X##0[0], l##X##0[1], l##X##0[2], l##X##0[3], h##X##0[0], h##X##0[1], h##X##0[2], h##X##0[3]}, o[d0], 0, 0, 0); \
        o[d0] = __builtin_amdgcn_mfma_f32_32x32x16_bf16(pa1, (bf16x8){l##X##1[0], l##X##1[1], l##X##1[2], l##X##1[3], h##X##1[0], h##X##1[1], h##X##1[2], h##X##1[3]}, o[d0], 0, 0, 0); \
        o[d0] = __builtin_amdgcn_mfma_f32_32x32x16_bf16(pa2, (bf16x8){l##X##2[0], l##X##2[1], l##X##2[2], l##X##2[3], h##X##2[0], h##X##2[1], h##X##2[2], h##X##2[3]}, o[d0], 0, 0, 0); \
        o[d0] = __builtin_amdgcn_mfma_f32_32x32x16_bf16(pa3, (bf16x8){l##X##3[0], l##X##3[1], l##X##3[2], l##X##3[3], h##X##3[0], h##X##3[1], h##X##3[2], h##X##3[3]}, o[d0], 0, 0, 0); } while (0)
    s16x4 lA0, lA1, lA2, lA3, hA0, hA1, hA2, hA3, lB0, lB1, lB2, lB3, hB0, hB1, hB2, hB3;
    AT_VRD(A, 0); AT_VRD(B, 1); AT_SBAR();
    float pmax = p0[0];
#pragma unroll
    for (int r = 1; r < 16; ++r) pmax = fmaxf(pmax, p0[r]);
#pragma unroll
    for (int r = 0; r < 16; ++r) pmax = fmaxf(pmax, p1[r]);
    { auto rr = __builtin_amdgcn_permlane32_swap(__float_as_uint(pmax), __float_as_uint(pmax), false, false); pmax = fmaxf(__uint_as_float(rr[0]), __uint_as_float(rr[1])); }
    float alpha = 1.f;
    if (!__all(pmax <= THR2)) {
        const float d = fmaxf(pmax, 0.f); alpha = __builtin_amdgcn_exp2f(-d); m_run += d;
#pragma unroll
        for (int r = 0; r < 16; ++r) { p0[r] -= d; p1[r] -= d; negm[r] = -m_run; } }
#pragma unroll
    for (int r = 0; r < 16; ++r) { p0[r] = __builtin_amdgcn_exp2f(p0[r]); p1[r] = __builtin_amdgcn_exp2f(p1[r]); }
    float ps = 0.f;
#pragma unroll
    for (int r = 0; r < 16; ++r) ps += p0[r];
#pragma unroll
    for (int r = 0; r < 16; ++r) ps += p1[r];
    { auto rr = __builtin_amdgcn_permlane32_swap(__float_as_uint(ps), __float_as_uint(ps), false, false); ps = __uint_as_float(rr[0]) + __uint_as_float(rr[1]); }
    l_run = l_run * alpha + ps;
    bf16x8 pa0, pa1, pa2, pa3;
#define AT_PK4(P, B_, OUT) do { unsigned a0 = cvt_pk_bf16(P[B_+0], P[B_+1]), a1 = cvt_pk_bf16(P[B_+2], P[B_+3]); \
        unsigned b0 = cvt_pk_bf16(P[B_+4], P[B_+5]), b1 = cvt_pk_bf16(P[B_+6], P[B_+7]); \
        auto r0 = __builtin_amdgcn_permlane32_swap(a0, b0, false, false); auto r1 = __builtin_amdgcn_permlane32_swap(a1, b1, false, false); \
        u32x4 w = {r0[0], r1[0], r0[1], r1[1]}; OUT = *reinterpret_cast<bf16x8*>(&w); } while (0)
    AT_PK4(p0, 0, pa0); AT_PK4(p0, 8, pa1); AT_PK4(p1, 0, pa2); AT_PK4(p1, 8, pa3);
#undef AT_PK4
    if (__any(alpha < 1.f)) { if (hi == 0) al_l[r32] = alpha; asm volatile("s_waitcnt lgkmcnt(0)" ::: "memory");
#pragma unroll
        for (int d_ = 0; d_ < 4; ++d_)
#pragma unroll
            for (int r = 0; r < 16; ++r) o[d_][r] *= al_l[crow(r, hi)]; }
    AT_SBAR();
    AT_WAITL(8); AT_PVM(A, 0); AT_SBAR(); AT_VRD(A, 2);
    AT_WAITL(8); AT_PVM(B, 1); AT_SBAR(); AT_VRD(B, 3);
    AT_WAITL(8); AT_PVM(A, 2); AT_SBAR();
    AT_WAITL(0); AT_PVM(B, 3); AT_SBAR();
#undef AT_TRRD
#undef AT_VRD
#undef AT_WAITL
#undef AT_PVM
}

struct AttnArgs { const bf16* QRAW; const float* SSQ; const float* qg; const float* CS; const unsigned char* KK8; const bf16* VV; bf16* O; };

__device__ __forceinline__ void attn_phase(LAS unsigned char* lds, const AttnArgs& A, int G, int bx) {
    int tid_ = threadIdx.x; asm volatile("" : "+v"(tid_));
    const int tid = tid_, wid = __builtin_amdgcn_readfirstlane(tid >> 6), lane = tid & 63, r32 = lane & 31, hi = lane >> 5;
    const unsigned voffK = (unsigned)lane * 16u;
    unsigned voffV; { const int ob = (wid * 2 * 64 + lane) * 16, sub = ob >> 9, within = ob & 511, kk = (sub >> 2) * 8 + (within >> 6), cc = (sub & 3) * 32 + ((within & 63) >> 1);
        const int k = (kk & ~0xC) | ((kk & 4) << 1) | ((kk & 8) >> 1); voffV = (unsigned)(k * 256 + cc * 2); }
    const __amdgpu_buffer_rsrc_t rsK = __builtin_amdgcn_make_buffer_rsrc((void*)A.KK8, 0, NB * NH * (SEQ / 64) * KTB, 0x00020000), rsV = __builtin_amdgcn_make_buffer_rsrc((void*)A.VV, 0, T * NH * DV * 2, 0x00020000);
    const LAS char* kl = (const LAS char*)lds + LDS_K + hi * 2048 + r32 * 16;
    const int vb0 = LDS_V + v_rd_base(lane);
    LAS float* al_l = (LAS float*)(lds + LDS_AL) + wid * 64; LAS float* li_l = al_l + 32;
    const int vcu = (G % 8 == 0) ? (bx % 8) * (G / 8) + bx / 8 : bx;
#define AT_ISSUE(t, buf) do { const int ks_ = kbase + (t) * KTB, vs_ = vbase + (t) * VTB; \
        __builtin_amdgcn_raw_ptr_buffer_load_lds(rsK, (LAS void*)(lds + LDS_K + (buf) * KTB + wid * 1024), 16, voffK, ks_ + wid * 1024, 0, 0); \
        if (wid < 4) __builtin_amdgcn_raw_ptr_buffer_load_lds(rsK, (LAS void*)(lds + LDS_K + (buf) * KTB + (wid + 8) * 1024), 16, voffK, ks_ + (wid + 8) * 1024, 0, 0); \
        _Pragma("unroll") for (int i_ = 0; i_ < 2; ++i_) __builtin_amdgcn_raw_ptr_buffer_load_lds(rsV, (LAS void*)(lds + LDS_V + (buf) * VTB + (wid * 2 + i_) * 1024), 16, voffV, vs_ + i_ * 128, 0, 0); } while (0)
    for (int item = vcu; item < NB * NH * 16; item += G) {
        const int bh = item >> 4, pr = item & 15, b = bh / NH, h = bh % NH;
        const int kbase = bh * ((SEQ / 64) * KTB), vbase = bh * (SEQ * DV * 2);
        for (int pass = 0; pass < 2; ++pass) {
            const int qb = pass == 0 ? 31 - pr : pr, NT = 4 * (qb + 1), myNT = 4 * qb + (wid >> 1) + 1;
            AT_ISSUE(0, 0);
            i32x8 qr[3];
            { const int t = b * SEQ + qb * 256 + wid * 32 + r32; const bf16* qp = A.QRAW + (size_t)t * 1536 + h * DQK;
              const f32x2* sq = (const f32x2*)(A.SSQ + (size_t)t * 48 + h * 6); const f32x2 s0 = sq[0], s1 = sq[1], s2 = sq[2];
              const float rq = fast_rsqrt(((s0[0] + s0[1]) + (s1[0] + s1[1]) + (s2[0] + s2[1])) * (1.0f / DQK) + EPS) * SQ2;
#pragma unroll
              for (int S = 0; S < 2; ++S) { unsigned w[8];
#pragma unroll
                  for (int g = 0; g < 4; ++g) { const int d0 = 64 * S + 32 * hi + 8 * g; const bf16x8 raw = *(const bf16x8*)(qp + d0); const f32x4 g0 = *(const f32x4*)(A.qg + d0), g1 = *(const f32x4*)(A.qg + d0 + 4);
                      float x[8];
#pragma unroll
                      for (int e = 0; e < 8; ++e) x[e] = __uint_as_float(((unsigned)(unsigned short)raw[e]) << 16) * (e < 4 ? g0[e] : g1[e - 4]) * rq;
                      const u32x2 pk = pack_fp8x8(x); w[2 * g] = pk.x; w[2 * g + 1] = pk.y; }
                  qr[S] = (i32x8){(int)w[0], (int)w[1], (int)w[2], (int)w[3], (int)w[4], (int)w[5], (int)w[6], (int)w[7]}; }
              { unsigned w[8];
#pragma unroll
                  for (int g = 0; g < 4; ++g) { const int j0 = 8 * g; const bf16x8 r1 = *(const bf16x8*)(qp + 128 + j0), r2 = *(const bf16x8*)(qp + 160 + j0);
                      const f32x4 ga0 = *(const f32x4*)(A.qg + 128 + j0), ga1 = *(const f32x4*)(A.qg + 132 + j0), gb0 = *(const f32x4*)(A.qg + 160 + j0), gb1 = *(const f32x4*)(A.qg + 164 + j0);
                      const float* cp = A.CS + (size_t)t * 64 + j0; const f32x4 c0 = *(const f32x4*)cp, c1 = *(const f32x4*)(cp + 4), n0 = *(const f32x4*)(cp + 32), n1 = *(const f32x4*)(cp + 36);
                      float y[8];
#pragma unroll
                      for (int e = 0; e < 8; ++e) { const float x1 = __uint_as_float(((unsigned)(unsigned short)r1[e]) << 16) * (e < 4 ? ga0[e] : ga1[e - 4]) * rq, x2 = __uint_as_float(((unsigned)(unsigned short)r2[e]) << 16) * (e < 4 ? gb0[e] : gb1[e - 4]) * rq;
                          const float c = e < 4 ? c0[e] : c1[e - 4], sn = e < 4 ? n0[e] : n1[e - 4]; y[e] = hi == 0 ? (x1 * c - x2 * sn) : (x1 * sn + x2 * c); }
                      const u32x2 pk = pack_fp8x8(y); w[2 * g] = pk.x; w[2 * g + 1] = pk.y; }
                  qr[2] = (i32x8){(int)w[0], (int)w[1], (int)w[2], (int)w[3], (int)w[4], (int)w[5], (int)w[6], (int)w[7]}; } }
            float m_run = 0.f, l_run = 0.f; f32x16 o[4] = {}; f32x16 negm = {};
            for (int t = 0; t < NT; t += 2) {
                asm volatile("s_waitcnt vmcnt(0)" ::: "memory"); __builtin_amdgcn_s_barrier();
                AT_ISSUE(t + 1, 1);
                if (t < myNT) tile_compute<0>(o, qr, m_run, l_run, negm, kl, vb0, al_l, r32, hi);
                asm volatile("s_waitcnt vmcnt(0)" ::: "memory"); __builtin_amdgcn_s_barrier();
                if (t + 2 < NT) AT_ISSUE(t + 2, 0);
                if (t + 1 < myNT) tile_compute<1>(o, qr, m_run, l_run, negm, kl, vb0, al_l, r32, hi);
            }
            if (hi == 0) li_l[r32] = l_run; asm volatile("s_waitcnt lgkmcnt(0)" ::: "memory");
            bf16* Ow = A.O + (size_t)(b * SEQ + qb * 256 + wid * 32) * D + h * DV + (size_t)(4 * hi) * D + r32;
            asm volatile("" : "+v"(Ow));
#pragma unroll
            for (int r = 0; r < 16; ++r) { const int orow = crow(r, hi); const float rl = __builtin_amdgcn_rcpf(li_l[orow]);
#pragma unroll
                for (int d0 = 0; d0 < 4; ++d0) { const float v = o[d0][r] * rl; const float vn = __shfl_xor(v, 1);
                    if ((r32 & 1) == 0) *(unsigned*)(Ow + (size_t)((r & 3) + 8 * (r >> 2)) * D + d0 * 32) = cvt_pk_bf16(v, vn); } }
        }
    }
    asm volatile("s_waitcnt vmcnt(0)" ::: "memory"); __builtin_amdgcn_s_barrier();
#undef AT_ISSUE
}
#undef AT_SBAR
}


namespace th {
#define TH_LDS_WAIT() asm volatile("s_waitcnt lgkmcnt(0)" ::: "memory")
__device__ __forceinline__ void tr_item(const float* W, int K, int N, bf16* Wt, int row_off, const float* gain, int half, LAS float* scr, int item, int lane) {
    const int nblk = N / 32, kb = item / nblk, nb = item % nblk, k0 = 64 * kb, n0 = 32 * nb;
    const int kr = lane >> 3, c4 = (lane & 7) * 4;
    f32x4 v[8]; float g[8];
#pragma unroll
    for (int i = 0; i < 8; ++i) { v[i] = __builtin_nontemporal_load((const f32x4*)(W + (size_t)(k0 + 8 * i + kr) * N + n0 + c4)); g[i] = gain ? gain[k0 + 8 * i + kr] : 1.0f; }
#pragma unroll
    for (int i = 0; i < 8; ++i) { LAS float* d = scr + (8 * i + kr) * 33 + c4; d[0] = v[i][0] * g[i]; d[1] = v[i][1] * g[i]; d[2] = v[i][2] * g[i]; d[3] = v[i][3] * g[i]; }
    TH_LDS_WAIT(); asm volatile("" ::: "memory");
    const int c = lane & 7;
#pragma unroll
    for (int j = 0; j < 4; ++j) { const int n = (lane >> 3) + 8 * j; const LAS float* sp = scr + (8 * c) * 33 + n; const int nn = n0 + n, nr = half ? pair_row(nn, half) : nn;
        u32x4 o; o.x = cvt_pk_bf16(sp[0 * 33], sp[1 * 33]); o.y = cvt_pk_bf16(sp[2 * 33], sp[3 * 33]); o.z = cvt_pk_bf16(sp[4 * 33], sp[5 * 33]); o.w = cvt_pk_bf16(sp[6 * 33], sp[7 * 33]);
        *(u32x4*)(Wt + (size_t)(row_off + nr) * K + k0 + 8 * c) = o; }
    TH_LDS_WAIT(); asm volatile("" ::: "memory");
}
struct P0Args { const float* const* in; unsigned char* ws; };
__device__ __forceinline__ void prologue(LAS unsigned char* lds, const float* const (&in)[30], unsigned char* ws, int G, int bx) {
    int tid_ = threadIdx.x; asm volatile("" : "+v"(tid_));
    const int tid = tid_, lane = tid & 63, wave = __builtin_amdgcn_readfirstlane(tid >> 6);
    LAS float* scr = (LAS float*)(lds + wave * 16384);
    const int gw = bx * NWAVES_ + wave, NGW = G * NWAVES_;
    bf16 *W1t = (bf16*)(ws + WS_W1T), *W2t = (bf16*)(ws + WS_W2T), *Wc = (bf16*)(ws + WS_WC), *Wukv = (bf16*)(ws + WS_WUKV), *Wuq = (bf16*)(ws + WS_WUQ), *Wo = (bf16*)(ws + WS_WO),
         *Wgu = (bf16*)(ws + WS_WGU), *Wd = (bf16*)(ws + WS_WD);
    constexpr int I_W1 = 16 * 64, I_W2 = 16 * 32, I_DKV = 16 * 8, I_KR = 16 * 2, I_DQ = 16 * 12, I_UKV = 4 * 64, I_UQ = 6 * 48, I_WO = 16 * 32, I_GU1 = 16 * 32, I_D1 = 8 * 32;
    constexpr int NIT = I_W1 + I_W2 + I_DKV + I_KR + I_DQ + I_UKV + I_UQ + I_WO + 64 * I_GU1 + 64 * I_D1;
    for (int it = gw; it < NIT; it += NGW) {
        int r = it;
        if (r < 64 * I_GU1) { const int e = r / I_GU1; tr_item(in[28] + (size_t)e * D * 1024, D, 1024, Wgu + (size_t)e * 1024 * D, 0, in[23] + (e / NE) * D, 512, scr, r % I_GU1, lane); continue; } r -= 64 * I_GU1;
        if (r < 64 * I_D1) { const int e = r / I_D1; tr_item(in[29] + (size_t)e * DE * D, DE, D, Wd + (size_t)e * D * DE, 0, nullptr, 0, scr, r % I_D1, lane); continue; } r -= 64 * I_D1;
        if (r < I_W1) { tr_item(in[3], D, 2048, W1t, 0, in[2], 1024, scr, r, lane); continue; } r -= I_W1;
        if (r < I_W2) { tr_item(in[9], D, D, W2t, 0, nullptr, 0, scr, r, lane); continue; } r -= I_W2;
        if (r < I_DKV) { tr_item(in[12], D, KVR, Wc, 0, in[11], 0, scr, r, lane); continue; } r -= I_DKV;
        if (r < I_KR) { tr_item(in[14], D, DROPE, Wc, 256, in[11], 0, scr, r, lane); continue; } r -= I_KR;
        if (r < I_DQ) { tr_item(in[18], D, QLR, Wc, 320, in[17], 0, scr, r, lane); continue; } r -= I_DQ;
        if (r < I_UKV) { tr_item(in[15], KVR, 2048, Wukv, 0, in[13], 0, scr, r, lane); continue; } r -= I_UKV;
        if (r < I_UQ) { tr_item(in[20], QLR, 1536, Wuq, 0, in[19], 0, scr, r, lane); continue; } r -= I_UQ;
        tr_item(in[22], D, D, Wo, 0, nullptr, 0, scr, r, lane);
    }
    const int gt = bx * (NWAVES_ * 64) + tid, NGT = G * NWAVES_ * 64;
    for (int i = gt; i < 64 * D / 8; i += NGT) ((u32x4*)(Wc + (size_t)704 * D))[i] = (u32x4){0u, 0u, 0u, 0u};
    { float* Wr = (float*)(ws + WS_WR);
      for (int i = gt; i < 2 * D * NRT; i += NGT) { const int c = i % NRT, k = (i / NRT) % D, l = i / (NRT * D);
          const float w = c < NG ? in[24][((size_t)l * D + k) * NG + c] : in[26][((size_t)l * D + k) * NE + (c - NG)];
          Wr[(size_t)l * D * NRT + ((((k >> 5) * 4 + ((k >> 3) & 3)) * NRT + c) * 8) + (k & 7)] = w * in[23][l * D + k]; } }
    { float* cs = (float*)(ws + WS_CS); const int* pos = (const int*)in[1];
      for (int i = gt; i < T * 32; i += NGT) { const int t = i >> 5, f = i & 31; const float ang = (float)pos[t] * INV_FREQ[f]; double sn, c; sincos_d((double)ang, sn, c); cs[(size_t)t * 64 + f] = (float)c; cs[(size_t)t * 64 + 32 + f] = (float)sn; } }
    { const float* x = in[0]; bf16* xb = (bf16*)(ws + WS_R1); float* rstd = (float*)(ws + WS_RSTD0);
      for (int row = gw; row < T; row += NGW) { const f32x4* xr = (const f32x4*)(x + (size_t)row * D); float ss = 0.f;
#pragma unroll
          for (int j = 0; j < 4; ++j) { const f32x4 v = xr[lane + 64 * j]; ss += (v[0] * v[0] + v[1] * v[1]) + (v[2] * v[2] + v[3] * v[3]);
              u32x2 o; o.x = cvt_pk_bf16(v[0], v[1]); o.y = cvt_pk_bf16(v[2], v[3]); ((u32x2*)(xb + (size_t)row * D))[lane + 64 * j] = o; }
          ss = wave_sum(ss); if (lane == 0) rstd[row] = fast_rsqrt(ss * (1.0f / D) + EPS); } }
}
__device__ __forceinline__ void conv_ln(LAS unsigned char* lds, const bf16* U, const float* dw_w, const float* dw_b, const float* ln_g, const float* ln_b, bf16* Vb, int G, int bx) {
    int tid_ = threadIdx.x; asm volatile("" : "+v"(tid_));
    const int tid = tid_, lane = tid & 63, wave = __builtin_amdgcn_readfirstlane(tid >> 6);
    LAS float* tile = (LAS float*)lds;
    const int c0 = tid * 2;
    float w0[CONVW], w1[CONVW];
#pragma unroll
    for (int j = 0; j < CONVW; ++j) { const f32x2 w = *(const f32x2*)(dw_w + j * D + c0); w0[j] = w[0]; w1[j] = w[1]; }
    const f32x2 bb = *(const f32x2*)(dw_b + c0);
    for (int unit = bx; unit < T / 16; unit += G) {
        const int t0 = unit * 16, s0 = t0 & (SEQ - 1);
        float a0[16], a1[16];
#pragma unroll
        for (int r = 0; r < 16; ++r) { a0[r] = bb[0]; a1[r] = bb[1]; }
#define CV_LOAD(dst, ib) do { _Pragma("unroll") for (int k = 0; k < 12; ++k) { const int i = (ib) + k; dst[k] = (i < 46 && s0 - 30 + i >= 0) ? *(const unsigned*)(U + (size_t)(t0 - 30 + i) * D + c0) : 0u; } } while (0)
#define CV_FMA(src, ib) do { _Pragma("unroll") for (int k = 0; k < 12; ++k) { const int i = (ib) + k; if (i < 46) { const float u0 = __uint_as_float(src[k] << 16), u1 = __uint_as_float(src[k] & 0xffff0000u); \
            _Pragma("unroll") for (int r = 0; r < 16; ++r) { const int j = i - r; if (j >= 0 && j < CONVW) { a0[r] = fmaf(w0[j], u0, a0[r]); a1[r] = fmaf(w1[j], u1, a1[r]); } } } } } while (0)
        { unsigned ua[12], ub[12];
          CV_LOAD(ua, 0); asm volatile("" ::: "memory");
          CV_LOAD(ub, 12); asm volatile("" ::: "memory"); CV_FMA(ua, 0);
          CV_LOAD(ua, 24); asm volatile("" ::: "memory"); CV_FMA(ub, 12);
          CV_LOAD(ub, 36); asm volatile("" ::: "memory"); CV_FMA(ua, 24);
          CV_FMA(ub, 36); }
#undef CV_LOAD
#undef CV_FMA
#pragma unroll
        for (int r = 0; r < 16; ++r) *(LAS f32x2*)(tile + r * D + c0) = (f32x2){a0[r], a1[r]};
        __syncthreads();
#pragma unroll
        for (int rr = 0; rr < 2; ++rr) { const int r = wave * 2 + rr; const LAS f32x4* xr = (const LAS f32x4*)(tile + r * D); f32x4 v[4]; float sm = 0.f;
#pragma unroll
            for (int j = 0; j < 4; ++j) { v[j] = xr[lane + 64 * j]; sm += (v[j][0] + v[j][1]) + (v[j][2] + v[j][3]); }
            const float mean = wave_sum(sm) * (1.0f / D); float q = 0.f;
#pragma unroll
            for (int j = 0; j < 4; ++j) { v[j] = v[j] - mean; q += (v[j][0] * v[j][0] + v[j][1] * v[j][1]) + (v[j][2] * v[j][2] + v[j][3] * v[j][3]); }
            const float rs = fast_rsqrt(wave_sum(q) * (1.0f / D) + EPS);
#pragma unroll
            for (int j = 0; j < 4; ++j) { const int c = (lane + 64 * j) * 4; const f32x4 gg = *(const f32x4*)(ln_g + c), bv = *(const f32x4*)(ln_b + c); const f32x4 y = v[j] * rs * gg + bv;
                u32x2 o; o.x = cvt_pk_bf16(y[0] * fast_sigmoid(y[0]), y[1] * fast_sigmoid(y[1])); o.y = cvt_pk_bf16(y[2] * fast_sigmoid(y[2]), y[3] * fast_sigmoid(y[3]));
                ((u32x2*)(Vb + (size_t)(t0 + r) * D))[lane + 64 * j] = o; } }
        __syncthreads();
    }
}
__device__ __forceinline__ void route(LAS unsigned char* lds, const bf16* H, const float* WrP, const float* bg, const float* br, int4* LIST, int* CNT, float* GATE, int G, int bx) {
    int tid_ = threadIdx.x; asm volatile("" : "+v"(tid_));
    const int tid = tid_, lane = tid & 63, wave = __builtin_amdgcn_readfirstlane(tid >> 6), r16 = lane & 15, kq = lane >> 4;
    LAS float* Bs = (LAS float*)lds; LAS float* LG = (LAS float*)(lds + 73728) + wave * (16 * 37);
    constexpr int NTILES = T / 16; const int NW = G * NWAVES_;
    LAS int* lcnt = (LAS int*)(lds + 73728 + 8 * 16 * 37 * 4); LAS int* gbase = lcnt + NE;
    if (tid < NE) lcnt[tid] = 0;
    int e0 = 0, e1 = 0, sl0 = 0, sl1 = 0; float rsv = 0.f, gt0 = 0.f, gt1 = 0.f;
    for (int base = 0; base < NTILES; base += NW) {
        const int tile = base + bx * NWAVES_ + wave; const bool act = tile < NTILES; const int t0 = tile * 16;
        f32x4 c0 = {0.f, 0.f, 0.f, 0.f}, c1 = c0, c2 = c0; float ss = 0.f;
#pragma unroll 1
        for (int half = 0; half < 2; ++half) {
            __syncthreads();
#pragma unroll
            for (int i = 0; i < 9; ++i) ((LAS f32x4*)Bs)[tid + 512 * i] = ((const f32x4*)(WrP + half * 18432))[tid + 512 * i];
            __syncthreads();
            if (act) {
                const bf16* hp = H + (size_t)(t0 + r16) * D + half * 512 + 8 * kq;
#pragma unroll 4
                for (int jj = 0; jj < 16; ++jj) {
                    const u32x4 hw = *(const u32x4*)(hp + 32 * jj);
                    const f32x4 a0 = (f32x4){__uint_as_float(hw.x << 16), __uint_as_float(hw.x & 0xffff0000u), __uint_as_float(hw.y << 16), __uint_as_float(hw.y & 0xffff0000u)};
                    const f32x4 a1 = (f32x4){__uint_as_float(hw.z << 16), __uint_as_float(hw.z & 0xffff0000u), __uint_as_float(hw.w << 16), __uint_as_float(hw.w & 0xffff0000u)};
                    ss += ((a0[0] * a0[0] + a0[1] * a0[1]) + (a0[2] * a0[2] + a0[3] * a0[3])) + ((a1[0] * a1[0] + a1[1] * a1[1]) + (a1[2] * a1[2] + a1[3] * a1[3]));
                    const LAS float* bp = Bs + ((jj * 4 + kq) * NRT + r16) * 8;
                    const f32x4 b00 = *(const LAS f32x4*)bp, b01 = *(const LAS f32x4*)(bp + 4), b10 = *(const LAS f32x4*)(bp + 128), b11 = *(const LAS f32x4*)(bp + 132), b20 = *(const LAS f32x4*)(bp + 256), b21 = *(const LAS f32x4*)(bp + 260);
#pragma unroll
                    for (int i = 0; i < 4; ++i) { c0 = __builtin_amdgcn_mfma_f32_16x16x4f32(a0[i], b00[i], c0, 0, 0, 0); c1 = __builtin_amdgcn_mfma_f32_16x16x4f32(a0[i], b10[i], c1, 0, 0, 0); c2 = __builtin_amdgcn_mfma_f32_16x16x4f32(a0[i], b20[i], c2, 0, 0, 0); }
#pragma unroll
                    for (int i = 0; i < 4; ++i) { c0 = __builtin_amdgcn_mfma_f32_16x16x4f32(a1[i], b01[i], c0, 0, 0, 0); c1 = __builtin_amdgcn_mfma_f32_16x16x4f32(a1[i], b11[i], c1, 0, 0, 0); c2 = __builtin_amdgcn_mfma_f32_16x16x4f32(a1[i], b21[i], c2, 0, 0, 0); }
                }
            }
        }
        if (act) {
            ss += __shfl_xor(ss, 16); ss += __shfl_xor(ss, 32);
#pragma unroll
            for (int rg = 0; rg < 4; ++rg) { LG[(4 * kq + rg) * 37 + r16] = c0[rg]; LG[(4 * kq + rg) * 37 + 16 + r16] = c1[rg]; if (r16 < 4) LG[(4 * kq + rg) * 37 + 32 + r16] = c2[rg]; }
            asm volatile("s_waitcnt lgkmcnt(0)" ::: "memory");
            if (lane < 16) {
                const int t = t0 + lane; const LAS float* lr = LG + lane * 37;
                const float rs = fast_rsqrt(ss * (1.0f / D) + EPS);
                float lg[NG]; int gi = 0; float gm = -3.0e38f;
#pragma unroll
                for (int c = 0; c < NG; ++c) { lg[c] = lr[c] * rs + bg[c]; if (lg[c] > gm) { gm = lg[c]; gi = c; } }
                float gs = 0.f;
#pragma unroll
                for (int c = 0; c < NG; ++c) gs += __expf(lg[c] - gm);
                const float gw = 1.0f / gs;
                float le[EPG]; float em = -3.0e38f;
#pragma unroll
                for (int c = 0; c < EPG; ++c) { le[c] = lr[NG + gi * EPG + c] * rs + br[gi * EPG + c]; em = fmaxf(em, le[c]); }
                int i0 = 0; float v0 = -3.0e38f;
#pragma unroll
                for (int c = 0; c < EPG; ++c) if (le[c] > v0) { v0 = le[c]; i0 = c; }
                int i1 = 0; float v1 = -3.0e38f;
#pragma unroll
                for (int c = 0; c < EPG; ++c) if (c != i0 && le[c] > v1) { v1 = le[c]; i1 = c; }
                const float p0 = __expf(v0 - em), p1 = __expf(v1 - em); const float inv = 1.0f / (p0 + p1);
                e0 = gi * EPG + i0; e1 = gi * EPG + i1; rsv = rs; gt0 = gw * p0 * inv; gt1 = gw * p1 * inv;
                GATE[2 * t] = gt0; GATE[2 * t + 1] = gt1;
                sl0 = __hip_atomic_fetch_add(lcnt + e0, 1, __ATOMIC_RELAXED, __HIP_MEMORY_SCOPE_WORKGROUP);
                sl1 = __hip_atomic_fetch_add(lcnt + e1, 1, __ATOMIC_RELAXED, __HIP_MEMORY_SCOPE_WORKGROUP);
            }
        }
        __syncthreads();
        if (tid < NE) { const int n = lcnt[tid]; gbase[tid] = n > 0 ? atomicAdd(CNT + tid * 64, n) : 0; }
        __syncthreads();
        if (act && lane < 16) { const int t = t0 + lane;
            LIST[(size_t)e0 * T + gbase[e0] + sl0] = make_int4(2 * t, __float_as_int(rsv), __float_as_int(gt0), 0);
            LIST[(size_t)e1 * T + gbase[e1] + sl1] = make_int4(2 * t + 1, __float_as_int(rsv), __float_as_int(gt1), 0); }
        __syncthreads();
        if (tid < NE) lcnt[tid] = 0;
    }
    __syncthreads();
}
template <bool FINAL>
__device__ __forceinline__ void combine(bf16* HB, float* out, const bf16* YS, const int* POS, const float* GATE, float* RSTD2, int G, int bx) {
    int tid_ = threadIdx.x; asm volatile("" : "+v"(tid_));
    const int tid = tid_, lane = tid & 63, wave = __builtin_amdgcn_readfirstlane(tid >> 6);
    for (int t = bx * NWAVES_ + wave; t < T; t += G * NWAVES_) {
        const int p0 = POS[2 * t], p1 = POS[2 * t + 1]; const float g0 = GATE[2 * t], g1 = GATE[2 * t + 1];
        const u32x4* hr = (const u32x4*)(HB + (size_t)t * D); const u32x4* y0 = (const u32x4*)(YS + (size_t)p0 * D); const u32x4* y1 = (const u32x4*)(YS + (size_t)p1 * D);
        float ss = 0.f;
#pragma unroll
        for (int j = 0; j < 2; ++j) { const u32x4 hw = hr[lane + 64 * j], p = y0[lane + 64 * j], q = y1[lane + 64 * j]; float v[8];
            const unsigned hv[4] = {hw.x, hw.y, hw.z, hw.w}, pv[4] = {p.x, p.y, p.z, p.w}, qv[4] = {q.x, q.y, q.z, q.w};
#pragma unroll
            for (int e = 0; e < 4; ++e) { v[2 * e] = __uint_as_float(hv[e] << 16) + g0 * __uint_as_float(pv[e] << 16) + g1 * __uint_as_float(qv[e] << 16);
                v[2 * e + 1] = __uint_as_float(hv[e] & 0xffff0000u) + g0 * __uint_as_float(pv[e] & 0xffff0000u) + g1 * __uint_as_float(qv[e] & 0xffff0000u); }
            if constexpr (FINAL) { f32x4* o = (f32x4*)(out + (size_t)t * D) + 2 * (lane + 64 * j); o[0] = (f32x4){v[0], v[1], v[2], v[3]}; o[1] = (f32x4){v[4], v[5], v[6], v[7]}; }
            else { unsigned wv[4];
#pragma unroll
                for (int e = 0; e < 4; ++e) { wv[e] = cvt_pk_bf16(v[2 * e], v[2 * e + 1]); const float r0 = __uint_as_float(wv[e] << 16), r1 = __uint_as_float(wv[e] & 0xffff0000u); ss += r0 * r0 + r1 * r1; }
                u32x4 w; w.x = wv[0]; w.y = wv[1]; w.z = wv[2]; w.w = wv[3]; ((u32x4*)(HB + (size_t)t * D))[lane + 64 * j] = w; } }
        if constexpr (!FINAL) { ss = wave_sum(ss); if (lane == 0) RSTD2[t] = fast_rsqrt(ss * (1.0f / D) + EPS); }
    }
}
__device__ __forceinline__ void kfin(const bf16* KN, const bf16* CL, const float* SSK, const float* SSP, const float* kg, const float* cs, unsigned char* KK8, int G, int bx) {
    int tid_ = threadIdx.x; asm volatile("" : "+v"(tid_));
    const int tid = tid_, lane = tid & 63, wave = __builtin_amdgcn_readfirstlane(tid >> 6), r32 = lane & 31, hi = lane >> 5;
    for (int item = bx * NWAVES_ + wave; item < NB * NH * (SEQ / 64) * 2; item += G * NWAVES_) {
        const int blk = item & 1, tile = (item >> 1) & (SEQ / 64 - 1), bh = item >> 8, b = bh / NH, h = bh % NH;
        const int t = b * SEQ + tile * 64 + blk * 32 + r32;
        const f32x4 sk = *(const f32x4*)(SSK + t * 32 + h * 4); const f32x2 sr = *(const f32x2*)(SSP + t * 32 + 8);
        const float rk = fast_rsqrt((((sk[0] + sk[1]) + (sk[2] + sk[3])) + (sr[0] + sr[1])) * (1.0f / DQK) + EPS) * at::SQ2;
        unsigned char* out = KK8 + ((size_t)(bh * (SEQ / 64) + tile)) * (64 * 192) + blk * 1024 + r32 * 16 + hi * 8;
#define KF_OFF(s_) (((s_) >> 2) * 4096 + ((((s_) & 3) >> 1) * 2048) + (((s_) & 1) * 512))
        const bf16* kn = KN + (size_t)t * D + h * 128 + hi * 8;
#pragma unroll
        for (int s = 0; s < 8; ++s) { const bf16x8 raw = *(const bf16x8*)(kn + s * 16); const f32x4 g0 = *(const f32x4*)(kg + s * 16 + hi * 8), g1 = *(const f32x4*)(kg + s * 16 + hi * 8 + 4);
            float y[8];
#pragma unroll
            for (int e = 0; e < 8; ++e) y[e] = __uint_as_float(((unsigned)(unsigned short)raw[e]) << 16) * rk * (e < 4 ? g0[e] : g1[e - 4]);
            *(u32x2*)(out + KF_OFF(s)) = pack_fp8x8(y); }
#pragma unroll
        for (int s = 0; s < 2; ++s) { const int jt = s * 16 + hi * 8;
            const bf16x8 r1 = *(const bf16x8*)(CL + (size_t)t * NCL + 256 + jt), r2 = *(const bf16x8*)(CL + (size_t)t * NCL + 288 + jt);
            const float* cp = cs + (size_t)t * 64 + jt; const f32x4 c0 = *(const f32x4*)cp, c1 = *(const f32x4*)(cp + 4), n0 = *(const f32x4*)(cp + 32), n1 = *(const f32x4*)(cp + 36);
            const f32x4 ga0 = *(const f32x4*)(kg + 128 + jt), ga1 = *(const f32x4*)(kg + 132 + jt), gb0 = *(const f32x4*)(kg + 160 + jt), gb1 = *(const f32x4*)(kg + 164 + jt);
            float y1[8], y2[8];
#pragma unroll
            for (int e = 0; e < 8; ++e) { const float p = __uint_as_float(((unsigned)(unsigned short)r1[e]) << 16) * rk * (e < 4 ? ga0[e] : ga1[e - 4]), q = __uint_as_float(((unsigned)(unsigned short)r2[e]) << 16) * rk * (e < 4 ? gb0[e] : gb1[e - 4]);
                const float c = e < 4 ? c0[e] : c1[e - 4], sn = e < 4 ? n0[e] : n1[e - 4]; y1[e] = p * c - q * sn; y2[e] = p * sn + q * c; }
            *(u32x2*)(out + KF_OFF(8 + s)) = pack_fp8x8(y1); *(u32x2*)(out + KF_OFF(10 + s)) = pack_fp8x8(y2); }
    }
#undef KF_OFF
}
#undef TH_LDS_WAIT
}

#define XB_TMO      128
#define XB_XCNT(j)  (256  + 64 * (j))
#define XB_XSUB(j)  (1280 + 64 * (j))
#define XB_XGEN(j)  (2304 + 64 * (j))
#define XB_TOP      3328
#define XB_TOPGEN   3392
#define XCD_BAR_WORDS 3456
#define XB_SPIN_CAP (1u << 18)
__device__ __forceinline__ unsigned xb_ld(unsigned* p)              { return __hip_atomic_load(p, __ATOMIC_RELAXED, __HIP_MEMORY_SCOPE_AGENT); }
__device__ __forceinline__ unsigned xb_add(unsigned* p, unsigned v) { return __hip_atomic_fetch_add(p, v, __ATOMIC_RELAXED, __HIP_MEMORY_SCOPE_AGENT); }
__device__ __forceinline__ unsigned xb_xcc_id() { return (unsigned)__builtin_amdgcn_s_getreg((3 << 11) | 20) & 0xFu; }
#define XB_SPIN(cond, bar) do { unsigned _sp = 0; while (cond) { __builtin_amdgcn_s_sleep(1); \
    if ((++_sp & 255u) == 0u) { if (xb_ld(&(bar)[XB_TMO])) break; if (_sp > XB_SPIN_CAP) { atomicAdd(&(bar)[XB_TMO], 1u); break; } } } } while (0)
struct XcdBarrier { unsigned* bar; unsigned x; volatile LAS unsigned* st; };
__device__ __forceinline__ XcdBarrier xcd_barrier_post(unsigned* bar, volatile LAS unsigned* st) {
    XcdBarrier b; b.bar = bar; b.x = xb_xcc_id(); b.st = st;
    if (threadIdx.x == 0) (void)xb_add(&bar[XB_XCNT(b.x)], 1u);
    return b;
}
__device__ __forceinline__ void xcd_barrier_complete(unsigned* bar, unsigned x, unsigned& nloc, unsigned& nx) {
    const unsigned G = gridDim.x * gridDim.y * gridDim.z;
    unsigned sum, cnt, mine, sp = 0u;
    for (;;) {
        sum = 0u; cnt = 0u; mine = 0u;
#pragma unroll
        for (unsigned j = 0; j < 16; ++j) { const unsigned c = xb_ld(&bar[XB_XCNT(j)]); sum += c; cnt += (c > 0u) ? 1u : 0u; mine = (j == x) ? c : mine; }
        if (sum == G) break;
        __builtin_amdgcn_s_sleep(1);
        if ((++sp & 255u) == 0u) { if (xb_ld(&bar[XB_TMO])) break; if (sp > XB_SPIN_CAP) { atomicAdd(&bar[XB_TMO], 1u); break; } }
    }
    nloc = mine > 0u ? mine : 1u; nx = cnt > 0u ? cnt : 1u;
}
__device__ __forceinline__ void xcd_barrier(const XcdBarrier& b) {
    asm volatile("s_waitcnt vmcnt(0)" ::: "memory");
    __syncthreads();
    if (threadIdx.x == 0) {
        unsigned* bar = b.bar;
        __builtin_amdgcn_s_waitcnt(0);
        unsigned nloc = b.st[0], nx = b.st[1];
        if (nloc == 0u) { xcd_barrier_complete(bar, b.x, nloc, nx); b.st[0] = nloc; b.st[1] = nx; }
        const unsigned old = xb_add(&bar[XB_XSUB(b.x)], 1u);
        const unsigned gen = old / nloc;
        if (old + 1u == (gen + 1u) * nloc) {
            __builtin_amdgcn_fence(__ATOMIC_RELEASE, "agent");
            asm volatile("s_waitcnt vmcnt(0)" ::: "memory");
            const unsigned og = xb_add(&bar[XB_TOP], 1u);
            const unsigned tg = og / nx;
            if (og + 1u == (tg + 1u) * nx) xb_add(&bar[XB_TOPGEN], 1u);
            else XB_SPIN(xb_ld(&bar[XB_TOPGEN]) == tg, bar);
            __builtin_amdgcn_fence(__ATOMIC_ACQUIRE, "agent");
            xb_add(&bar[XB_XGEN(b.x)], 1u);
            asm volatile("s_waitcnt vmcnt(0)" ::: "memory");
        } else {
            XB_SPIN(xb_ld(&bar[XB_XGEN(b.x)]) == gen, bar);
            __builtin_amdgcn_fence(__ATOMIC_ACQUIRE, "agent");
            asm volatile("s_waitcnt vmcnt(0)" ::: "memory");
        }
    }
    __syncthreads();
}

constexpr int NWAVES = 8, LDS_BYTES = 160 * 1024, LDS_MISC = 159 * 1024;
constexpr int CW_BAR = 4096;
constexpr int NPHASE = 17;
constexpr int PROBE_PH = -1, PROBE_MULT = 4;
constexpr int REP0 = 1, REP1 = 1, REP2 = 1, REP3 = 1, REP5 = 1, REP6 = 1, REP8 = 1, REP9 = 1, REP10 = 1, REP11 = 1, REP14 = 1, REP15 = 1;
struct Args { const float* in[30]; float* out; unsigned char* ws; int ph_lo, ph_hi; };

__global__ void __launch_bounds__(NWAVES * 64, 2) fwd(Args a) {
    extern __shared__ __attribute__((aligned(16))) unsigned char lds_raw[];
    LAS unsigned char* lds = (LAS unsigned char*)lds_raw;
    volatile LAS unsigned* MISC = (volatile LAS unsigned*)(lds + LDS_MISC);
    const int tid = threadIdx.x;
    if (tid < 64) MISC[tid] = 0u;
    __syncthreads();
    unsigned char* ws = a.ws; float* H = a.out;
    XcdBarrier bar = xcd_barrier_post((unsigned*)(ws + WS_CTL) + CW_BAR, MISC + 8);
    const int lo = a.ph_lo, hi = a.ph_hi, G = gridDim.x, bx = blockIdx.x;
    const int vcu = (G % 8 == 0) ? (bx % 8) * (G / 8) + bx / 8 : bx;
    unsigned long long pt0_ = 0, pt1_ = 0;
#define STAMP(k) do { if (PROBE_PH >= 0 && (k) == PROBE_PH) pt0_ = __builtin_amdgcn_s_memrealtime(); if (PROBE_PH >= 0 && (k) == PROBE_PH + 1) pt1_ = __builtin_amdgcn_s_memrealtime(); } while (0)
#define IN(k) (lo <= (k) && (k) < hi)
#define SEAM(k) do { if (IN(k) && IN((k) + 1)) xcd_barrier(bar); } while (0)
    const float* x = a.in[0];
    bf16 *W1t = (bf16*)(ws + WS_W1T), *W2t = (bf16*)(ws + WS_W2T), *Wc = (bf16*)(ws + WS_WC), *Wukv = (bf16*)(ws + WS_WUKV), *Wuq = (bf16*)(ws + WS_WUQ), *Wo = (bf16*)(ws + WS_WO);
    float *RSTD0 = (float*)(ws + WS_RSTD0), *RSTD2 = (float*)(ws + WS_RSTD2), *SSP = (float*)(ws + WS_SSP), *SSQ = (float*)(ws + WS_SSQ), *SSK = (float*)(ws + WS_SSK);
    bf16 *XB = (bf16*)(ws + WS_R1), *HB = XB, *U = (bf16*)(ws + WS_R2), *O = U, *Vb = (bf16*)(ws + WS_R3), *KN = Vb, *VV = (bf16*)(ws + WS_R3 + 64 * MiB),
         *CL = (bf16*)(ws + WS_CL), *QRAW = (bf16*)(ws + WS_QRAW);

    STAMP(0);
    if (IN(0)) for (int rep_ = 0; rep_ < REP0; ++rep_) th::prologue(lds, a.in, ws, G, bx);
    SEAM(0);
    STAMP(1);
    if (IN(1)) for (int rep_ = 0; rep_ < REP1; ++rep_) { fg::DenseP<fg::EpiGlu> p{(const char*)XB, D, (const char*)W1t, D, {}, {RSTD0, a.in[4], U}}; p.S.init(T, 2048, G, bx); fg::gemm_phase(lds, p); }
    SEAM(1);
    STAMP(2);
    if (IN(2)) for (int rep_ = 0; rep_ < REP2; ++rep_) th::conv_ln(lds, U, a.in[5], a.in[6], a.in[7], a.in[8], Vb, G, bx);
    SEAM(2);
    STAMP(3);
    if (IN(3)) for (int rep_ = 0; rep_ < REP3; ++rep_) { fg::DenseP<fg::EpiRes<true>> p{(const char*)Vb, D, (const char*)W2t, D, {}, {HB  , a.in[10], HB}}; p.S.init(T, D, G, bx); fg::gemm_phase(lds, p); }
    SEAM(3);
    LAS int* pref = (LAS int*)(lds + LDS_MISC + 256); LAS int* cnts = (LAS int*)(lds + LDS_MISC + 640);
    int4* LIST = (int4*)(ws + WS_LISTR); int* POS = (int*)(ws + WS_LIST); float* GATE = (float*)(ws + WS_GATE); bf16* ACTS = (bf16*)(ws + WS_ACTS); bf16* YS = (bf16*)(ws + WS_YS);
    bf16* XT = XB; bf16* ACT = U; bf16* Y = Vb; const bf16* Wgu = (const bf16*)(ws + WS_WGU); const bf16* Wd = (const bf16*)(ws + WS_WD);
#define MOE_GEMMS(l, p1, p2) do { \
        STAMP(p1); \
        if (IN(p1)) for (int rep_ = 0; rep_ < ((l) ? REP14 : REP5); ++rep_) { fg::moe_setup((const int*)(ws + WS_CTL) + (l) * NE * 64, pref, cnts); \
            fg::MoeP<fg::EpiSwiglu, true> p{(const char*)HB, D, 1, (const char*)(Wgu + (size_t)(l) * NE * 1024 * D), (size_t)1024 * D * 2, D, LIST, pref, cnts, G, vcu, 4 * (__builtin_amdgcn_readfirstlane(pref[32]) + __builtin_amdgcn_readfirstlane(pref[72])), {ACTS, POS}}; \
            fg::gemm_phase(lds, p); } \
        SEAM(p1); \
        STAMP(p2); \
        if (IN(p2)) for (int rep_ = 0; rep_ < ((l) ? REP15 : REP6); ++rep_) { fg::moe_setup((const int*)(ws + WS_CTL) + (l) * NE * 64, pref, cnts); \
            fg::MoeP<fg::EpiDown, false> p{(const char*)ACTS, DE, 0, (const char*)(Wd + (size_t)(l) * NE * D * DE), (size_t)D * DE * 2, DE, LIST, pref, cnts, G, vcu, 4 * (__builtin_amdgcn_readfirstlane(pref[32]) + __builtin_amdgcn_readfirstlane(pref[72])), {YS}}; \
            fg::gemm_phase(lds, p); } \
        SEAM(p2); } while (0)
    float* Wr = (float*)(ws + WS_WR); int* CNT = (int*)(ws + WS_CTL);
    STAMP(4);
    if (IN(4)) th::route(lds, HB, Wr, a.in[25], a.in[27], LIST, CNT, GATE, G, bx);
    SEAM(4);
    MOE_GEMMS(0, 5, 6);
    STAMP(7);
    if (IN(7)) th::combine<false>(HB, nullptr, YS, POS, GATE, RSTD2, G, bx);
    SEAM(7);
    STAMP(8);
    if (IN(8)) for (int rep_ = 0; rep_ < REP8; ++rep_) { fg::DenseP<fg::EpiCL> p{(const char*)HB, D, (const char*)Wc, D, {}, {RSTD2, CL, SSP}}; p.S.init(T, NCL, G, bx); fg::gemm_phase(lds, p); }
    SEAM(8);
    STAMP(9);
    if (IN(9)) for (int rep_ = 0; rep_ < REP9; ++rep_) {
        { fg::DenseP<fg::EpiQ> p{(const char*)(CL + 320), NCL, (const char*)Wuq, QLR, {}, {SSP, QRAW, SSQ}}; p.S.init(T, 1536, G, bx); fg::gemm_phase(lds, p); }
        { fg::DenseP<fg::EpiKV> p{(const char*)CL, NCL, (const char*)Wukv, KVR, {}, {SSP, KN, VV, SSK}}; p.S.init(T, 2048, G, bx); fg::gemm_phase(lds, p); }
    }
    SEAM(9);
    STAMP(10);
    if (IN(10)) for (int rep_ = 0; rep_ < REP10; ++rep_) th::kfin(KN, CL, SSK, SSP, a.in[16], (const float*)(ws + WS_CS), (unsigned char*)(ws + WS_KK), G, bx);
    SEAM(10);
    STAMP(11);
    if (IN(11)) for (int rep_ = 0; rep_ < REP11; ++rep_) { const at::AttnArgs aa{QRAW, SSQ, a.in[21], (const float*)(ws + WS_CS), (const unsigned char*)(ws + WS_KK), VV, O}; at::attn_phase(lds, aa, G, bx); }
    SEAM(11);
    STAMP(12);
    if (IN(12)) { fg::DenseP<fg::EpiRes<true>> p{(const char*)O, D, (const char*)Wo, D, {}, {HB, nullptr, HB}}; p.S.init(T, D, G, bx); fg::gemm_phase(lds, p); }
    SEAM(12);
    STAMP(13);
    if (IN(13)) th::route(lds, HB, Wr + (size_t)D * NRT, a.in[25] + NG, a.in[27] + NE, LIST, CNT + NE * 64, GATE, G, bx);
    SEAM(13);
    MOE_GEMMS(1, 14, 15);
    STAMP(16);
    if (IN(16)) th::combine<true>(HB, H, YS, POS, GATE, nullptr, G, bx);
#undef MOE_GEMMS
    STAMP(17);
    if (PROBE_PH >= 0 && bx == 0) { const unsigned long long te_ = __builtin_amdgcn_s_memrealtime(), dt_ = (pt1_ - pt0_) * (unsigned long long)PROBE_MULT; while (__builtin_amdgcn_s_memrealtime() - te_ < dt_) __builtin_amdgcn_s_sleep(8); }
#undef IN
#undef SEAM
#undef STAMP
}

extern "C" void kernel_launch(void* const* d_in, const int* in_sizes, int n_in, void* d_out, int out_size, void* d_ws, size_t ws_size, hipStream_t stream) {
    if (n_in != 30 || ws_size < WS_END || out_size != T * D) { fprintf(stderr, "kernel_launch: unexpected shapes (n_in %d, ws %zu, out %d)\n", n_in, ws_size, out_size); return; }
    static int grid = 0;
    if (!grid) {
        (void)hipFuncSetAttribute((const void*)fwd, hipFuncAttributeMaxDynamicSharedMemorySize, LDS_BYTES);
        int dev = 0, cus = 0; (void)hipGetDevice(&dev); if (hipDeviceGetAttribute(&cus, hipDeviceAttributeMultiprocessorCount, dev) != hipSuccess || cus <= 0) cus = 256;
        grid = cus;
    }
    char* ws = (char*)d_ws;
    Args a{}; for (int i = 0; i < 30; ++i) a.in[i] = (const float*)d_in[i]; a.out = (float*)d_out; a.ws = (unsigned char*)d_ws;
    (void)hipMemsetAsync(ws + WS_CTL, 0, 1 * MiB, stream);
    a.ph_lo = 0; a.ph_hi = NPHASE;
    hipLaunchKernelGGL(fwd, dim3(grid), dim3(NWAVES * 64), LDS_BYTES, stream, a);
}
```

```cpp
#include <hip/hip_runtime.h>
#include <stdint.h>
#include <stdio.h>

typedef unsigned short bf16;
constexpr int NB = 4, SEQ = 8192, T = NB * SEQ, D = 1024, NH = 8, DQK = 192, DNOPE = 128, DROPE = 64, DV = 128, KVR = 256, QLR = 384;
constexpr int NE = 32, NG = 4, EPG = 8, DE = 512, CONVW = 31, NCL = 768, NRT = 36;
constexpr float EPS = 1e-6f;
constexpr float SM_SCALE = 0.07216878364870322f;

constexpr size_t MiB = 1u << 20;
constexpr size_t WS_CTL = 0, WS_W1T = 1 * MiB, WS_W2T = 5 * MiB, WS_WC = 7 * MiB, WS_WUKV = 9 * MiB, WS_WUQ = 10 * MiB, WS_WO = 12 * MiB, WS_WR = 14 * MiB,
                 WS_WGU = 16 * MiB, WS_WD = 144 * MiB, WS_RSTD0 = 208 * MiB, WS_RSTD = WS_RSTD0 + 256 * 1024, WS_RSTD2 = WS_RSTD0 + 512 * 1024,
                 WS_GATE = 209 * MiB, WS_LIST = 210 * MiB, WS_CS = 214 * MiB, WS_SSP = 222 * MiB, WS_SSQ = 226 * MiB, WS_SSK = 232 * MiB,
                 WS_R1 = 236 * MiB, WS_R2 = 300 * MiB, WS_R3 = 364 * MiB, WS_CL = 492 * MiB, WS_QRAW = 540 * MiB, WS_KK = 636 * MiB, WS_LISTR = 732 * MiB  , WS_ACTS = 748 * MiB  , WS_YS = 828 * MiB  ,  WS_END = 988 * MiB;

__device__ const float INV_FREQ[32] = {
    1.0f, 0.7498942093324559f, 0.5623413251903491f, 0.4216965034285822f, 0.31622776601683794f, 0.23713737056616552f, 0.1778279410038923f, 0.1333521432163324f,
    0.1f, 0.07498942093324558f, 0.05623413251903491f, 0.04216965034285822f, 0.03162277660168379f, 0.023713737056616554f, 0.01778279410038923f, 0.01333521432163324f,
    0.01f, 0.007498942093324558f, 0.005623413251903491f, 0.004216965034285823f, 0.0031622776601683794f, 0.0023713737056616554f, 0.001778279410038923f, 0.001333521432163324f,
    0.001f, 0.0007498942093324559f, 0.0005623413251903491f, 0.00042169650342858224f, 0.00031622776601683794f, 0.00023713737056616554f, 0.0001778279410038923f, 0.0001333521432163324f};

__device__ __forceinline__ float bf2f(bf16 b) { return __uint_as_float(((unsigned)b) << 16); }
__device__ __forceinline__ bf16 f2bf(float f) { unsigned u = __float_as_uint(f); u += 0x7fffu + ((u >> 16) & 1u); return (bf16)(u >> 16); }
__device__ __forceinline__ float wave_sum(float v) {
#pragma unroll
    for (int o = 1; o < 64; o <<= 1) v += __shfl_xor(v, o);
    return v;
}
__device__ __forceinline__ float sigmoidf_(float x) { return 1.0f / (1.0f + __expf(-x)); }
__device__ __forceinline__ float siluf_(float x) { return x / (1.0f + __expf(-x)); }
__host__ __device__ __forceinline__ int pair_row(int n, int half) { const int j = n % half, hf = n / half; return 256 * (j / 128) + 128 * hf + (j % 128); }

__device__ __forceinline__ void sincos_d(double a, double& s, double& c) {
    const double TWO_PI = 6.283185307179586476925287, PI = 3.14159265358979323846;
    double k = __builtin_rint(a / TWO_PI); double r = a - k * TWO_PI;
    double q = __builtin_rint(r / (PI * 0.5)); double y = r - q * (PI * 0.5); int qi = ((int)q) & 3;
    const double y2 = y * y;
    double sp = y * (1.0 + y2 * (-1.0 / 6 + y2 * (1.0 / 120 + y2 * (-1.0 / 5040 + y2 * (1.0 / 362880 + y2 * (-1.0 / 39916800 + y2 * (1.0 / 6227020800.0)))))));
    double cp = 1.0 + y2 * (-0.5 + y2 * (1.0 / 24 + y2 * (-1.0 / 720 + y2 * (1.0 / 40320 + y2 * (-1.0 / 3628800 + y2 * (1.0 / 479001600.0 + y2 * (-1.0 / 87178291200.0)))))));
    if (qi == 0) { s = sp; c = cp; } else if (qi == 1) { s = cp; c = -sp; } else if (qi == 2) { s = -sp; c = -cp; } else { s = -cp; c = sp; }
}

constexpr int NWAVES_ = 8;
#define LAS __attribute__((address_space(3)))
#define GAS __attribute__((address_space(1)))
typedef short bf16x8 __attribute__((ext_vector_type(8)));
typedef float f32x4 __attribute__((ext_vector_type(4)));
typedef float f32x2 __attribute__((ext_vector_type(2)));
typedef unsigned u32x4 __attribute__((ext_vector_type(4)));
typedef unsigned u32x2 __attribute__((ext_vector_type(2)));

__device__ __forceinline__ unsigned cvt_pk_bf16(float lo, float hi) { unsigned r; asm volatile("v_cvt_pk_bf16_f32 %0, %1, %2" : "=v"(r) : "v"(lo), "v"(hi)); return r; }
__device__ __forceinline__ float fast_sigmoid(float x) { return __builtin_amdgcn_rcpf(1.0f + __builtin_amdgcn_exp2f(-1.4426950408889634f * x)); }
__device__ __forceinline__ float fast_rsqrt(float x) { return 1.0f / sqrtf(x); }
__device__ __forceinline__ u32x2 pack_fp8x8(const float (&y)[8]) { int w0 = 0, w1 = 0; w0 = __builtin_amdgcn_cvt_pk_fp8_f32(y[0], y[1], w0, false); w0 = __builtin_amdgcn_cvt_pk_fp8_f32(y[2], y[3], w0, true);
    w1 = __builtin_amdgcn_cvt_pk_fp8_f32(y[4], y[5], w1, false); w1 = __builtin_amdgcn_cvt_pk_fp8_f32(y[6], y[7], w1, true); u32x2 r; r.x = (unsigned)w0; r.y = (unsigned)w1; return r; }

namespace fg {
constexpr int BM = 256, BK = 64, HALF = 128, HTB = HALF * BK * 2, STAGE_BYTES = 8 * HTB, NXCD = 8, WGM = 8;
__host__ __device__ __forceinline__ int lds_byte(int r, int c) { const int st = (r >> 4) * 2 + (c >> 5), rr = r & 15, cc = c & 31, ob = rr * 64 + cc * 2; return st * 1024 + (ob ^ (((ob >> 9) & 1) << 5)); }
__host__ __device__ __forceinline__ void stage_rc(int b, int& R, int& C) { const int st = b / 1024, sb = b % 1024, swz = sb ^ (((sb >> 9) & 1) << 5); R = (st >> 1) * 16 + swz / 64; C = (st & 1) * 32 + (swz % 64) / 2; }
__host__ __device__ __forceinline__ int perm32(int rho) { const int n = rho >> 4, i = rho & 15; return 8 * (i >> 2) + 4 * n + (i & 3); }
struct Unit { int pm, pn, e, nvalid, r, am; };
typedef f32x4 Acc[2][2][4][2];

struct StaticOrder {
    int nM, nN, nwg, G, c;
    __device__ void init(int M, int N, int G_, int c_) { nM = M / BM; nN = N / BM; nwg = nM * nN; G = G_; c = c_; }
    __device__ bool next(int i, Unit& u) const {
        long L = (long)i * G + c; const int nfull = (nwg / G) * G;
        int am = 3; if (L >= nfull) { const long hu = L - nfull; L = nfull + (hu >> 1); am = 1 << (int)(hu & 1); }
        if (L >= nwg) return false;
        int wgid = (int)L; { const int q = nwg / NXCD, r = nwg % NXCD, xcd = wgid % NXCD, off = wgid / NXCD; wgid = (xcd < r ? xcd * (q + 1) : r * (q + 1) + (xcd - r) * q) + off; }
        const int nig = WGM * nN, gid = wgid / nig, fm = gid * WGM, gsz = (nM - fm) < WGM ? (nM - fm) : WGM;
        u.pm = fm + ((wgid % nig) % gsz); u.pn = (wgid % nig) / gsz; u.e = 0; u.nvalid = 256; u.r = u.pm; u.am = am; return true;
    }
};

template <class P>
__device__ __forceinline__ void gemm_phase(LAS unsigned char* lds, const P& p) {
    int tid_ = threadIdx.x; asm volatile("" : "+v"(tid_));
    const int tid = tid_, wid = __builtin_amdgcn_readfirstlane(tid >> 6), lane = tid & 63, wr = wid >> 2, wc = wid & 3, fr = lane & 15, fq = lane >> 4;
    const int K = p.K, nt = K / BK;
    int sR[2], sC[2]; unsigned voffB[2];
#pragma unroll
    for (int i = 0; i < 2; ++i) { int R, C; stage_rc(tid * 16 + i * 8192, R, C); sR[i] = R; sC[i] = C; const int Rb = P::PERM ? ((R & ~31) + perm32(R & 31)) : R; voffB[i] = (unsigned)(Rb * K + C) * 2u; }
    const size_t kstep = (size_t)(BK * 2), hstepB = (size_t)HALF * K * 2;
    const unsigned ldsw = (unsigned)wid * 1024u;
    const int aoff = lds_byte(wr * 64 + fr, fq * 8), boff = lds_byte(wc * 32 + fr, fq * 8);
#define FG_SA(b, h) (((b) * 2 + (h)) * HTB)
#define FG_SB(b, h) ((4 + (b) * 2 + (h)) * HTB)
#define FG_STAGE(bufoff, gbase, voff) do { _Pragma("unroll") for (int _i = 0; _i < 2; ++_i) \
        __builtin_amdgcn_global_load_lds((const unsigned*)((const char*)(gbase) + (voff)[_i]), (LAS unsigned*)(lds + (bufoff) + ldsw + _i * 8192), 16, 0, 0); } while (0)
#define FG_LDA(dst, b, h) do { _Pragma("unroll") for (int m = 0; m < 4; ++m) _Pragma("unroll") for (int k = 0; k < 2; ++k) dst[m][k] = *(const LAS bf16x8*)(lds + FG_SA(b, h) + aoff + m * 2048 + k * 1024); } while (0)
#define FG_LDB(dst, b, h) do { _Pragma("unroll") for (int n = 0; n < 2; ++n) _Pragma("unroll") for (int k = 0; k < 2; ++k) dst[n][k] = *(const LAS bf16x8*)(lds + FG_SB(b, h) + boff + n * 2048 + k * 1024); } while (0)
#define FG_MMA(ai, bj, At, Bt) do { __builtin_amdgcn_s_setprio(1); _Pragma("unroll") for (int m = 0; m < 4; ++m) _Pragma("unroll") for (int n = 0; n < 2; ++n) _Pragma("unroll") for (int k = 0; k < 2; ++k) \
        acc[ai][bj][m][n] = __builtin_amdgcn_mfma_f32_16x16x32_bf16(Bt[n][k], At[m][k], acc[ai][bj][m][n], 0, 0, 0); __builtin_amdgcn_s_setprio(0); } while (0)
#define FG_WAIT_V(n) asm volatile("s_waitcnt vmcnt(" #n ")" ::: "memory")
#define FG_WAIT_L(n) asm volatile("s_waitcnt lgkmcnt(" #n ")" ::: "memory")
#define FG_BAR __builtin_amdgcn_s_barrier()
#define FG_SCHED __builtin_amdgcn_sched_barrier(0)
    Unit cur, nxt, nn; int ui = 0;
    if (!p.next(0, cur)) return;
    unsigned ao[4], nao[4], nnao[4];
    p.a_off(cur, sR, sC, ao);
    bool has_next = p.next(1, nxt);
    if (has_next) p.a_off(nxt, sR, sC, nao); else { nxt = cur; _Pragma("unroll") for (int j = 0; j < 4; ++j) nao[j] = ao[j]; }
    Acc acc;
#pragma unroll
    for (int a = 0; a < 2; ++a)
#pragma unroll
        for (int b = 0; b < 2; ++b)
#pragma unroll
            for (int m = 0; m < 4; ++m)
#pragma unroll
                for (int n = 0; n < 2; ++n) acc[a][b][m][n] = (f32x4){0.f, 0.f, 0.f, 0.f};
    bf16x8 At[4][2], B0[2][2], B1[2][2];
    const char* const Ab = p.A;
    const char* cB = p.b_base(cur);
    FG_STAGE(FG_SB(0, 0), cB, voffB); FG_STAGE(FG_SB(0, 1), cB + hstepB, voffB); FG_STAGE(FG_SA(0, 0), Ab, ao); FG_STAGE(FG_SA(0, 1), Ab, ao + 2);
    if (wr == 1) FG_BAR;
    FG_WAIT_V(2); FG_BAR;
    FG_STAGE(FG_SB(1, 0), cB + kstep, voffB); FG_STAGE(FG_SA(1, 0), Ab + kstep, ao); FG_STAGE(FG_SB(1, 1), cB + hstepB + kstep, voffB);
    FG_WAIT_V(6); FG_BAR;
    for (;;) {
        const char* nB = has_next ? p.b_base(nxt) : cB;
        for (int t = 0; t < nt; t += 2) {
            const bool last = (t == nt - 2);
            const char* a1 = Ab + (size_t)(t + 1) * kstep;
            const char* a2 = last ? Ab : Ab + (size_t)(t + 2) * kstep; const char* b2 = last ? nB : cB + (size_t)(t + 2) * kstep;
            const char* a3 = a2 + kstep; const char* b3 = b2 + kstep;
            unsigned so[4];
#pragma unroll
            for (int j = 0; j < 4; ++j) so[j] = last ? nao[j] : ao[j];
            FG_LDB(B0, 0, 0); FG_LDB(B1, 0, 1); FG_SCHED; FG_LDA(At, 0, 0); FG_STAGE(FG_SA(1, 1), a1, ao + 2);
            FG_WAIT_V(8); FG_WAIT_L(0); FG_BAR; if (cur.am & 1) { FG_MMA(0, 0, At, B0); FG_MMA(0, 1, At, B1); } FG_BAR; FG_SCHED;
            FG_LDA(At, 0, 1); FG_STAGE(FG_SB(0, 0), b2, voffB); FG_STAGE(FG_SB(0, 1), b2 + hstepB, voffB); FG_STAGE(FG_SA(0, 0), a2, so);
            FG_WAIT_V(8); FG_WAIT_L(0); FG_BAR; if (cur.am & 2) { FG_MMA(1, 0, At, B0); FG_MMA(1, 1, At, B1); } FG_BAR; FG_SCHED;
            FG_LDB(B0, 1, 0); FG_LDB(B1, 1, 1); FG_SCHED; FG_LDA(At, 1, 0); FG_STAGE(FG_SA(0, 1), a2, so + 2);
            FG_WAIT_V(8); FG_WAIT_L(0); FG_BAR; if (cur.am & 1) { FG_MMA(0, 0, At, B0); FG_MMA(0, 1, At, B1); } FG_BAR; FG_SCHED;
            FG_LDA(At, 1, 1); FG_STAGE(FG_SB(1, 0), b3, voffB); FG_STAGE(FG_SB(1, 1), b3 + hstepB, voffB); FG_STAGE(FG_SA(1, 0), a3, so);
            FG_WAIT_V(8); FG_WAIT_L(0); FG_BAR; if (cur.am & 2) { FG_MMA(1, 0, At, B0); FG_MMA(1, 1, At, B1); } FG_BAR; FG_SCHED;
        }
        if (wr == 0) FG_BAR;
        const bool has_nn = has_next && p.next(ui + 2, nn);
        if (has_nn) p.a_off(nn, sR, sC, nnao); else { nn = nxt; _Pragma("unroll") for (int j = 0; j < 4; ++j) nnao[j] = nao[j]; }
        p.epi(acc, cur, wr, wc, fr, fq);
        if (!has_next) break;
#pragma unroll
        for (int a = 0; a < 2; ++a)
#pragma unroll
            for (int b = 0; b < 2; ++b)
#pragma unroll
                for (int m = 0; m < 4; ++m)
#pragma unroll
                    for (int n = 0; n < 2; ++n) acc[a][b][m][n] = (f32x4){0.f, 0.f, 0.f, 0.f};
        cur = nxt; cB = nB; nxt = nn; has_next = has_nn; ++ui;
#pragma unroll
        for (int j = 0; j < 4; ++j) { ao[j] = nao[j]; nao[j] = nnao[j]; }
        if (wr == 1) FG_BAR;
    }
    FG_WAIT_V(0);
    FG_BAR;
#undef FG_SA
#undef FG_SB
#undef FG_STAGE
#undef FG_LDA
#undef FG_LDB
#undef FG_MMA
#undef FG_WAIT_V
#undef FG_WAIT_L
#undef FG_BAR
#undef FG_SCHED
}

template <class Epi> struct DenseP {
    static constexpr bool PERM = Epi::PERM;
    const char* A; int lda; const char* Bt; int K; StaticOrder S; Epi E;
    __device__ __forceinline__ bool next(int i, Unit& u) const { return S.next(i, u); }
    __device__ __forceinline__ const char* b_base(const Unit& u) const { return Bt + (size_t)u.pn * BM * K * 2; }
    __device__ __forceinline__ void a_off(const Unit& u, const int (&sR)[2], const int (&sC)[2], unsigned (&ao)[4]) const {
#pragma unroll
        for (int h = 0; h < 2; ++h)
#pragma unroll
            for (int i = 0; i < 2; ++i) ao[h * 2 + i] = (unsigned)((u.pm * BM + h * HALF + sR[i]) * lda + sC[i]) * 2u;
    }
    __device__ __forceinline__ void epi(const Acc& acc, const Unit& u, int wr, int wc, int fr, int fq) const { E(acc, u, wr, wc, fr, fq); }
};

struct EpiGlu {
    static constexpr bool PERM = true;
    const float* rstd; const float* bias; bf16* U;
    __device__ __forceinline__ void operator()(const Acc& acc, const Unit& u, int wr, int wc, int fr, int fq) const {
        const int col = u.pn * 128 + wc * 32 + fq * 8, row0 = u.pm * BM + wr * 64 + fr;
        const f32x4 ba0 = *(const f32x4*)(bias + col), ba1 = *(const f32x4*)(bias + col + 4), bg0 = *(const f32x4*)(bias + 1024 + col), bg1 = *(const f32x4*)(bias + 1024 + col + 4);
        float rsv[8];
#pragma unroll
        for (int q = 0; q < 8; ++q) rsv[q] = rstd[row0 + (q >> 2) * HALF + (q & 3) * 16];
#pragma unroll
        for (int ai = 0; ai < 2; ++ai) if ((u.am >> ai) & 1)
#pragma unroll
            for (int m = 0; m < 4; ++m) { const int row = row0 + ai * HALF + m * 16; const float rs = rsv[ai * 4 + m];
                const f32x4 a0 = acc[ai][0][m][0] * rs + ba0, a1 = acc[ai][0][m][1] * rs + ba1, g0 = acc[ai][1][m][0] * rs + bg0, g1 = acc[ai][1][m][1] * rs + bg1;
                float o[8];
#pragma unroll
                for (int j = 0; j < 4; ++j) { o[j] = a0[j] * fast_sigmoid(g0[j]); o[4 + j] = a1[j] * fast_sigmoid(g1[j]); }
                u32x4 w; w.x = cvt_pk_bf16(o[0], o[1]); w.y = cvt_pk_bf16(o[2], o[3]); w.z = cvt_pk_bf16(o[4], o[5]); w.w = cvt_pk_bf16(o[6], o[7]);
                *(u32x4*)(U + (size_t)row * D + col) = w; }
    }
};
__device__ __forceinline__ u32x4 pack8(const f32x4 a, const f32x4 b);
template <bool BF16BASE> struct EpiRes {
    static constexpr bool PERM = true;
    const void* base; const float* bias; bf16* out;
    __device__ __forceinline__ void operator()(const Acc& acc, const Unit& u, int wr, int wc, int fr, int fq) const {
        const int row0 = u.pm * BM + wr * 64 + fr, col0 = u.pn * BM + wc * 32 + 8 * fq;
        f32x4 bv[2][2];
#pragma unroll
        for (int bj = 0; bj < 2; ++bj)
#pragma unroll
            for (int n = 0; n < 2; ++n) bv[bj][n] = bias ? *(const f32x4*)(bias + col0 + bj * HALF + 4 * n) : (f32x4){0.f, 0.f, 0.f, 0.f};
#pragma unroll
        for (int ai = 0; ai < 2; ++ai) { if (!((u.am >> ai) & 1)) continue;
            if constexpr (BF16BASE) {
                u32x4 raw[4][2];
#pragma unroll
                for (int m = 0; m < 4; ++m) { const size_t off = (size_t)(row0 + ai * HALF + m * 16) * D + col0;
#pragma unroll
                    for (int bj = 0; bj < 2; ++bj) raw[m][bj] = *(const u32x4*)((const bf16*)base + off + bj * HALF); }
                asm volatile("" ::: "memory");
#pragma unroll
                for (int m = 0; m < 4; ++m) { const size_t off = (size_t)(row0 + ai * HALF + m * 16) * D + col0;
#pragma unroll
                    for (int bj = 0; bj < 2; ++bj) { const u32x4 w = raw[m][bj];
                        const f32x4 b0 = (f32x4){__uint_as_float(w.x << 16), __uint_as_float(w.x & 0xffff0000u), __uint_as_float(w.y << 16), __uint_as_float(w.y & 0xffff0000u)};
                        const f32x4 b1 = (f32x4){__uint_as_float(w.z << 16), __uint_as_float(w.z & 0xffff0000u), __uint_as_float(w.w << 16), __uint_as_float(w.w & 0xffff0000u)};
                        *(u32x4*)(out + off + bj * HALF) = pack8(b0 + acc[ai][bj][m][0] + bv[bj][0], b1 + acc[ai][bj][m][1] + bv[bj][1]); } }
                asm volatile("" ::: "memory");
            } else {
#pragma unroll
                for (int mh = 0; mh < 2; ++mh) {
                    f32x4 bs[2][2][2];
#pragma unroll
                    for (int m2 = 0; m2 < 2; ++m2) { const size_t off = (size_t)(row0 + ai * HALF + (mh * 2 + m2) * 16) * D + col0;
#pragma unroll
                        for (int bj = 0; bj < 2; ++bj) { bs[m2][bj][0] = *(const f32x4*)((const float*)base + off + bj * HALF); bs[m2][bj][1] = *(const f32x4*)((const float*)base + off + bj * HALF + 4); } }
                    asm volatile("" ::: "memory");
#pragma unroll
                    for (int m2 = 0; m2 < 2; ++m2) { const int m = mh * 2 + m2; const size_t off = (size_t)(row0 + ai * HALF + m * 16) * D + col0;
#pragma unroll
                        for (int bj = 0; bj < 2; ++bj) *(u32x4*)(out + off + bj * HALF) = pack8(bs[m2][bj][0] + acc[ai][bj][m][0] + bv[bj][0], bs[m2][bj][1] + acc[ai][bj][m][1] + bv[bj][1]); }
                    asm volatile("" ::: "memory");
                }
            }
        }
    }
};
__device__ __forceinline__ float quad_sum(float s) { s += __shfl_xor(s, 16); s += __shfl_xor(s, 32); return s; }
__device__ __forceinline__ u32x4 pack8(const f32x4 a, const f32x4 b) { u32x4 w; w.x = cvt_pk_bf16(a[0], a[1]); w.y = cvt_pk_bf16(a[2], a[3]); w.z = cvt_pk_bf16(b[0], b[1]); w.w = cvt_pk_bf16(b[2], b[3]); return w; }
__device__ __forceinline__ float sumsq8(const f32x4 a, const f32x4 b) { return (a[0] * a[0] + a[1] * a[1]) + (a[2] * a[2] + a[3] * a[3]) + (b[0] * b[0] + b[1] * b[1]) + (b[2] * b[2] + b[3] * b[3]); }
struct EpiCL {
    static constexpr bool PERM = true;
    const float* rstd2; bf16* CL; float* SSP;
    __device__ __forceinline__ void operator()(const Acc& acc, const Unit& u, int wr, int wc, int fr, int fq) const {
        const int row0 = u.pm * BM + wr * 64 + fr;
        float rsv[8];
#pragma unroll
        for (int q = 0; q < 8; ++q) rsv[q] = rstd2[row0 + (q >> 2) * HALF + (q & 3) * 16];
#pragma unroll
        for (int ai = 0; ai < 2; ++ai) if ((u.am >> ai) & 1)
#pragma unroll
            for (int m = 0; m < 4; ++m) { const int row = row0 + ai * HALF + m * 16; const float rs = rsv[ai * 4 + m];
#pragma unroll
                for (int bj = 0; bj < 2; ++bj) { const f32x4 v0 = acc[ai][bj][m][0] * rs, v1 = acc[ai][bj][m][1] * rs; const float ss = quad_sum(sumsq8(v0, v1));
                    *(u32x4*)(CL + (size_t)row * NCL + u.pn * BM + bj * HALF + wc * 32 + fq * 8) = pack8(v0, v1);
                    const int g = u.pn * 8 + bj * 4 + wc; if (fq == 0) SSP[row * 32 + (g < 10 ? g : g + 2)] = ss; } }
    }
};
struct EpiQ {
    static constexpr bool PERM = true;
    const float* SSP; bf16* QRAW; float* SSQ;
    __device__ __forceinline__ void operator()(const Acc& acc, const Unit& u, int wr, int wc, int fr, int fq) const {
        const int row0 = u.pm * BM + wr * 64 + fr;
        float rsv[8];
#pragma unroll
        for (int q = 0; q < 8; ++q) { const int row = row0 + (q >> 2) * HALF + (q & 3) * 16;
            const f32x4 s0 = *(const f32x4*)(SSP + row * 32 + 12), s1 = *(const f32x4*)(SSP + row * 32 + 16), s2 = *(const f32x4*)(SSP + row * 32 + 20);
            rsv[q] = ((s0[0] + s0[1]) + (s0[2] + s0[3])) + ((s1[0] + s1[1]) + (s1[2] + s1[3])) + ((s2[0] + s2[1]) + (s2[2] + s2[3]));
            if (q == 3) asm volatile("" : "+v"(rsv[0]), "+v"(rsv[1]), "+v"(rsv[2]), "+v"(rsv[3]) :: "memory"); }
#pragma unroll
        for (int q = 0; q < 8; ++q) rsv[q] = fast_rsqrt(rsv[q] * (1.0f / QLR) + EPS);
#pragma unroll
        for (int ai = 0; ai < 2; ++ai) if ((u.am >> ai) & 1)
#pragma unroll
            for (int m = 0; m < 4; ++m) { const int row = row0 + ai * HALF + m * 16; const float rs = rsv[ai * 4 + m];
#pragma unroll
                for (int bj = 0; bj < 2; ++bj) { const f32x4 v0 = acc[ai][bj][m][0] * rs, v1 = acc[ai][bj][m][1] * rs; const float ss = quad_sum(sumsq8(v0, v1));
                    *(u32x4*)(QRAW + (size_t)row * 1536 + u.pn * BM + bj * HALF + wc * 32 + fq * 8) = pack8(v0, v1);
                    if (fq == 0) SSQ[row * 48 + u.pn * 8 + bj * 4 + wc] = ss; } }
    }
};
struct EpiKV {
    static constexpr bool PERM = true;
    const float* SSP; bf16* KN; bf16* VV; float* SSK;
    __device__ __forceinline__ void operator()(const Acc& acc, const Unit& u, int wr, int wc, int fr, int fq) const {
        const int row0 = u.pm * BM + wr * 64 + fr;
        float rsv[8];
#pragma unroll
        for (int q = 0; q < 8; ++q) { const int row = row0 + (q >> 2) * HALF + (q & 3) * 16;
            const f32x4 s0 = *(const f32x4*)(SSP + row * 32), s1 = *(const f32x4*)(SSP + row * 32 + 4);
            rsv[q] = ((s0[0] + s0[1]) + (s0[2] + s0[3])) + ((s1[0] + s1[1]) + (s1[2] + s1[3])); }
#pragma unroll
        for (int q = 0; q < 8; ++q) rsv[q] = fast_rsqrt(rsv[q] * (1.0f / KVR) + EPS);
#pragma unroll
        for (int ai = 0; ai < 2; ++ai) if ((u.am >> ai) & 1)
#pragma unroll
            for (int m = 0; m < 4; ++m) { const int row = row0 + ai * HALF + m * 16; const float rs = rsv[ai * 4 + m];
                { const f32x4 v0 = acc[ai][0][m][0] * rs, v1 = acc[ai][0][m][1] * rs; const float ss = quad_sum(sumsq8(v0, v1));
                  *(u32x4*)(KN + (size_t)row * D + u.pn * 128 + wc * 32 + fq * 8) = pack8(v0, v1);
                  if (fq == 0) SSK[row * 32 + u.pn * 4 + wc] = ss; }
                { const f32x4 v0 = acc[ai][1][m][0] * rs, v1 = acc[ai][1][m][1] * rs; const int b = row / SEQ, sq = row % SEQ;
                  *(u32x4*)(VV + (((size_t)b * NH + u.pn) * SEQ + sq) * DV + wc * 32 + fq * 8) = pack8(v0, v1); } }
    }
};

__device__ __forceinline__ void moe_setup(const int* CNT, LAS int* pref, LAS int* cnts) {
    const int tid = threadIdx.x; LAS int* spre = pref + 40;
    if (tid < 64) { const int c = tid < 32 ? (int)__hip_atomic_load((const unsigned*)CNT + tid * 64, __ATOMIC_RELAXED, __HIP_MEMORY_SCOPE_AGENT) : 0;
        const int nt = (c + 255) >> 8, rem = c - ((nt - 1) << 8), sm = (nt > 0 && rem <= 128) ? 1 : 0; int ib = nt - sm, is = sm;
#pragma unroll
        for (int o = 1; o < 32; o <<= 1) { const int v = __shfl_up(ib, o), w = __shfl_up(is, o); if (tid >= o) { ib += v; is += w; } }
        if (tid < 32) { pref[tid + 1] = ib; spre[tid + 1] = is; cnts[tid] = c; } if (tid == 0) { pref[0] = 0; spre[0] = 0; } }
    __syncthreads();
}
template <class Epi, bool GATHER> struct MoeP {
    static constexpr bool PERM = true;
    const char* A; int lda; int a_shift; const char* Bt; size_t b_estride; int K; const int4* LIST; const LAS int* pref; const LAS int* cnts; int G, c, nunits; Epi E;
    __device__ __forceinline__ bool next(int i, Unit& u) const {
        int L = i * G + c; const int nfull = (nunits / G) * G; int am = 3;
        if (L >= nfull) { const int hu = L - nfull; L = nfull + (hu >> 1); am = 1 << (hu & 1); }
        if (L >= nunits) return false;
        const int r = L >> 2, lane = threadIdx.x & 63; const LAS int* spre = pref + 40; const int nbig = __builtin_amdgcn_readfirstlane(pref[32]);
        int e, pm;
        if (r < nbig) { const int v = pref[(lane & 31) + 1]; e = __builtin_popcountll(__ballot(lane < 32 && r >= v)); pm = r - __builtin_amdgcn_readfirstlane(pref[e]); }
        else { const int q = r - nbig; const int v = spre[(lane & 31) + 1]; e = __builtin_popcountll(__ballot(lane < 32 && q >= v)); pm = ((__builtin_amdgcn_readfirstlane(cnts[e]) + 255) >> 8) - 1; }
        u.pn = L & 3; u.e = e; u.r = r; u.pm = pm; const int rem = __builtin_amdgcn_readfirstlane(cnts[e]) - BM * pm; u.nvalid = rem < BM ? rem : BM; u.am = (u.nvalid > HALF) ? am : (am & 1); return true;
    }
    __device__ __forceinline__ const char* b_base(const Unit& u) const { return Bt + (size_t)u.e * b_estride + (size_t)u.pn * BM * K * 2; }
    __device__ __forceinline__ void a_off(const Unit& u, const int (&sR)[2], const int (&sC)[2], unsigned (&ao)[4]) const {
        if constexpr (GATHER) {
            const int4* lp = LIST + (size_t)u.e * T + u.pm * BM;
#pragma unroll
            for (int h = 0; h < 2; ++h)
#pragma unroll
                for (int i = 0; i < 2; ++i) { const int row = h * HALF + sR[i]; int ent = lp[row].x; ent = row < u.nvalid ? ent : 0; ao[h * 2 + i] = (unsigned)((ent >> a_shift) * lda + sC[i]) * 2u; }
        } else {
#pragma unroll
            for (int h = 0; h < 2; ++h)
#pragma unroll
                for (int i = 0; i < 2; ++i) ao[h * 2 + i] = (unsigned)((u.r * BM + h * HALF + sR[i]) * lda + sC[i]) * 2u;
        }
    }
    __device__ __forceinline__ void epi(const Acc& acc, const Unit& u, int wr, int wc, int fr, int fq) const { E(acc, u, wr, wc, fr, fq, LIST + (size_t)u.e * T + u.pm * BM); }
};
struct EpiSwiglu {
    bf16* ACTS; int* POS;
    __device__ __forceinline__ void operator()(const Acc& acc, const Unit& u, int wr, int wc, int fr, int fq, const int4* lp) const {
        int4 rec[8];
#pragma unroll
        for (int q = 0; q < 8; ++q) { const int row = (q >> 2) * HALF + wr * 64 + (q & 3) * 16 + fr; rec[q] = lp[row]; }
#pragma unroll
        for (int ai = 0; ai < 2; ++ai) if ((u.am >> ai) & 1)
#pragma unroll
            for (int m = 0; m < 4; ++m) { const int q = ai * 4 + m, row = ai * HALF + wr * 64 + m * 16 + fr; const float rs = __int_as_float(rec[q].y);
                const f32x4 a0 = acc[ai][0][m][0] * rs, a1 = acc[ai][0][m][1] * rs, b0 = acc[ai][1][m][0] * rs, b1 = acc[ai][1][m][1] * rs;
                float o[8];
#pragma unroll
                for (int j = 0; j < 4; ++j) { o[j] = a0[j] * fast_sigmoid(a0[j]) * b0[j]; o[4 + j] = a1[j] * fast_sigmoid(a1[j]) * b1[j]; }
                u32x4 w; w.x = cvt_pk_bf16(o[0], o[1]); w.y = cvt_pk_bf16(o[2], o[3]); w.z = cvt_pk_bf16(o[4], o[5]); w.w = cvt_pk_bf16(o[6], o[7]);
                *(u32x4*)(ACTS + (size_t)(u.r * BM + row) * DE + u.pn * 128 + wc * 32 + fq * 8) = w;
                if (u.pn == 0 && wc == 0 && fq == 0 && row < u.nvalid) POS[rec[q].x] = u.r * BM + row; }
    }
};
struct EpiDown {
    bf16* YS;
    __device__ __forceinline__ void operator()(const Acc& acc, const Unit& u, int wr, int wc, int fr, int fq, const int4*) const {
#pragma unroll
        for (int ai = 0; ai < 2; ++ai) if ((u.am >> ai) & 1)
#pragma unroll
            for (int m = 0; m < 4; ++m) { const int row = ai * HALF + wr * 64 + m * 16 + fr;
#pragma unroll
                for (int bj = 0; bj < 2; ++bj) *(u32x4*)(YS + (size_t)(u.r * BM + row) * D + u.pn * BM + bj * HALF + wc * 32 + fq * 8) = pack8(acc[ai][bj][m][0], acc[ai][bj][m][1]); }
    }
};
}


namespace at {
typedef short s16x4 __attribute__((ext_vector_type(4)));
typedef float f32x16 __attribute__((ext_vector_type(16)));
constexpr int KTB = 64 * 192  , VTB = 64 * 128  , LDS_K = 0, LDS_V = 2 * KTB, LDS_AL = LDS_V + 2 * VTB, LDS_TOTAL = LDS_AL + 8 * 256;
constexpr float SC2 = SM_SCALE * 1.4426950408889634f;
constexpr float SQ2 = 0.32263132f;
constexpr float THR2 = 8.0f;
__device__ __forceinline__ int v_rd_base(int lane) { return ((lane & 3) << 3) | (((lane >> 2) & 3) << 6) | (((lane >> 4) & 1) << 5) | (((lane >> 5) & 1) << 8); }
constexpr int v_rd_off(int d0, int ks, int half) { return d0 * 512 + ks * 4096 + half * 2048; }
__device__ __forceinline__ int crow(int r, int hi) { return (r & 3) + 8 * (r >> 2) + 4 * hi; }
#define AT_SBAR() __builtin_amdgcn_sched_barrier(0)

typedef int i32x8 __attribute__((ext_vector_type(8)));
typedef int i32x4v __attribute__((ext_vector_type(4)));
template <int BUF>
__device__ __forceinline__ void tile_compute(f32x16 (&o)[4], const i32x8 (&qr)[3], float& m_run, float& l_run, f32x16& negm, const LAS char* kl,
                                             const LAS char* vl, LAS float* al_l, int r32, int hi) {
    f32x16 p0, p1;
#define AT_LOADK(kf, S_, blk_) do { const i32x4v a_ = *(const LAS i32x4v*)(kl + (S_) * 4096 + (blk_) * 1024 + BUF * KTB), b_ = *(const LAS i32x4v*)(kl + (S_) * 4096 + (blk_) * 1024 + 512 + BUF * KTB); \
        kf = (i32x8){a_[0], a_[1], a_[2], a_[3], b_[0], b_[1], b_[2], b_[3]}; } while (0)
#define AT_MMAK(P, kf, S_) do { __builtin_amdgcn_s_setprio(1); P = __builtin_amdgcn_mfma_scale_f32_32x32x64_f8f6f4(kf, qr[S_], (S_) == 0 ? negm : P, 0, 0, 0, 0x7f7f7f7f, 0, 0x7f7f7f7f); __builtin_amdgcn_s_setprio(0); } while (0)
    { i32x8 kfA, kfB;
      AT_LOADK(kfA, 0, 0); AT_LOADK(kfB, 0, 1); AT_SBAR();
      AT_MMAK(p0, kfA, 0); AT_SBAR(); AT_LOADK(kfA, 1, 0); AT_SBAR(); AT_MMAK(p1, kfB, 0); AT_SBAR(); AT_LOADK(kfB, 1, 1); AT_SBAR();
      AT_MMAK(p0, kfA, 1); AT_SBAR(); AT_LOADK(kfA, 2, 0); AT_SBAR(); AT_MMAK(p1, kfB, 1); AT_SBAR(); AT_LOADK(kfB, 2, 1); AT_SBAR();
      AT_MMAK(p0, kfA, 2); AT_SBAR(); AT_MMAK(p1, kfB, 2); AT_SBAR(); }
#undef AT_LOADK
#undef AT_MMAK
#define AT_LOADV(vf, d0_) do { const i32x4v a_ = *(const LAS i32x4v*)(vl + (d0_) * 2048 + BUF * VTB), b_ = *(const LAS i32x4v*)(vl + (d0_) * 2048 + 512 + BUF * VTB); \
        vf = (i32x8){a_[0], a_[1], a_[2], a_[3], b_[0], b_[1], b_[2], b_[3]}; } while (0)
    i32x8 vf0, vf1, vf2, vf3;
    AT_LOADV(vf0, 0); AT_LOADV(vf1, 1); AT_LOADV(vf2, 2); AT_LOADV(vf3, 3);
#undef AT_LOADV
    float pmax = p0[0];
#pragma unroll
    for (int r = 1; r < 16; ++r) pmax = fmaxf(pmax, p0[r]);
#pragma unroll
    for (int r = 0; r < 16; ++r) pmax = fmaxf(pmax, p1[r]);
    { auto rr = __builtin_amdgcn_permlane32_swap(__float_as_uint(pmax), __float_as_uint(pmax), false, false); pmax = fmaxf(__uint_as_float(rr[0]), __uint_as_float(rr[1])); }
    float alpha = 1.f;
    if (!__all(pmax <= THR2)) {
        const float d = fmaxf(pmax, 0.f); alpha = __builtin_amdgcn_exp2f(-d); m_run += d;
#pragma unroll
        for (int r = 0; r < 16; ++r) { p0[r] -= d; p1[r] -= d; negm[r] = -m_run; } }
#pragma unroll
    for (int r = 0; r < 16; ++r) { p0[r] = __builtin_amdgcn_exp2f(p0[r]); p1[r] = __builtin_amdgcn_exp2f(p1[r]); }
    float ps = 0.f;
#pragma unroll
    for (int r = 0; r < 16; ++r) ps += p0[r];
#pragma unroll
    for (int r = 0; r < 16; ++r) ps += p1[r];
    { auto rr = __builtin_amdgcn_permlane32_swap(__float_as_uint(ps), __float_as_uint(ps), false, false); ps = __uint_as_float(rr[0]) + __uint_as_float(rr[1]); }
    l_run = l_run * alpha + ps;
    i32x8 pf;
    { int a_[4], b_[4];
#pragma unroll
      for (int i = 0; i < 4; ++i) { int w = 0; w = __builtin_amdgcn_cvt_pk_fp8_f32(p0[4 * i], p0[4 * i + 1], w, false); a_[i] = __builtin_amdgcn_cvt_pk_fp8_f32(p0[4 * i + 2], p0[4 * i + 3], w, true);
          int v = 0; v = __builtin_amdgcn_cvt_pk_fp8_f32(p1[4 * i], p1[4 * i + 1], v, false); b_[i] = __builtin_amdgcn_cvt_pk_fp8_f32(p1[4 * i + 2], p1[4 * i + 3], v, true); }
      const auto r0 = __builtin_amdgcn_permlane32_swap((unsigned)a_[0], (unsigned)b_[0], false, false), r1 = __builtin_amdgcn_permlane32_swap((unsigned)a_[1], (unsigned)b_[1], false, false),
                 r2 = __builtin_amdgcn_permlane32_swap((unsigned)a_[2], (unsigned)b_[2], false, false), r3 = __builtin_amdgcn_permlane32_swap((unsigned)a_[3], (unsigned)b_[3], false, false);
      pf = (i32x8){(int)r0[0], (int)r1[0], (int)r2[0], (int)r3[0], (int)r0[1], (int)r1[1], (int)r2[1], (int)r3[1]}; }
    if (__any(alpha < 1.f)) { if (hi == 0) al_l[r32] = alpha; asm volatile("s_waitcnt lgkmcnt(0)" ::: "memory");
#pragma unroll
        for (int d_ = 0; d_ < 4; ++d_)
#pragma unroll
            for (int r = 0; r < 16; ++r) o[d_][r] *= al_l[crow(r, hi)]; }
    __builtin_amdgcn_s_setprio(1);
    o[0] = __builtin_amdgcn_mfma_scale_f32_32x32x64_f8f6f4(pf, vf0, o[0], 0, 0, 0, 0x7f7f7f7f, 0, 0x7f7f7f7f);
    o[1] = __builtin_amdgcn_mfma_scale_f32_32x32x64_f8f6f4(pf, vf1, o[1], 0, 0, 0, 0x7f7f7f7f, 0, 0x7f7f7f7f);
    o[2] = __builtin_amdgcn_mfma_scale_f32_32x32x64_f8f6f4(pf, vf2, o[2], 0, 0, 0, 0x7f7f7f7f, 0, 0x7f7f7f7f);
    o[3] = __builtin_amdgcn_mfma_scale_f32_32x32x64_f8f6f4(pf, vf3, o[3], 0, 0, 0, 0x7f7f7f7f, 0, 0x7f7f7f7f);
    __builtin_amdgcn_s_setprio(0);
}

struct AttnArgs { const bf16* QRAW; const float* SSQ; const float* qg; const float* CS; const unsigned char* KK8; const unsigned char* VV8; bf16* O; };

__device__ __forceinline__ void attn_phase(LAS unsigned char* lds, const AttnArgs& A, int G, int bx) {
    int tid_ = threadIdx.x; asm volatile("" : "+v"(tid_));
    const int tid = tid_, wid = __builtin_amdgcn_readfirstlane(tid >> 6), lane = tid & 63, r32 = lane & 31, hi = lane >> 5;
    const unsigned voffK = (unsigned)lane * 16u;
    const __amdgpu_buffer_rsrc_t rsK = __builtin_amdgcn_make_buffer_rsrc((void*)A.KK8, 0, NB * NH * (SEQ / 64) * KTB, 0x00020000), rsV = __builtin_amdgcn_make_buffer_rsrc((void*)A.VV8, 0, NB * NH * (SEQ / 64) * VTB, 0x00020000);
    const LAS char* kl = (const LAS char*)lds + LDS_K + hi * 2048 + r32 * 16;
    const LAS char* vl = (const LAS char*)lds + LDS_V + hi * 1024 + r32 * 16;
    LAS float* al_l = (LAS float*)(lds + LDS_AL) + wid * 64; LAS float* li_l = al_l + 32;
    const int vcu = (G % 8 == 0) ? (bx % 8) * (G / 8) + bx / 8 : bx;
#define AT_ISSUE(t, buf) do { const int ks_ = kbase + (t) * KTB, vs_ = vbase + (t) * VTB; \
        __builtin_amdgcn_raw_ptr_buffer_load_lds(rsK, (LAS void*)(lds + LDS_K + (buf) * KTB + wid * 1024), 16, voffK, ks_ + wid * 1024, 0, 0); \
        if (wid < 4) __builtin_amdgcn_raw_ptr_buffer_load_lds(rsK, (LAS void*)(lds + LDS_K + (buf) * KTB + (wid + 8) * 1024), 16, voffK, ks_ + (wid + 8) * 1024, 0, 0); \
        __builtin_amdgcn_raw_ptr_buffer_load_lds(rsV, (LAS void*)(lds + LDS_V + (buf) * VTB + wid * 1024), 16, voffK, vs_ + wid * 1024, 0, 0); } while (0)
    for (int item = vcu; item < NB * NH * 16; item += G) {
        const int bh = item >> 4, pr = item & 15, b = bh / NH, h = bh % NH;
        const int kbase = bh * ((SEQ / 64) * KTB), vbase = bh * ((SEQ / 64) * VTB);
        for (int pass = 0; pass < 2; ++pass) {
            const int qb = pass == 0 ? 31 - pr : pr, NT = 4 * (qb + 1), myNT = 4 * qb + (wid >> 1) + 1;
            AT_ISSUE(0, 0);
            i32x8 qr[3];
            { const int t = b * SEQ + qb * 256 + wid * 32 + r32; const bf16* qp = A.QRAW + (size_t)t * 1536 + h * DQK;
              const f32x2* sq = (const f32x2*)(A.SSQ + (size_t)t * 48 + h * 6); const f32x2 s0 = sq[0], s1 = sq[1], s2 = sq[2];
              const float rq = fast_rsqrt(((s0[0] + s0[1]) + (s1[0] + s1[1]) + (s2[0] + s2[1])) * (1.0f / DQK) + EPS) * SQ2;
#pragma unroll
              for (int S = 0; S < 2; ++S) { unsigned w[8];
#pragma unroll
                  for (int g = 0; g < 4; ++g) { const int d0 = 64 * S + 32 * hi + 8 * g; const bf16x8 raw = *(const bf16x8*)(qp + d0); const f32x4 g0 = *(const f32x4*)(A.qg + d0), g1 = *(const f32x4*)(A.qg + d0 + 4);
                      float x[8];
#pragma unroll
                      for (int e = 0; e < 8; ++e) x[e] = __uint_as_float(((unsigned)(unsigned short)raw[e]) << 16) * (e < 4 ? g0[e] : g1[e - 4]) * rq;
                      const u32x2 pk = pack_fp8x8(x); w[2 * g] = pk.x; w[2 * g + 1] = pk.y; }
                  qr[S] = (i32x8){(int)w[0], (int)w[1], (int)w[2], (int)w[3], (int)w[4], (int)w[5], (int)w[6], (int)w[7]}; }
              { unsigned w[8];
#pragma unroll
                  for (int g = 0; g < 4; ++g) { const int j0 = 8 * g; const bf16x8 r1 = *(const bf16x8*)(qp + 128 + j0), r2 = *(const bf16x8*)(qp + 160 + j0);
                      const f32x4 ga0 = *(const f32x4*)(A.qg + 128 + j0), ga1 = *(const f32x4*)(A.qg + 132 + j0), gb0 = *(const f32x4*)(A.qg + 160 + j0), gb1 = *(const f32x4*)(A.qg + 164 + j0);
                      const float* cp = A.CS + (size_t)t * 64 + j0; const f32x4 c0 = *(const f32x4*)cp, c1 = *(const f32x4*)(cp + 4), n0 = *(const f32x4*)(cp + 32), n1 = *(const f32x4*)(cp + 36);
                      float y[8];
#pragma unroll
                      for (int e = 0; e < 8; ++e) { const float x1 = __uint_as_float(((unsigned)(unsigned short)r1[e]) << 16) * (e < 4 ? ga0[e] : ga1[e - 4]) * rq, x2 = __uint_as_float(((unsigned)(unsigned short)r2[e]) << 16) * (e < 4 ? gb0[e] : gb1[e - 4]) * rq;
                          const float c = e < 4 ? c0[e] : c1[e - 4], sn = e < 4 ? n0[e] : n1[e - 4]; y[e] = hi == 0 ? (x1 * c - x2 * sn) : (x1 * sn + x2 * c); }
                      const u32x2 pk = pack_fp8x8(y); w[2 * g] = pk.x; w[2 * g + 1] = pk.y; }
                  qr[2] = (i32x8){(int)w[0], (int)w[1], (int)w[2], (int)w[3], (int)w[4], (int)w[5], (int)w[6], (int)w[7]}; } }
            float m_run = 0.f, l_run = 0.f; f32x16 o[4] = {}; f32x16 negm = {};
            for (int t = 0; t < NT; t += 2) {
                asm volatile("s_waitcnt vmcnt(0)" ::: "memory"); __builtin_amdgcn_s_barrier();
                AT_ISSUE(t + 1, 1);
                if (t < myNT) tile_compute<0>(o, qr, m_run, l_run, negm, kl, vl, al_l, r32, hi);
                asm volatile("s_waitcnt vmcnt(0)" ::: "memory"); __builtin_amdgcn_s_barrier();
                if (t + 2 < NT) AT_ISSUE(t + 2, 0);
                if (t + 1 < myNT) tile_compute<1>(o, qr, m_run, l_run, negm, kl, vl, al_l, r32, hi);
            }
            if (hi == 0) li_l[r32] = l_run; asm volatile("s_waitcnt lgkmcnt(0)" ::: "memory");
            bf16* Ow = A.O + (size_t)(b * SEQ + qb * 256 + wid * 32) * D + h * DV + (size_t)(4 * hi) * D + r32;
            asm volatile("" : "+v"(Ow));
#pragma unroll
            for (int r = 0; r < 16; ++r) { const int orow = crow(r, hi); const float rl = __builtin_amdgcn_rcpf(li_l[orow]);
#pragma unroll
                for (int d0 = 0; d0 < 4; ++d0) { const float v = o[d0][r] * rl; const float vn = __shfl_xor(v, 1);
                    if ((r32 & 1) == 0) *(unsigned*)(Ow + (size_t)((r & 3) + 8 * (r >> 2)) * D + d0 * 32) = cvt_pk_bf16(v, vn); } }
        }
    }
    asm volatile("s_waitcnt vmcnt(0)" ::: "memory"); __builtin_amdgcn_s_barrier();
#undef AT_ISSUE
}
#undef AT_SBAR
}


namespace th {
#define TH_LDS_WAIT() asm volatile("s_waitcnt lgkmcnt(0)" ::: "memory")
__device__ __forceinline__ void tr_item(const float* W, int K, int N, bf16* Wt, int row_off, const float* gain, int half, LAS float* scr, int item, int lane) {
    const int nblk = N / 32, kb = item / nblk, nb = item % nblk, k0 = 64 * kb, n0 = 32 * nb;
    const int kr = lane >> 3, c4 = (lane & 7) * 4;
    f32x4 v[8]; float g[8];
#pragma unroll
    for (int i = 0; i < 8; ++i) { v[i] = __builtin_nontemporal_load((const f32x4*)(W + (size_t)(k0 + 8 * i + kr) * N + n0 + c4)); g[i] = gain ? gain[k0 + 8 * i + kr] : 1.0f; }
#pragma unroll
    for (int i = 0; i < 8; ++i) { LAS float* d = scr + (8 * i + kr) * 33 + c4; d[0] = v[i][0] * g[i]; d[1] = v[i][1] * g[i]; d[2] = v[i][2] * g[i]; d[3] = v[i][3] * g[i]; }
    TH_LDS_WAIT(); asm volatile("" ::: "memory");
    const int c = lane & 7;
#pragma unroll
    for (int j = 0; j < 4; ++j) { const int n = (lane >> 3) + 8 * j; const LAS float* sp = scr + (8 * c) * 33 + n; const int nn = n0 + n, nr = half ? pair_row(nn, half) : nn;
        u32x4 o; o.x = cvt_pk_bf16(sp[0 * 33], sp[1 * 33]); o.y = cvt_pk_bf16(sp[2 * 33], sp[3 * 33]); o.z = cvt_pk_bf16(sp[4 * 33], sp[5 * 33]); o.w = cvt_pk_bf16(sp[6 * 33], sp[7 * 33]);
        *(u32x4*)(Wt + (size_t)(row_off + nr) * K + k0 + 8 * c) = o; }
    TH_LDS_WAIT(); asm volatile("" ::: "memory");
}
struct P0Args { const float* const* in; unsigned char* ws; };
__device__ __forceinline__ void prologue(LAS unsigned char* lds, const float* const (&in)[30], unsigned char* ws, int G, int bx) {
    int tid_ = threadIdx.x; asm volatile("" : "+v"(tid_));
    const int tid = tid_, lane = tid & 63, wave = __builtin_amdgcn_readfirstlane(tid >> 6);
    LAS float* scr = (LAS float*)(lds + wave * 16384);
    const int gw = bx * NWAVES_ + wave, NGW = G * NWAVES_;
    bf16 *W1t = (bf16*)(ws + WS_W1T), *W2t = (bf16*)(ws + WS_W2T), *Wc = (bf16*)(ws + WS_WC), *Wukv = (bf16*)(ws + WS_WUKV), *Wuq = (bf16*)(ws + WS_WUQ), *Wo = (bf16*)(ws + WS_WO),
         *Wgu = (bf16*)(ws + WS_WGU), *Wd = (bf16*)(ws + WS_WD);
    constexpr int I_W1 = 16 * 64, I_W2 = 16 * 32, I_DKV = 16 * 8, I_KR = 16 * 2, I_DQ = 16 * 12, I_UKV = 4 * 64, I_UQ = 6 * 48, I_WO = 16 * 32, I_GU1 = 16 * 32, I_D1 = 8 * 32;
    constexpr int NIT = I_W1 + I_W2 + I_DKV + I_KR + I_DQ + I_UKV + I_UQ + I_WO + 64 * I_GU1 + 64 * I_D1;
    for (int it = gw; it < NIT; it += NGW) {
        int r = it;
        if (r < 64 * I_GU1) { const int e = r / I_GU1; tr_item(in[28] + (size_t)e * D * 1024, D, 1024, Wgu + (size_t)e * 1024 * D, 0, in[23] + (e / NE) * D, 512, scr, r % I_GU1, lane); continue; } r -= 64 * I_GU1;
        if (r < 64 * I_D1) { const int e = r / I_D1; tr_item(in[29] + (size_t)e * DE * D, DE, D, Wd + (size_t)e * D * DE, 0, nullptr, 0, scr, r % I_D1, lane); continue; } r -= 64 * I_D1;
        if (r < I_W1) { tr_item(in[3], D, 2048, W1t, 0, in[2], 1024, scr, r, lane); continue; } r -= I_W1;
        if (r < I_W2) { tr_item(in[9], D, D, W2t, 0, nullptr, 0, scr, r, lane); continue; } r -= I_W2;
        if (r < I_DKV) { tr_item(in[12], D, KVR, Wc, 0, in[11], 0, scr, r, lane); continue; } r -= I_DKV;
        if (r < I_KR) { tr_item(in[14], D, DROPE, Wc, 256, in[11], 0, scr, r, lane); continue; } r -= I_KR;
        if (r < I_DQ) { tr_item(in[18], D, QLR, Wc, 320, in[17], 0, scr, r, lane); continue; } r -= I_DQ;
        if (r < I_UKV) { tr_item(in[15], KVR, 2048, Wukv, 0, in[13], 0, scr, r, lane); continue; } r -= I_UKV;
        if (r < I_UQ) { tr_item(in[20], QLR, 1536, Wuq, 0, in[19], 0, scr, r, lane); continue; } r -= I_UQ;
        tr_item(in[22], D, D, Wo, 0, nullptr, 0, scr, r, lane);
    }
    const int gt = bx * (NWAVES_ * 64) + tid, NGT = G * NWAVES_ * 64;
    for (int i = gt; i < 64 * D / 8; i += NGT) ((u32x4*)(Wc + (size_t)704 * D))[i] = (u32x4){0u, 0u, 0u, 0u};
    { float* Wr = (float*)(ws + WS_WR);
      for (int i = gt; i < 2 * D * NRT; i += NGT) { const int c = i % NRT, k = (i / NRT) % D, l = i / (NRT * D);
          const float w = c < NG ? in[24][((size_t)l * D + k) * NG + c] : in[26][((size_t)l * D + k) * NE + (c - NG)];
          Wr[(size_t)l * D * NRT + ((((k >> 5) * 4 + ((k >> 3) & 3)) * NRT + c) * 8) + (k & 7)] = w * in[23][l * D + k]; } }
    { float* cs = (float*)(ws + WS_CS); const int* pos = (const int*)in[1];
      for (int i = gt; i < T * 32; i += NGT) { const int t = i >> 5, f = i & 31; const float ang = (float)pos[t] * INV_FREQ[f]; double sn, c; sincos_d((double)ang, sn, c); cs[(size_t)t * 64 + f] = (float)c; cs[(size_t)t * 64 + 32 + f] = (float)sn; } }
    { const float* x = in[0]; bf16* xb = (bf16*)(ws + WS_R1); float* rstd = (float*)(ws + WS_RSTD0);
      for (int row = gw; row < T; row += NGW) { const f32x4* xr = (const f32x4*)(x + (size_t)row * D); float ss = 0.f;
#pragma unroll
          for (int j = 0; j < 4; ++j) { const f32x4 v = xr[lane + 64 * j]; ss += (v[0] * v[0] + v[1] * v[1]) + (v[2] * v[2] + v[3] * v[3]);
              u32x2 o; o.x = cvt_pk_bf16(v[0], v[1]); o.y = cvt_pk_bf16(v[2], v[3]); ((u32x2*)(xb + (size_t)row * D))[lane + 64 * j] = o; }
          ss = wave_sum(ss); if (lane == 0) rstd[row] = fast_rsqrt(ss * (1.0f / D) + EPS); } }
}
__device__ __forceinline__ void conv_ln(LAS unsigned char* lds, const bf16* U, const float* dw_w, const float* dw_b, const float* ln_g, const float* ln_b, bf16* Vb, int G, int bx) {
    int tid_ = threadIdx.x; asm volatile("" : "+v"(tid_));
    const int tid = tid_, lane = tid & 63, wave = __builtin_amdgcn_readfirstlane(tid >> 6);
    LAS float* tile = (LAS float*)lds;
    const int c0 = tid * 2;
    float w0[CONVW], w1[CONVW];
#pragma unroll
    for (int j = 0; j < CONVW; ++j) { const f32x2 w = *(const f32x2*)(dw_w + j * D + c0); w0[j] = w[0]; w1[j] = w[1]; }
    const f32x2 bb = *(const f32x2*)(dw_b + c0);
    for (int unit = bx; unit < T / 16; unit += G) {
        const int t0 = unit * 16, s0 = t0 & (SEQ - 1);
        float a0[16], a1[16];
#pragma unroll
        for (int r = 0; r < 16; ++r) { a0[r] = bb[0]; a1[r] = bb[1]; }
#define CV_LOAD(dst, ib) do { _Pragma("unroll") for (int k = 0; k < 12; ++k) { const int i = (ib) + k; dst[k] = (i < 46 && s0 - 30 + i >= 0) ? *(const unsigned*)(U + (size_t)(t0 - 30 + i) * D + c0) : 0u; } } while (0)
#define CV_FMA(src, ib) do { _Pragma("unroll") for (int k = 0; k < 12; ++k) { const int i = (ib) + k; if (i < 46) { const float u0 = __uint_as_float(src[k] << 16), u1 = __uint_as_float(src[k] & 0xffff0000u); \
            _Pragma("unroll") for (int r = 0; r < 16; ++r) { const int j = i - r; if (j >= 0 && j < CONVW) { a0[r] = fmaf(w0[j], u0, a0[r]); a1[r] = fmaf(w1[j], u1, a1[r]); } } } } } while (0)
        { unsigned ua[12], ub[12];
          CV_LOAD(ua, 0); asm volatile("" ::: "memory");
          CV_LOAD(ub, 12); asm volatile("" ::: "memory"); CV_FMA(ua, 0);
          CV_LOAD(ua, 24); asm volatile("" ::: "memory"); CV_FMA(ub, 12);
          CV_LOAD(ub, 36); asm volatile("" ::: "memory"); CV_FMA(ua, 24);
          CV_FMA(ub, 36); }
#undef CV_LOAD
#undef CV_FMA
#pragma unroll
        for (int r = 0; r < 16; ++r) *(LAS f32x2*)(tile + r * D + c0) = (f32x2){a0[r], a1[r]};
        __syncthreads();
#pragma unroll
        for (int rr = 0; rr < 2; ++rr) { const int r = wave * 2 + rr; const LAS f32x4* xr = (const LAS f32x4*)(tile + r * D); f32x4 v[4]; float sm = 0.f;
#pragma unroll
            for (int j = 0; j < 4; ++j) { v[j] = xr[lane + 64 * j]; sm += (v[j][0] + v[j][1]) + (v[j][2] + v[j][3]); }
            const float mean = wave_sum(sm) * (1.0f / D); float q = 0.f;
#pragma unroll
            for (int j = 0; j < 4; ++j) { v[j] = v[j] - mean; q += (v[j][0] * v[j][0] + v[j][1] * v[j][1]) + (v[j][2] * v[j][2] + v[j][3] * v[j][3]); }
            const float rs = fast_rsqrt(wave_sum(q) * (1.0f / D) + EPS);
#pragma unroll
            for (int j = 0; j < 4; ++j) { const int c = (lane + 64 * j) * 4; const f32x4 gg = *(const f32x4*)(ln_g + c), bv = *(const f32x4*)(ln_b + c); const f32x4 y = v[j] * rs * gg + bv;
                u32x2 o; o.x = cvt_pk_bf16(y[0] * fast_sigmoid(y[0]), y[1] * fast_sigmoid(y[1])); o.y = cvt_pk_bf16(y[2] * fast_sigmoid(y[2]), y[3] * fast_sigmoid(y[3]));
                ((u32x2*)(Vb + (size_t)(t0 + r) * D))[lane + 64 * j] = o; } }
        __syncthreads();
    }
}
__device__ __forceinline__ void route(LAS unsigned char* lds, const bf16* H, const float* WrP, const float* bg, const float* br, int4* LIST, int* CNT, float* GATE, int G, int bx) {
    int tid_ = threadIdx.x; asm volatile("" : "+v"(tid_));
    const int tid = tid_, lane = tid & 63, wave = __builtin_amdgcn_readfirstlane(tid >> 6), r16 = lane & 15, kq = lane >> 4;
    LAS float* Bs = (LAS float*)lds; LAS float* LG = (LAS float*)(lds + 73728) + wave * (16 * 37);
    constexpr int NTILES = T / 16; const int NW = G * NWAVES_;
    LAS int* lcnt = (LAS int*)(lds + 73728 + 8 * 16 * 37 * 4); LAS int* gbase = lcnt + NE;
    if (tid < NE) lcnt[tid] = 0;
    int e0 = 0, e1 = 0, sl0 = 0, sl1 = 0; float rsv = 0.f, gt0 = 0.f, gt1 = 0.f;
    for (int base = 0; base < NTILES; base += NW) {
        const int tile = base + bx * NWAVES_ + wave; const bool act = tile < NTILES; const int t0 = tile * 16;
        f32x4 c0 = {0.f, 0.f, 0.f, 0.f}, c1 = c0, c2 = c0; float ss = 0.f;
#pragma unroll 1
        for (int half = 0; half < 2; ++half) {
            __syncthreads();
#pragma unroll
            for (int i = 0; i < 9; ++i) ((LAS f32x4*)Bs)[tid + 512 * i] = ((const f32x4*)(WrP + half * 18432))[tid + 512 * i];
            __syncthreads();
            if (act) {
                const bf16* hp = H + (size_t)(t0 + r16) * D + half * 512 + 8 * kq;
#pragma unroll 4
                for (int jj = 0; jj < 16; ++jj) {
                    const u32x4 hw = *(const u32x4*)(hp + 32 * jj);
                    const f32x4 a0 = (f32x4){__uint_as_float(hw.x << 16), __uint_as_float(hw.x & 0xffff0000u), __uint_as_float(hw.y << 16), __uint_as_float(hw.y & 0xffff0000u)};
                    const f32x4 a1 = (f32x4){__uint_as_float(hw.z << 16), __uint_as_float(hw.z & 0xffff0000u), __uint_as_float(hw.w << 16), __uint_as_float(hw.w & 0xffff0000u)};
                    ss += ((a0[0] * a0[0] + a0[1] * a0[1]) + (a0[2] * a0[2] + a0[3] * a0[3])) + ((a1[0] * a1[0] + a1[1] * a1[1]) + (a1[2] * a1[2] + a1[3] * a1[3]));
                    const LAS float* bp = Bs + ((jj * 4 + kq) * NRT + r16) * 8;
                    const f32x4 b00 = *(const LAS f32x4*)bp, b01 = *(const LAS f32x4*)(bp + 4), b10 = *(const LAS f32x4*)(bp + 128), b11 = *(const LAS f32x4*)(bp + 132), b20 = *(const LAS f32x4*)(bp + 256), b21 = *(const LAS f32x4*)(bp + 260);
#pragma unroll
                    for (int i = 0; i < 4; ++i) { c0 = __builtin_amdgcn_mfma_f32_16x16x4f32(a0[i], b00[i], c0, 0, 0, 0); c1 = __builtin_amdgcn_mfma_f32_16x16x4f32(a0[i], b10[i], c1, 0, 0, 0); c2 = __builtin_amdgcn_mfma_f32_16x16x4f32(a0[i], b20[i], c2, 0, 0, 0); }
#pragma unroll
                    for (int i = 0; i < 4; ++i) { c0 = __builtin_amdgcn_mfma_f32_16x16x4f32(a1[i], b01[i], c0, 0, 0, 0); c1 = __builtin_amdgcn_mfma_f32_16x16x4f32(a1[i], b11[i], c1, 0, 0, 0); c2 = __builtin_amdgcn_mfma_f32_16x16x4f32(a1[i], b21[i], c2, 0, 0, 0); }
                }
            }
        }
        if (act) {
            ss += __shfl_xor(ss, 16); ss += __shfl_xor(ss, 32);
#pragma unroll
            for (int rg = 0; rg < 4; ++rg) { LG[(4 * kq + rg) * 37 + r16] = c0[rg]; LG[(4 * kq + rg) * 37 + 16 + r16] = c1[rg]; if (r16 < 4) LG[(4 * kq + rg) * 37 + 32 + r16] = c2[rg]; }
            asm volatile("s_waitcnt lgkmcnt(0)" ::: "memory");
            if (lane < 16) {
                const int t = t0 + lane; const LAS float* lr = LG + lane * 37;
                const float rs = fast_rsqrt(ss * (1.0f / D) + EPS);
                float lg[NG]; int gi = 0; float gm = -3.0e38f;
#pragma unroll
                for (int c = 0; c < NG; ++c) { lg[c] = lr[c] * rs + bg[c]; if (lg[c] > gm) { gm = lg[c]; gi = c; } }
                float gs = 0.f;
#pragma unroll
                for (int c = 0; c < NG; ++c) gs += __expf(lg[c] - gm);
                const float gw = 1.0f / gs;
                float le[EPG]; float em = -3.0e38f;
#pragma unroll
                for (int c = 0; c < EPG; ++c) { le[c] = lr[NG + gi * EPG + c] * rs + br[gi * EPG + c]; em = fmaxf(em, le[c]); }
                int i0 = 0; float v0 = -3.0e38f;
#pragma unroll
                for (int c = 0; c < EPG; ++c) if (le[c] > v0) { v0 = le[c]; i0 = c; }
                int i1 = 0; float v1 = -3.0e38f;
#pragma unroll
                for (int c = 0; c < EPG; ++c) if (c != i0 && le[c] > v1) { v1 = le[c]; i1 = c; }
                const float p0 = __expf(v0 - em), p1 = __expf(v1 - em); const float inv = 1.0f / (p0 + p1);
                e0 = gi * EPG + i0; e1 = gi * EPG + i1; rsv = rs; gt0 = gw * p0 * inv; gt1 = gw * p1 * inv;
                GATE[2 * t] = gt0; GATE[2 * t + 1] = gt1;
                sl0 = __hip_atomic_fetch_add(lcnt + e0, 1, __ATOMIC_RELAXED, __HIP_MEMORY_SCOPE_WORKGROUP);
                sl1 = __hip_atomic_fetch_add(lcnt + e1, 1, __ATOMIC_RELAXED, __HIP_MEMORY_SCOPE_WORKGROUP);
            }
        }
        __syncthreads();
        if (tid < NE) { const int n = lcnt[tid]; gbase[tid] = n > 0 ? atomicAdd(CNT + tid * 64, n) : 0; }
        __syncthreads();
        if (act && lane < 16) { const int t = t0 + lane;
            LIST[(size_t)e0 * T + gbase[e0] + sl0] = make_int4(2 * t, __float_as_int(rsv), __float_as_int(gt0), 0);
            LIST[(size_t)e1 * T + gbase[e1] + sl1] = make_int4(2 * t + 1, __float_as_int(rsv), __float_as_int(gt1), 0); }
        __syncthreads();
        if (tid < NE) lcnt[tid] = 0;
    }
    __syncthreads();
}
template <bool FINAL>
__device__ __forceinline__ void combine(bf16* HB, float* out, const bf16* YS, const int* POS, const float* GATE, float* RSTD2, int G, int bx) {
    int tid_ = threadIdx.x; asm volatile("" : "+v"(tid_));
    const int tid = tid_, lane = tid & 63, wave = __builtin_amdgcn_readfirstlane(tid >> 6);
    for (int t = bx * NWAVES_ + wave; t < T; t += G * NWAVES_) {
        const int p0 = POS[2 * t], p1 = POS[2 * t + 1]; const float g0 = GATE[2 * t], g1 = GATE[2 * t + 1];
        const u32x4* hr = (const u32x4*)(HB + (size_t)t * D); const u32x4* y0 = (const u32x4*)(YS + (size_t)p0 * D); const u32x4* y1 = (const u32x4*)(YS + (size_t)p1 * D);
        float ss = 0.f;
#pragma unroll
        for (int j = 0; j < 2; ++j) { const u32x4 hw = hr[lane + 64 * j], p = y0[lane + 64 * j], q = y1[lane + 64 * j]; float v[8];
            const unsigned hv[4] = {hw.x, hw.y, hw.z, hw.w}, pv[4] = {p.x, p.y, p.z, p.w}, qv[4] = {q.x, q.y, q.z, q.w};
#pragma unroll
            for (int e = 0; e < 4; ++e) { v[2 * e] = __uint_as_float(hv[e] << 16) + g0 * __uint_as_float(pv[e] << 16) + g1 * __uint_as_float(qv[e] << 16);
                v[2 * e + 1] = __uint_as_float(hv[e] & 0xffff0000u) + g0 * __uint_as_float(pv[e] & 0xffff0000u) + g1 * __uint_as_float(qv[e] & 0xffff0000u); }
            if constexpr (FINAL) { f32x4* o = (f32x4*)(out + (size_t)t * D) + 2 * (lane + 64 * j); o[0] = (f32x4){v[0], v[1], v[2], v[3]}; o[1] = (f32x4){v[4], v[5], v[6], v[7]}; }
            else { unsigned wv[4];
#pragma unroll
                for (int e = 0; e < 4; ++e) { wv[e] = cvt_pk_bf16(v[2 * e], v[2 * e + 1]); const float r0 = __uint_as_float(wv[e] << 16), r1 = __uint_as_float(wv[e] & 0xffff0000u); ss += r0 * r0 + r1 * r1; }
                u32x4 w; w.x = wv[0]; w.y = wv[1]; w.z = wv[2]; w.w = wv[3]; ((u32x4*)(HB + (size_t)t * D))[lane + 64 * j] = w; } }
        if constexpr (!FINAL) { ss = wave_sum(ss); if (lane == 0) RSTD2[t] = fast_rsqrt(ss * (1.0f / D) + EPS); }
    }
}
__device__ __forceinline__ void kfin(const bf16* KN, const bf16* CL, const float* SSK, const float* SSP, const float* kg, const float* cs, unsigned char* KK8, int G, int bx) {
    int tid_ = threadIdx.x; asm volatile("" : "+v"(tid_));
    const int tid = tid_, lane = tid & 63, wave = __builtin_amdgcn_readfirstlane(tid >> 6), r32 = lane & 31, hi = lane >> 5;
    for (int item = bx * NWAVES_ + wave; item < NB * NH * (SEQ / 64) * 2; item += G * NWAVES_) {
        const int blk = item & 1, tile = (item >> 1) & (SEQ / 64 - 1), bh = item >> 8, b = bh / NH, h = bh % NH;
        const int t = b * SEQ + tile * 64 + blk * 32 + r32;
        const f32x4 sk = *(const f32x4*)(SSK + t * 32 + h * 4); const f32x2 sr = *(const f32x2*)(SSP + t * 32 + 8);
        const float rk = fast_rsqrt((((sk[0] + sk[1]) + (sk[2] + sk[3])) + (sr[0] + sr[1])) * (1.0f / DQK) + EPS) * at::SQ2;
        unsigned char* out = KK8 + ((size_t)(bh * (SEQ / 64) + tile)) * (64 * 192) + blk * 1024 + r32 * 16 + hi * 8;
#define KF_OFF(s_) (((s_) >> 2) * 4096 + ((((s_) & 3) >> 1) * 2048) + (((s_) & 1) * 512))
        const bf16* kn = KN + (size_t)t * D + h * 128 + hi * 8;
#pragma unroll
        for (int s = 0; s < 8; ++s) { const bf16x8 raw = *(const bf16x8*)(kn + s * 16); const f32x4 g0 = *(const f32x4*)(kg + s * 16 + hi * 8), g1 = *(const f32x4*)(kg + s * 16 + hi * 8 + 4);
            float y[8];
#pragma unroll
            for (int e = 0; e < 8; ++e) y[e] = __uint_as_float(((unsigned)(unsigned short)raw[e]) << 16) * rk * (e < 4 ? g0[e] : g1[e - 4]);
            *(u32x2*)(out + KF_OFF(s)) = pack_fp8x8(y); }
#pragma unroll
        for (int s = 0; s < 2; ++s) { const int jt = s * 16 + hi * 8;
            const bf16x8 r1 = *(const bf16x8*)(CL + (size_t)t * NCL + 256 + jt), r2 = *(const bf16x8*)(CL + (size_t)t * NCL + 288 + jt);
            const float* cp = cs + (size_t)t * 64 + jt; const f32x4 c0 = *(const f32x4*)cp, c1 = *(const f32x4*)(cp + 4), n0 = *(const f32x4*)(cp + 32), n1 = *(const f32x4*)(cp + 36);
            const f32x4 ga0 = *(const f32x4*)(kg + 128 + jt), ga1 = *(const f32x4*)(kg + 132 + jt), gb0 = *(const f32x4*)(kg + 160 + jt), gb1 = *(const f32x4*)(kg + 164 + jt);
            float y1[8], y2[8];
#pragma unroll
            for (int e = 0; e < 8; ++e) { const float p = __uint_as_float(((unsigned)(unsigned short)r1[e]) << 16) * rk * (e < 4 ? ga0[e] : ga1[e - 4]), q = __uint_as_float(((unsigned)(unsigned short)r2[e]) << 16) * rk * (e < 4 ? gb0[e] : gb1[e - 4]);
                const float c = e < 4 ? c0[e] : c1[e - 4], sn = e < 4 ? n0[e] : n1[e - 4]; y1[e] = p * c - q * sn; y2[e] = p * sn + q * c; }
            *(u32x2*)(out + KF_OFF(8 + s)) = pack_fp8x8(y1); *(u32x2*)(out + KF_OFF(10 + s)) = pack_fp8x8(y2); }
    }
#undef KF_OFF
}
__device__ __forceinline__ void vfin(LAS unsigned char* lds, const bf16* VV, unsigned char* VV8, int G, int bx) {
    int tid_ = threadIdx.x; asm volatile("" : "+v"(tid_));
    const int tid = tid_, lane = tid & 63, wave = __builtin_amdgcn_readfirstlane(tid >> 6);
    LAS unsigned char* scr = lds + wave * 2048;
    const int hh = lane >> 5, kb = lane & 31, q4 = kb >> 3, w8 = kb & 7, jp = w8 < 4 ? 4 * q4 + w8 : 16 + 4 * q4 + (w8 - 4);
    LAS unsigned char* dst = scr + hh * 1024 + (jp >> 4) * 512 + (jp & 15);
    for (int item = bx * NWAVES_ + wave; item < NB * NH * (SEQ / 64) * 4; item += G * NWAVES_) {
        const int d0 = item & 3, tile = (item >> 2) & (SEQ / 64 - 1), bh = item >> 9;
        const bf16* src = VV + ((size_t)bh * SEQ + tile * 64 + lane) * DV + d0 * 32;
#pragma unroll
        for (int g = 0; g < 4; ++g) { const bf16x8 raw = *(const bf16x8*)(src + 8 * g);
#pragma unroll
            for (int e = 0; e < 8; ++e) { const float v = __uint_as_float(((unsigned)(unsigned short)raw[e]) << 16); dst[(8 * g + e) * 16] = (unsigned char)(__builtin_amdgcn_cvt_pk_fp8_f32(v, v, 0, false) & 0xff); } }
        asm volatile("s_waitcnt lgkmcnt(0)" ::: "memory");
        const u32x4 o0 = *(const LAS u32x4*)(scr + lane * 32), o1 = *(const LAS u32x4*)(scr + lane * 32 + 16);
        unsigned char* out = VV8 + ((size_t)(bh * (SEQ / 64) + tile)) * (64 * 128) + d0 * 2048 + lane * 32;
        *(u32x4*)out = o0; *(u32x4*)(out + 16) = o1;
        asm volatile("s_waitcnt lgkmcnt(0)" ::: "memory");
    }
}
#undef TH_LDS_WAIT
}

#define XB_TMO      128
#define XB_XCNT(j)  (256  + 64 * (j))
#define XB_XSUB(j)  (1280 + 64 * (j))
#define XB_XGEN(j)  (2304 + 64 * (j))
#define XB_TOP      3328
#define XB_TOPGEN   3392
#define XCD_BAR_WORDS 3456
#define XB_SPIN_CAP (1u << 18)
__device__ __forceinline__ unsigned xb_ld(unsigned* p)              { return __hip_atomic_load(p, __ATOMIC_RELAXED, __HIP_MEMORY_SCOPE_AGENT); }
__device__ __forceinline__ unsigned xb_add(unsigned* p, unsigned v) { return __hip_atomic_fetch_add(p, v, __ATOMIC_RELAXED, __HIP_MEMORY_SCOPE_AGENT); }
__device__ __forceinline__ unsigned xb_xcc_id() { return (unsigned)__builtin_amdgcn_s_getreg((3 << 11) | 20) & 0xFu; }
#define XB_SPIN(cond, bar) do { unsigned _sp = 0; while (cond) { __builtin_amdgcn_s_sleep(1); \
    if ((++_sp & 255u) == 0u) { if (xb_ld(&(bar)[XB_TMO])) break; if (_sp > XB_SPIN_CAP) { atomicAdd(&(bar)[XB_TMO], 1u); break; } } } } while (0)
struct XcdBarrier { unsigned* bar; unsigned x; volatile LAS unsigned* st; };
__device__ __forceinline__ XcdBarrier xcd_barrier_post(unsigned* bar, volatile LAS unsigned* st) {
    XcdBarrier b; b.bar = bar; b.x = xb_xcc_id(); b.st = st;
    if (threadIdx.x == 0) (void)xb_add(&bar[XB_XCNT(b.x)], 1u);
    return b;
}
__device__ __forceinline__ void xcd_barrier_complete(unsigned* bar, unsigned x, unsigned& nloc, unsigned& nx) {
    const unsigned G = gridDim.x * gridDim.y * gridDim.z;
    unsigned sum, cnt, mine, sp = 0u;
    for (;;) {
        sum = 0u; cnt = 0u; mine = 0u;
#pragma unroll
        for (unsigned j = 0; j < 16; ++j) { const unsigned c = xb_ld(&bar[XB_XCNT(j)]); sum += c; cnt += (c > 0u) ? 1u : 0u; mine = (j == x) ? c : mine; }
        if (sum == G) break;
        __builtin_amdgcn_s_sleep(1);
        if ((++sp & 255u) == 0u) { if (xb_ld(&bar[XB_TMO])) break; if (sp > XB_SPIN_CAP) { atomicAdd(&bar[XB_TMO], 1u); break; } }
    }
    nloc = mine > 0u ? mine : 1u; nx = cnt > 0u ? cnt : 1u;
}
__device__ __forceinline__ void xcd_barrier(const XcdBarrier& b) {
    asm volatile("s_waitcnt vmcnt(0)" ::: "memory");
    __syncthreads();
    if (threadIdx.x == 0) {
        unsigned* bar = b.bar;
        __builtin_amdgcn_s_waitcnt(0);
        unsigned nloc = b.st[0], nx = b.st[1];
        if (nloc == 0u) { xcd_barrier_complete(bar, b.x, nloc, nx); b.st[0] = nloc; b.st[1] = nx; }
        const unsigned old = xb_add(&bar[XB_XSUB(b.x)], 1u);
        const unsigned gen = old / nloc;
        if (old + 1u == (gen + 1u) * nloc) {
            __builtin_amdgcn_fence(__ATOMIC_RELEASE, "agent");
            asm volatile("s_waitcnt vmcnt(0)" ::: "memory");
            const unsigned og = xb_add(&bar[XB_TOP], 1u);
            const unsigned tg = og / nx;
            if (og + 1u == (tg + 1u) * nx) xb_add(&bar[XB_TOPGEN], 1u);
            else XB_SPIN(xb_ld(&bar[XB_TOPGEN]) == tg, bar);
            __builtin_amdgcn_fence(__ATOMIC_ACQUIRE, "agent");
            xb_add(&bar[XB_XGEN(b.x)], 1u);
            asm volatile("s_waitcnt vmcnt(0)" ::: "memory");
        } else {
            XB_SPIN(xb_ld(&bar[XB_XGEN(b.x)]) == gen, bar);
            __builtin_amdgcn_fence(__ATOMIC_ACQUIRE, "agent");
            asm volatile("s_waitcnt vmcnt(0)" ::: "memory");
        }
    }
    __syncthreads();
}

constexpr int NWAVES = 8, LDS_BYTES = 160 * 1024, LDS_MISC = 159 * 1024;
constexpr int CW_BAR = 4096;
constexpr int NPHASE = 17;
constexpr int PROBE_PH = -1, PROBE_MULT = 4;
constexpr int REP0 = 1, REP1 = 1, REP2 = 1, REP3 = 1, REP5 = 1, REP6 = 1, REP8 = 1, REP9 = 1, REP10 = 1, REP11 = 1, REP14 = 1, REP15 = 1;
struct Args { const float* in[30]; float* out; unsigned char* ws; int ph_lo, ph_hi; };

__global__ void __launch_bounds__(NWAVES * 64, 2) fwd(Args a) {
    extern __shared__ __attribute__((aligned(16))) unsigned char lds_raw[];
    LAS unsigned char* lds = (LAS unsigned char*)lds_raw;
    volatile LAS unsigned* MISC = (volatile LAS unsigned*)(lds + LDS_MISC);
    const int tid = threadIdx.x;
    if (tid < 64) MISC[tid] = 0u;
    __syncthreads();
    unsigned char* ws = a.ws; float* H = a.out;
    XcdBarrier bar = xcd_barrier_post((unsigned*)(ws + WS_CTL) + CW_BAR, MISC + 8);
    const int lo = a.ph_lo, hi = a.ph_hi, G = gridDim.x, bx = blockIdx.x;
    const int vcu = (G % 8 == 0) ? (bx % 8) * (G / 8) + bx / 8 : bx;
    unsigned long long pt0_ = 0, pt1_ = 0;
#define STAMP(k) do { if (PROBE_PH >= 0 && (k) == PROBE_PH) pt0_ = __builtin_amdgcn_s_memrealtime(); if (PROBE_PH >= 0 && (k) == PROBE_PH + 1) pt1_ = __builtin_amdgcn_s_memrealtime(); } while (0)
#define IN(k) (lo <= (k) && (k) < hi)
#define SEAM(k) do { if (IN(k) && IN((k) + 1)) xcd_barrier(bar); } while (0)
    const float* x = a.in[0];
    bf16 *W1t = (bf16*)(ws + WS_W1T), *W2t = (bf16*)(ws + WS_W2T), *Wc = (bf16*)(ws + WS_WC), *Wukv = (bf16*)(ws + WS_WUKV), *Wuq = (bf16*)(ws + WS_WUQ), *Wo = (bf16*)(ws + WS_WO);
    float *RSTD0 = (float*)(ws + WS_RSTD0), *RSTD2 = (float*)(ws + WS_RSTD2), *SSP = (float*)(ws + WS_SSP), *SSQ = (float*)(ws + WS_SSQ), *SSK = (float*)(ws + WS_SSK);
    bf16 *XB = (bf16*)(ws + WS_R1), *HB = XB, *U = (bf16*)(ws + WS_R2), *O = U, *Vb = (bf16*)(ws + WS_R3), *KN = Vb, *VV = (bf16*)(ws + WS_R3 + 64 * MiB),
         *CL = (bf16*)(ws + WS_CL), *QRAW = (bf16*)(ws + WS_QRAW);

    STAMP(0);
    if (IN(0)) for (int rep_ = 0; rep_ < REP0; ++rep_) th::prologue(lds, a.in, ws, G, bx);
    SEAM(0);
    STAMP(1);
    if (IN(1)) for (int rep_ = 0; rep_ < REP1; ++rep_) { fg::DenseP<fg::EpiGlu> p{(const char*)XB, D, (const char*)W1t, D, {}, {RSTD0, a.in[4], U}}; p.S.init(T, 2048, G, bx); fg::gemm_phase(lds, p); }
    SEAM(1);
    STAMP(2);
    if (IN(2)) for (int rep_ = 0; rep_ < REP2; ++rep_) th::conv_ln(lds, U, a.in[5], a.in[6], a.in[7], a.in[8], Vb, G, bx);
    SEAM(2);
    STAMP(3);
    if (IN(3)) for (int rep_ = 0; rep_ < REP3; ++rep_) { fg::DenseP<fg::EpiRes<true>> p{(const char*)Vb, D, (const char*)W2t, D, {}, {HB  , a.in[10], HB}}; p.S.init(T, D, G, bx); fg::gemm_phase(lds, p); }
    SEAM(3);
    LAS int* pref = (LAS int*)(lds + LDS_MISC + 256); LAS int* cnts = (LAS int*)(lds + LDS_MISC + 640);
    int4* LIST = (int4*)(ws + WS_LISTR); int* POS = (int*)(ws + WS_LIST); float* GATE = (float*)(ws + WS_GATE); bf16* ACTS = (bf16*)(ws + WS_ACTS); bf16* YS = (bf16*)(ws + WS_YS);
    bf16* XT = XB; bf16* ACT = U; bf16* Y = Vb; const bf16* Wgu = (const bf16*)(ws + WS_WGU); const bf16* Wd = (const bf16*)(ws + WS_WD);
#define MOE_GEMMS(l, p1, p2) do { \
        STAMP(p1); \
        if (IN(p1)) for (int rep_ = 0; rep_ < ((l) ? REP14 : REP5); ++rep_) { fg::moe_setup((const int*)(ws + WS_CTL) + (l) * NE * 64, pref, cnts); \
            fg::MoeP<fg::EpiSwiglu, true> p{(const char*)HB, D, 1, (const char*)(Wgu + (size_t)(l) * NE * 1024 * D), (size_t)1024 * D * 2, D, LIST, pref, cnts, G, vcu, 4 * (__builtin_amdgcn_readfirstlane(pref[32]) + __builtin_amdgcn_readfirstlane(pref[72])), {ACTS, POS}}; \
            fg::gemm_phase(lds, p); } \
        SEAM(p1); \
        STAMP(p2); \
        if (IN(p2)) for (int rep_ = 0; rep_ < ((l) ? REP15 : REP6); ++rep_) { fg::moe_setup((const int*)(ws + WS_CTL) + (l) * NE * 64, pref, cnts); \
            fg::MoeP<fg::EpiDown, false> p{(const char*)ACTS, DE, 0, (const char*)(Wd + (size_t)(l) * NE * D * DE), (size_t)D * DE * 2, DE, LIST, pref, cnts, G, vcu, 4 * (__builtin_amdgcn_readfirstlane(pref[32]) + __builtin_amdgcn_readfirstlane(pref[72])), {YS}}; \
            fg::gemm_phase(lds, p); } \
        SEAM(p2); } while (0)
    float* Wr = (float*)(ws + WS_WR); int* CNT = (int*)(ws + WS_CTL);
    STAMP(4);
    if (IN(4)) th::route(lds, HB, Wr, a.in[25], a.in[27], LIST, CNT, GATE, G, bx);
    SEAM(4);
    MOE_GEMMS(0, 5, 6);
    STAMP(7);
    if (IN(7)) th::combine<false>(HB, nullptr, YS, POS, GATE, RSTD2, G, bx);
    SEAM(7);
    STAMP(8);
    if (IN(8)) for (int rep_ = 0; rep_ < REP8; ++rep_) { fg::DenseP<fg::EpiCL> p{(const char*)HB, D, (const char*)Wc, D, {}, {RSTD2, CL, SSP}}; p.S.init(T, NCL, G, bx); fg::gemm_phase(lds, p); }
    SEAM(8);
    STAMP(9);
    if (IN(9)) for (int rep_ = 0; rep_ < REP9; ++rep_) {
        { fg::DenseP<fg::EpiQ> p{(const char*)(CL + 320), NCL, (const char*)Wuq, QLR, {}, {SSP, QRAW, SSQ}}; p.S.init(T, 1536, G, bx); fg::gemm_phase(lds, p); }
        { fg::DenseP<fg::EpiKV> p{(const char*)CL, NCL, (const char*)Wukv, KVR, {}, {SSP, KN, VV, SSK}}; p.S.init(T, 2048, G, bx); fg::gemm_phase(lds, p); }
    }
    SEAM(9);
    STAMP(10);
    if (IN(10)) for (int rep_ = 0; rep_ < REP10; ++rep_) { th::kfin(KN, CL, SSK, SSP, a.in[16], (const float*)(ws + WS_CS), (unsigned char*)(ws + WS_KK), G, bx); th::vfin(lds, VV, (unsigned char*)(ws + WS_KK + 48 * MiB), G, bx); }
    SEAM(10);
    STAMP(11);
    if (IN(11)) for (int rep_ = 0; rep_ < REP11; ++rep_) { const at::AttnArgs aa{QRAW, SSQ, a.in[21], (const float*)(ws + WS_CS), (const unsigned char*)(ws + WS_KK), (const unsigned char*)(ws + WS_KK + 48 * MiB), O}; at::attn_phase(lds, aa, G, bx); }
    SEAM(11);
    STAMP(12);
    if (IN(12)) { fg::DenseP<fg::EpiRes<true>> p{(const char*)O, D, (const char*)Wo, D, {}, {HB, nullptr, HB}}; p.S.init(T, D, G, bx); fg::gemm_phase(lds, p); }
    SEAM(12);
    STAMP(13);
    if (IN(13)) th::route(lds, HB, Wr + (size_t)D * NRT, a.in[25] + NG, a.in[27] + NE, LIST, CNT + NE * 64, GATE, G, bx);
    SEAM(13);
    MOE_GEMMS(1, 14, 15);
    STAMP(16);
    if (IN(16)) th::combine<true>(HB, H, YS, POS, GATE, nullptr, G, bx);
#undef MOE_GEMMS
    STAMP(17);
    if (PROBE_PH >= 0 && bx == 0) { const unsigned long long te_ = __builtin_amdgcn_s_memrealtime(), dt_ = (pt1_ - pt0_) * (unsigned long long)PROBE_MULT; while (__builtin_amdgcn_s_memrealtime() - te_ < dt_) __builtin_amdgcn_s_sleep(8); }
#undef IN
#undef SEAM
#undef STAMP
}

extern "C" void kernel_launch(void* const* d_in, const int* in_sizes, int n_in, void* d_out, int out_size, void* d_ws, size_t ws_size, hipStream_t stream) {
    if (n_in != 30 || ws_size < WS_END || out_size != T * D) { fprintf(stderr, "kernel_launch: unexpected shapes (n_in %d, ws %zu, out %d)\n", n_in, ws_size, out_size); return; }
    static int grid = 0;
    if (!grid) {
        (void)hipFuncSetAttribute((const void*)fwd, hipFuncAttributeMaxDynamicSharedMemorySize, LDS_BYTES);
        int dev = 0, cus = 0; (void)hipGetDevice(&dev); if (hipDeviceGetAttribute(&cus, hipDeviceAttributeMultiprocessorCount, dev) != hipSuccess || cus <= 0) cus = 256;
        grid = cus;
    }
    char* ws = (char*)d_ws;
    Args a{}; for (int i = 0; i < 30; ++i) a.in[i] = (const float*)d_in[i]; a.out = (float*)d_out; a.ws = (unsigned char*)d_ws;
    (void)hipMemsetAsync(ws + WS_CTL, 0, 1 * MiB, stream);
    a.ph_lo = 0; a.ph_hi = NPHASE;
    hipLaunchKernelGGL(fwd, dim3(grid), dim3(NWAVES * 64), LDS_BYTES, stream, a);
}
```
